# Optimizing an MI355X kernel written in HIP

```python
import math
import jax, jax.numpy as jnp
from jax import lax
import numpy as np

D_MODEL = 2048
BATCH = 16
SEQ = 2048
DEPTH = 2
DEC_BATCH = 2
DEC_SEQ = 16384
PAST_LEN = 128

N_MIXERS = 2
N_A_LAYERS = (DEPTH + 1) // 2
N_B_LAYERS = DEPTH // 2
CHUNK = 128
GMLP_WIDTH = D_MODEL
GMLP_GROUPS = 16
GMLP_GROUP_DIM = GMLP_WIDTH // GMLP_GROUPS
HEAD_DIM = 128
HEADS_PER_GROUP = 8
DILATION_PAIRS = ((128, 1), (512, 4), (2048, 16))
N_DIL_GROUPS = len(DILATION_PAIRS)
ATTN_WIDTH = HEADS_PER_GROUP * HEAD_DIM
ROT_DIM = HEAD_DIM // 4
ROPE_THETA = 500000.0
NEG_BIG = -1e30
D_FF = ((8 * D_MODEL + 3 * 256 - 1) // (3 * 256)) * 256
PLE_DIM = 256
DEEPNORM_ALPHA = (2.0 * DEPTH) ** 0.25
DEEPNORM_BETA = (8.0 * DEPTH) ** -0.25
LN_EPS = 1e-5

kernel_name = "hybrid_gmlp_dilated_attn_encoder"


def layer_norm(x, g, b):
    xf = x.astype(jnp.float32)
    mu = jnp.mean(xf, axis=-1, keepdims=True)
    var = jnp.mean(jnp.square(xf - mu), axis=-1, keepdims=True)
    y = (xf - mu) * lax.rsqrt(var + LN_EPS)
    return (y * g.astype(jnp.float32) + b.astype(jnp.float32)).astype(x.dtype)


def rotary_partial(t, pos):
    half = ROT_DIM // 2
    inv_freq = ROPE_THETA ** (-jnp.arange(0, ROT_DIM, 2, dtype=jnp.float32) / ROT_DIM)
    ang = pos.astype(jnp.float32)[:, None] * inv_freq[None, :]
    cos = jnp.cos(ang)[None, :, None, :]
    sin = jnp.sin(ang)[None, :, None, :]
    tr = t[..., :ROT_DIM].astype(jnp.float32)
    t1, t2 = tr[..., :half], tr[..., half:]
    rot = jnp.concatenate([t1 * cos - t2 * sin, t1 * sin + t2 * cos], axis=-1)
    return jnp.concatenate([rot.astype(t.dtype), t[..., ROT_DIM:]], axis=-1)


def banded_attention(q, k, v, half):
    bp, L, H, dh = q.shape
    blk = 2 * half
    nb = -(-L // blk)
    lp = nb * blk
    qp = jnp.pad(q, ((0, 0), (0, lp - L), (0, 0), (0, 0))).reshape(bp, nb, blk, H, dh)
    pad_k = ((0, 0), (half, lp - L + half), (0, 0), (0, 0))
    kp = jnp.pad(k, pad_k).reshape(bp, nb + 1, blk, H, dh)
    vp = jnp.pad(v, pad_k).reshape(bp, nb + 1, blk, H, dh)
    kwin = jnp.concatenate([kp[:, :-1], kp[:, 1:]], axis=2)
    vwin = jnp.concatenate([vp[:, :-1], vp[:, 1:]], axis=2)
    s = jnp.einsum('bnqhd,bnkhd->bnhqk', qp.astype(jnp.float32), kwin.astype(jnp.float32))
    a = jnp.arange(blk)[:, None]
    c = jnp.arange(2 * blk)[None, :]
    rel = c - a
    band = (rel >= 0) & (rel <= 2 * half)
    j = jnp.arange(nb)[:, None, None] * blk + c[None] - half
    mask = band[None] & (j >= 0) & (j < L)
    s = jnp.where(mask[None, :, None], s, NEG_BIG)
    m = jnp.max(s, axis=-1, keepdims=True)
    p = jnp.exp(s - m)
    den = jnp.sum(p, axis=-1)
    o = jnp.einsum('bnhqk,bnkhd->bnqhd', p, vwin.astype(jnp.float32))
    o = o / jnp.transpose(den, (0, 1, 3, 2))[..., None]
    lse = jnp.transpose(m[..., 0] + jnp.log(den), (0, 1, 3, 2))
    o = o.reshape(bp, lp, H, dh)[:, :L]
    lse = lse.reshape(bp, lp, H)[:, :L]
    return o, lse


def dilated_group(q, k, v, dil, half):
    b, s, h, dh = q.shape
    L = s // dil

    def to_sub(t):
        return jnp.transpose(t.reshape(b, L, dil, h, dh), (0, 2, 1, 3, 4)).reshape(b * dil, L, h, dh)

    o, lse = banded_attention(to_sub(q), to_sub(k), to_sub(v), half)
    o = jnp.transpose(o.reshape(b, dil, L, h, dh), (0, 2, 1, 3, 4)).reshape(b, s, h, dh)
    lse = jnp.transpose(lse.reshape(b, dil, L, h), (0, 2, 1, 3)).reshape(b, s, h)
    return o, lse


def dilated_attention(x, w_qkv, w_o, pos):
    b, s, _ = x.shape
    qkv = (x @ w_qkv).reshape(b, s, N_DIL_GROUPS, 3, HEADS_PER_GROUP, HEAD_DIM)
    outs, lses = [], []
    for g, (window, dil) in enumerate(DILATION_PAIRS):
        q = rotary_partial(qkv[:, :, g, 0], pos) * (HEAD_DIM ** -0.5)
        k = rotary_partial(qkv[:, :, g, 1], pos)
        v = qkv[:, :, g, 2]
        o, lse = dilated_group(q, k, v, dil, window // (2 * dil))
        outs.append(o)
        lses.append(lse)
    wts = jax.nn.softmax(jnp.stack(lses, axis=0), axis=0)
    o = sum(wts[g][..., None] * outs[g] for g in range(N_DIL_GROUPS))
    return o.astype(x.dtype).reshape(b, s, ATTN_WIDTH) @ w_o


def chunked_gmlp(x, w_in, ln_g, ln_b, w_s, b_s, w_o):
    b, s, _ = x.shape
    h = jax.nn.gelu(x @ w_in, approximate=False)
    u, v = jnp.split(h, 2, axis=-1)
    v = layer_norm(v, ln_g, ln_b).reshape(b, s // CHUNK, CHUNK, GMLP_GROUPS, GMLP_GROUP_DIM)
    v = jnp.einsum('gpq,bnqgc->bnpgc', w_s, v) + jnp.transpose(b_s)[:, :, None]
    return (u * v.reshape(b, s, GMLP_WIDTH)) @ w_o


def swiglu(x, w_gu, w_down):
    g, u = jnp.split(x @ w_gu, 2, axis=-1)
    return (jax.nn.silu(g) * u) @ w_down


def trunk(x, p, w_in_a, ln_v_g, ln_v_b, w_s_a, b_s_a, w_o_a, w_qkv_b, w_o_b,
          ln_mix_g, ln_mix_b, w_ffn_gu, w_ffn_down, ln_ffn_g, ln_ffn_b,
          w_ple_gate, w_ple_proj):
    pos = jnp.arange(x.shape[1], dtype=jnp.float32)
    for i in range(DEPTH):
        j = i // N_MIXERS
        if i % N_MIXERS == 0:
            mix = chunked_gmlp(x, w_in_a[j], ln_v_g[j], ln_v_b[j], w_s_a[j], b_s_a[j], w_o_a[j])
        else:
            mix = dilated_attention(x, w_qkv_b[j], w_o_b[j], pos)
        x = layer_norm(DEEPNORM_ALPHA * x + mix, ln_mix_g[i], ln_mix_b[i])
        x = layer_norm(DEEPNORM_ALPHA * x + swiglu(x, w_ffn_gu[i], w_ffn_down[i]), ln_ffn_g[i], ln_ffn_b[i])
        x = x + jax.nn.sigmoid(x @ w_ple_gate[i]) * (p[i] @ w_ple_proj[i])
    return x


def setup_inputs(seed: int = 0) -> dict:
    key = jax.random.key(seed)
    ks = jax.random.split(key, 24)
    f32 = jnp.float32

    def nrm(k, shape, scale):
        return jax.random.normal(k, shape, f32) * scale

    return {
        "x_prompt": nrm(ks[0], (BATCH, SEQ, D_MODEL), 1.0),
        "x_sample": nrm(ks[1], (DEC_BATCH, DEC_SEQ, D_MODEL), 1.0),
        "p_prompt": nrm(ks[2], (DEPTH, BATCH, SEQ, PLE_DIM), 1.0),
        "p_sample": nrm(ks[3], (DEPTH, DEC_BATCH, DEC_SEQ, PLE_DIM), 1.0),
        "w_in_a": nrm(ks[4], (N_A_LAYERS, D_MODEL, 2 * GMLP_WIDTH), D_MODEL ** -0.5),
        "ln_v_g": 1.0 + nrm(ks[5], (N_A_LAYERS, GMLP_WIDTH), 0.02),
        "ln_v_b": nrm(ks[6], (N_A_LAYERS, GMLP_WIDTH), 0.02),
        "w_s_a": nrm(ks[7], (N_A_LAYERS, GMLP_GROUPS, CHUNK, CHUNK), CHUNK ** -0.5),
        "b_s_a": 1.0 + nrm(ks[8], (N_A_LAYERS, GMLP_GROUPS, CHUNK), 0.01),
        "w_o_a": nrm(ks[9], (N_A_LAYERS, GMLP_WIDTH, D_MODEL), DEEPNORM_BETA * GMLP_WIDTH ** -0.5),
        "w_qkv_b": nrm(ks[10], (N_B_LAYERS, D_MODEL, N_DIL_GROUPS * 3 * ATTN_WIDTH), D_MODEL ** -0.5),
        "w_o_b": nrm(ks[11], (N_B_LAYERS, ATTN_WIDTH, D_MODEL), DEEPNORM_BETA * ATTN_WIDTH ** -0.5),
        "ln_mix_g": 1.0 + nrm(ks[12], (DEPTH, D_MODEL), 0.02),
        "ln_mix_b": nrm(ks[13], (DEPTH, D_MODEL), 0.02),
        "w_ffn_gu": nrm(ks[14], (DEPTH, D_MODEL, 2 * D_FF), D_MODEL ** -0.5),
        "w_ffn_down": nrm(ks[15], (DEPTH, D_FF, D_MODEL), DEEPNORM_BETA * D_FF ** -0.5),
        "ln_ffn_g": 1.0 + nrm(ks[16], (DEPTH, D_MODEL), 0.02),
        "ln_ffn_b": nrm(ks[17], (DEPTH, D_MODEL), 0.02),
        "w_ple_gate": nrm(ks[18], (DEPTH, D_MODEL, D_MODEL), D_MODEL ** -0.5),
        "w_ple_proj": nrm(ks[19], (DEPTH, PLE_DIM, D_MODEL), 0.5 * PLE_DIM ** -0.5),
    }


def reference(x_prompt, x_sample, p_prompt, p_sample, w_in_a, ln_v_g, ln_v_b, w_s_a, b_s_a,
              w_o_a, w_qkv_b, w_o_b, ln_mix_g, ln_mix_b, w_ffn_gu, w_ffn_down, ln_ffn_g,
              ln_ffn_b, w_ple_gate, w_ple_proj):
    y_prompt = trunk(x_prompt, p_prompt, w_in_a, ln_v_g, ln_v_b, w_s_a, b_s_a, w_o_a, w_qkv_b,
                     w_o_b, ln_mix_g, ln_mix_b, w_ffn_gu, w_ffn_down, ln_ffn_g, ln_ffn_b,
                     w_ple_gate, w_ple_proj)
    y_sample = trunk(x_sample, p_sample, w_in_a, ln_v_g, ln_v_b, w_s_a, b_s_a, w_o_a, w_qkv_b,
                     w_o_b, ln_mix_g, ln_mix_b, w_ffn_gu, w_ffn_down, ln_ffn_g, ln_ffn_b,
                     w_ple_gate, w_ple_proj)
    return (y_prompt, y_sample)
```

```cpp
#include <hip/hip_runtime.h>
#include <cstdio>
#include <cstdint>
namespace pg8 {
#define PG8_LAS __attribute__((address_space(3)))
typedef unsigned short bf16_t;
typedef short bf16x8 __attribute__((ext_vector_type(8)));
typedef float f32x4 __attribute__((ext_vector_type(4)));
typedef unsigned u32x4 __attribute__((ext_vector_type(4)));
constexpr int BM = 256, BK = 64, HALF = 128, HTB = HALF * BK * 2  , STAGE_BYTES = 8 * HTB, NXCD = 8, WGM = 8;

__host__ __device__ __forceinline__ int lds_byte(int r, int c) { const int st = (r >> 4) * 2 + (c >> 5), rr = r & 15, cc = c & 31, ob = rr * 64 + cc * 2; return st * 1024 + (ob ^ (((ob >> 9) & 1) << 5)); }
__host__ __device__ __forceinline__ void stage_rc(int b, int& R, int& C) { const int st = b / 1024, sb = b % 1024, swz = sb ^ (((sb >> 9) & 1) << 5); R = (st >> 1) * 16 + swz / 64; C = (st & 1) * 32 + (swz % 64) / 2; }
__host__ __device__ __forceinline__ int perm32(int rho) { const int n = rho >> 4, i = rho & 15; return 8 * (i >> 2) + 4 * n + (i & 3); }

struct Unit { int pm, pn; };
struct Gemm { const bf16_t* A; const bf16_t* Bt; int M, N, K; };

struct StaticOrder {
    int nM, nN, nwg, G, c;
    __host__ __device__ void init(int M, int N, int G_, int c_) { nM = M / BM; nN = N / BM; nwg = nM * nN; G = G_; c = c_; }
    __host__ __device__ bool next(int i, Unit& u) const {
        const long L = (long)i * G + c; if (L >= nwg) return false;
        int wgid = (int)L; { const int q = nwg / NXCD, r = nwg % NXCD, xcd = wgid % NXCD, off = wgid / NXCD; wgid = (xcd < r ? xcd * (q + 1) : r * (q + 1) + (xcd - r) * q) + off; }
        const int nig = WGM * nN, gid = wgid / nig, fm = gid * WGM, gsz = (nM - fm) < WGM ? (nM - fm) : WGM;
        u.pm = fm + ((wgid % nig) % gsz); u.pn = (wgid % nig) / gsz; return true;
    }
    __device__ __forceinline__ void a_ready(const Unit&) const {}
    __device__ __forceinline__ void done(const Unit&) const {}
};
__device__ __forceinline__ unsigned cvt_pk_bf16(float lo, float hi) { unsigned r; asm volatile("v_cvt_pk_bf16_f32 %0, %1, %2" : "=v"(r) : "v"(lo), "v"(hi)); return r; }
typedef float f32x2 __attribute__((ext_vector_type(2)));
__device__ __forceinline__ f32x2 gelu_pk(f32x2 v) {
    const f32x2 av = __builtin_elementwise_abs(v), d = av * 0.2316418882f + 1.0f;
    f32x2 t; t.x = __builtin_amdgcn_rcpf(d.x); t.y = __builtin_amdgcn_rcpf(d.y);
    f32x2 q = t * 0.5307027145f + (-0.7265760135f); q = q * t + 0.7107068705f; q = q * t + (-0.142248368f); q = q * t + 0.127414796f; q = q * t;
    const f32x2 s = (v * v) * (-0.72134752044f);
    f32x2 e; e.x = __builtin_amdgcn_exp2f(s.x); e.y = __builtin_amdgcn_exp2f(s.y);
    const f32x2 m = v * (q * e), r = v - m;
    f32x2 o; o.x = v.x < 0.f ? m.x : r.x; o.y = v.y < 0.f ? m.y : r.y; return o;
}

template <int ACT  > struct EpiBf16 {
    static constexpr bool PERM = true, AFTER_DRAIN = false; static_assert(ACT == 0 || ACT == 1, "EpiBf16: ACT is 0 (none) or 1 (gelu_pk)");
    bf16_t* O; int ldc; const float* bias; int split_cols; size_t split_stride; float scale0;
    __device__ __forceinline__ void operator()(const f32x4 (&acc)[2][2][4][2], const Unit& u, int wr, int wc, int fr, int fq) const {
        const int row0 = u.pm * BM + wr * 64 + fr; int colt = u.pn * BM; bf16_t* base = O;
        float sc = 1.f; if (split_cols) { const int t = colt / split_cols; base += (size_t)t * split_stride; colt -= t * split_cols; if (t == 0) sc = scale0; }
        const int col0 = colt + wc * 32 + 8 * fq, bcol0 = u.pn * BM + wc * 32 + 8 * fq;
        f32x4 bv[2][2];
#pragma unroll
        for (int bj = 0; bj < 2; ++bj)
#pragma unroll
            for (int n = 0; n < 2; ++n) bv[bj][n] = bias ? *(const f32x4*)(bias + bcol0 + bj * HALF + 4 * n) : (f32x4){0.f, 0.f, 0.f, 0.f};
#pragma unroll
        for (int ai = 0; ai < 2; ++ai)
#pragma unroll
            for (int m = 0; m < 4; ++m) { bf16_t* rowp = base + (size_t)(row0 + ai * HALF + m * 16) * ldc + col0;
#pragma unroll
                for (int bj = 0; bj < 2; ++bj) { f32x4 v0 = acc[ai][bj][m][0] + bv[bj][0], v1 = acc[ai][bj][m][1] + bv[bj][1];
                    if (ACT == 1) { f32x2 a = gelu_pk((f32x2){v0[0], v0[1]}), b = gelu_pk((f32x2){v0[2], v0[3]}), c = gelu_pk((f32x2){v1[0], v1[1]}), d = gelu_pk((f32x2){v1[2], v1[3]});
                        v0 = (f32x4){a.x, a.y, b.x, b.y}; v1 = (f32x4){c.x, c.y, d.x, d.y}; }
                    v0 = v0 * sc; v1 = v1 * sc; u32x4 w; w.x = cvt_pk_bf16(v0[0], v0[1]); w.y = cvt_pk_bf16(v0[2], v0[3]); w.z = cvt_pk_bf16(v1[0], v1[1]); w.w = cvt_pk_bf16(v1[2], v1[3]);
                    *(u32x4*)(rowp + bj * HALF) = w; } }
    }
};
}

constexpr int D = 2048, FF = 5632, NGU = 2 * FF, NQKV = 9216, AW = 1024, PLE = 256, HW = 4096;
constexpr int MG = 32768;
constexpr float LN_EPS = 1e-5f;
constexpr float ALPHA = 1.4142135623730951f;
constexpr float QSCALE = 0.08838834764831845f * 1.4426950408889634f;
constexpr float LN2 = 0.6931471805599453f;
constexpr int NWAVES = 8;

constexpr size_t MiB = 1u << 20;
constexpr size_t WS_CTL = 0, CTL_ZERO_BYTES = 65536;
constexpr size_t WS_ROT = 2 * MiB;
constexpr size_t WS_ST1 = 4 * MiB, WS_ST2 = 6 * MiB;
constexpr size_t WS_PART = 8 * MiB;
constexpr size_t WS_VEC = 16 * MiB;
constexpr size_t WS_W_IN = 17 * MiB, WS_W_OA = 33 * MiB, WS_W_S = 41 * MiB, WS_W_QKV = 42 * MiB, WS_W_OB = 78 * MiB;
constexpr size_t WS_W_GU = 82 * MiB, W_GU_STRIDE = 44 * MiB, WS_W_DN = 170 * MiB, W_DN_STRIDE = 22 * MiB;
constexpr size_t WS_W_GT = 214 * MiB, W_GT_STRIDE = 8 * MiB, WS_W_PJ = 230 * MiB, W_PJ_STRIDE = 1 * MiB;
constexpr size_t WS_XB = 232 * MiB;
constexpr size_t WS_BIG = 360 * MiB;
constexpr size_t BIG_H = 0, BIG_GATED = 256 * MiB, BIG_PB = 384 * MiB, BIG_XB2 = 384 * MiB, BIG_HB = 0, BIG_PP = 512 * MiB;
constexpr size_t BIG_QKV = 0, BIG_ATT = 576 * MiB, BIG_LSE = 640 * MiB;
constexpr size_t WS_END = WS_BIG + 643 * MiB;
constexpr int KB32 = 32;
constexpr size_t PART_GU = 0, PART_GU_L = (size_t)2 * KB32 * NGU, PART_GT = 2 * PART_GU_L, PART_GT_L = (size_t)2 * KB32 * D;
constexpr size_t VEC_GU = 0, VEC_GU_L = 2 * NGU, VEC_GT = 2 * VEC_GU_L, VEC_GT_L = 2 * D;
static_assert((PART_GT + 2 * PART_GT_L) * 4 <= 8 * MiB && (VEC_GT + 2 * VEC_GT_L) * 4 <= 1 * MiB, "partials");

constexpr int RING_BYTES = 131072;
constexpr int MISC_OFF = RING_BYTES + 320;
constexpr int STAB_OFF = RING_BYTES + 512;
constexpr int PTAB_OFF = STAB_OFF + 2048;
constexpr int LDS_BYTES = 147456;
static_assert(PTAB_OFF + 8192 <= LDS_BYTES, "LDS map");

#define GAS __attribute__((address_space(1)))
#define LAS __attribute__((address_space(3)))
typedef unsigned short bf16;
typedef unsigned v4u __attribute__((ext_vector_type(4)));
typedef unsigned v2u __attribute__((ext_vector_type(2)));
typedef float f32x4 __attribute__((ext_vector_type(4)));
typedef float f32x2v __attribute__((ext_vector_type(2)));
typedef short bf16x8 __attribute__((ext_vector_type(8)));
typedef short s16x4 __attribute__((ext_vector_type(4)));
#define LDS_WAIT() asm volatile("s_waitcnt lgkmcnt(0)" ::: "memory")
#define VM_WAIT() asm volatile("s_waitcnt vmcnt(0)" ::: "memory")
#define WG_BAR() do { asm volatile("s_waitcnt lgkmcnt(0)" ::: "memory"); __builtin_amdgcn_s_barrier(); asm volatile("" ::: "memory"); } while (0)

__device__ __forceinline__ unsigned f2bf(float f) { unsigned u = __builtin_bit_cast(unsigned, f); return (u + 0x7fffu + ((u >> 16) & 1u)) >> 16; }
__device__ __forceinline__ float bf_round(float f) { return __builtin_bit_cast(float, f2bf(f) << 16); }
__device__ __forceinline__ unsigned pk2(float lo, float hi) { return pg8::cvt_pk_bf16(lo, hi); }
__device__ __forceinline__ float bf_lo(unsigned w) { return __builtin_bit_cast(float, w << 16); }
__device__ __forceinline__ float bf_hi(unsigned w) { return __builtin_bit_cast(float, w & 0xffff0000u); }
__device__ __forceinline__ int opaque_tid() { int t = threadIdx.x; asm volatile("" : "+v"(t)); return t; }
__device__ __forceinline__ float wave_sum(float v) {
#pragma unroll
    for (int o = 1; o < 64; o <<= 1) v += __shfl_xor(v, o);
    return v;
}
__device__ __forceinline__ float fast_exp2(float x) { return __builtin_amdgcn_exp2f(x); }
__device__ __forceinline__ float fast_rcp(float x) { return __builtin_amdgcn_rcpf(x); }
__device__ __forceinline__ float sigmoidf_(float x) { return fast_rcp(1.0f + fast_exp2(-1.4426950408889634f * x)); }
__device__ __forceinline__ unsigned off_b(unsigned row, unsigned ch) { return 256u * row + 16u * (ch ^ (((row & 3u) << 2) | ((row >> 2) & 3u))); }
typedef short v4i16_t __attribute__((ext_vector_type(4)));
__device__ __forceinline__ s16x4 tr_read(LAS const unsigned char* p) { return __builtin_bit_cast(s16x4, __builtin_amdgcn_ds_read_tr16_b64_v4i16((LAS v4i16_t*)p)); }

namespace pg8 {
__device__ __forceinline__ void stab_from_partials(const float* st, int pm, PG8_LAS unsigned char* xl, float eps) {
    const int tid = opaque_tid();
    if (tid < 256) {
        const f32x4* p = (const f32x4*)(st + ((size_t)(pm * BM + tid)) * 16);
        const f32x4 a = p[0], b = p[1], c = p[2], d = p[3];
        const float S = ((a[0] + a[2]) + (b[0] + b[2])) + ((c[0] + c[2]) + (d[0] + d[2]));
        const float Q = ((a[1] + a[3]) + (b[1] + b[3])) + ((c[1] + c[3]) + (d[1] + d[3]));
        const float mean = S * (1.0f / 2048.0f); float var = Q * (1.0f / 2048.0f) - mean * mean; var = var < 0.f ? 0.f : var;
        ((PG8_LAS f32x2*)(xl + (STAB_OFF - RING_BYTES)))[tid] = (f32x2){mean, 1.0f / sqrtf(var + eps)};
    }
    asm volatile("s_waitcnt lgkmcnt(0)" ::: "memory"); __builtin_amdgcn_s_barrier(); asm volatile("" ::: "memory");
}
__device__ __forceinline__ void partials_to_st(float* st, const Unit& u, PG8_LAS unsigned char* xl) {
    asm volatile("s_waitcnt lgkmcnt(0)" ::: "memory"); __builtin_amdgcn_s_barrier(); asm volatile("" ::: "memory");
    const int tid = opaque_tid();
    if (tid < 256) {
        const PG8_LAS f32x4* P = (const PG8_LAS f32x4*)(xl + (PTAB_OFF - RING_BYTES)) + tid * 2;
        const f32x4 a = P[0], b = P[1];
        f32x2 o; o.x = (a[0] + a[2]) + (b[0] + b[2]); o.y = (a[1] + a[3]) + (b[1] + b[3]);
        *(f32x2*)(st + ((size_t)(u.pm * BM + tid) * 8 + u.pn) * 2) = o;
    }
}
struct LaneId { int wr, wc, fr, fq; };
__device__ __forceinline__ LaneId lane_id() { int t = threadIdx.x; asm volatile("" : "+v"(t)); const int wid = __builtin_amdgcn_readfirstlane(t >> 6), lane = t & 63; LaneId L; L.wr = wid >> 2; L.wc = wid & 3; L.fr = lane & 15; L.fq = lane >> 4; return L; }
#define PG8_ROWSUM(s, q, v) do { s += ((v)[0] + (v)[1]) + ((v)[2] + (v)[3]); q += ((v)[0] * (v)[0] + (v)[1] * (v)[1]) + ((v)[2] * (v)[2] + (v)[3] * (v)[3]); } while (0)

template <int ACT> struct EpiPlain {
    static constexpr bool PERM = true, AFTER_DRAIN = false;
    bf16_t* O; int ldc;
    __device__ __forceinline__ void operator()(const f32x4 (&acc)[2][2][4][2], const Unit& u, int, int, int, int) const {
        const LaneId L_ = lane_id(); const int wr = L_.wr, wc = L_.wc, fr = L_.fr, fq = L_.fq;
        const int row0 = u.pm * BM + wr * 64 + fr, col0 = u.pn * BM + wc * 32 + 8 * fq;
#pragma unroll
        for (int ai = 0; ai < 2; ++ai)
#pragma unroll
            for (int m = 0; m < 4; ++m) { bf16_t* rowp = O + (size_t)(row0 + ai * HALF + m * 16) * ldc + col0;
#pragma unroll
                for (int bj = 0; bj < 2; ++bj) { f32x4 v0 = acc[ai][bj][m][0], v1 = acc[ai][bj][m][1];
                    if (ACT == 1) { f32x2 a = gelu_pk((f32x2){v0[0], v0[1]}), b = gelu_pk((f32x2){v0[2], v0[3]}), c = gelu_pk((f32x2){v1[0], v1[1]}), d = gelu_pk((f32x2){v1[2], v1[3]});
                        v0 = (f32x4){a.x, a.y, b.x, b.y}; v1 = (f32x4){c.x, c.y, d.x, d.y}; }
                    u32x4 w; w.x = cvt_pk_bf16(v0[0], v0[1]); w.y = cvt_pk_bf16(v0[2], v0[3]); w.z = cvt_pk_bf16(v1[0], v1[1]); w.w = cvt_pk_bf16(v1[2], v1[3]);
                    *(u32x4*)(rowp + bj * HALF) = w; } }
    }
};
struct EpiQKV {
    static constexpr bool PERM = true, AFTER_DRAIN = false;
    bf16_t* O; const float* rot; int seq_mask; float qscale;
    __device__ __forceinline__ void operator()(const f32x4 (&acc)[2][2][4][2], const Unit& u, int, int, int, int) const {
        const LaneId L_ = lane_id(); const int wr = L_.wr, wc = L_.wc, fr = L_.fr, fq = L_.fq;
        const int colt = u.pn * BM, tsel = (colt % 3072) / 1024;
        const float sc = tsel == 0 ? qscale : 1.0f;
        const bool dorot = (tsel < 2) && (wc == 0);
        const int row0 = u.pm * BM + wr * 64 + fr, col0 = colt + wc * 32 + 8 * fq;
        const float sgn = fq < 2 ? -1.0f : 1.0f;
#pragma unroll
        for (int ai = 0; ai < 2; ++ai)
#pragma unroll
            for (int m = 0; m < 4; ++m) {
                const int row = row0 + ai * HALF + m * 16;
                f32x4 cs[2], sn[2];
                if (dorot) { const float* rp = rot + (size_t)(row & seq_mask) * 32 + 8 * (fq & 1);
                    cs[0] = *(const f32x4*)(rp); cs[1] = *(const f32x4*)(rp + 4); sn[0] = *(const f32x4*)(rp + 16); sn[1] = *(const f32x4*)(rp + 20); }
#pragma unroll
                for (int bj = 0; bj < 2; ++bj) {
                    f32x4 v[2] = {acc[ai][bj][m][0], acc[ai][bj][m][1]};
                    if (dorot) {
#pragma unroll
                        for (int n = 0; n < 2; ++n) { f32x4 pr;
#pragma unroll
                            for (int j = 0; j < 4; ++j) pr[j] = __shfl_xor(v[n][j], 32);
                            v[n] = v[n] * cs[n] + (pr * sn[n]) * sgn; }
                    }
                    v[0] = v[0] * sc; v[1] = v[1] * sc;
                    u32x4 w; w.x = cvt_pk_bf16(v[0][0], v[0][1]); w.y = cvt_pk_bf16(v[0][2], v[0][3]); w.z = cvt_pk_bf16(v[1][0], v[1][1]); w.w = cvt_pk_bf16(v[1][2], v[1][3]);
                    *(u32x4*)(O + (size_t)row * NQKV + col0 + bj * HALF) = w;
                }
            }
    }
};
struct EpiY1 {
    static constexpr bool PERM = true, AFTER_DRAIN = false;
    const float* xin; float* yout; bf16_t* yb; float* st; PG8_LAS unsigned char* xl; float alpha;
    __device__ __forceinline__ void operator()(const f32x4 (&acc)[2][2][4][2], const Unit& u, int, int, int, int) const {
        const LaneId L_ = lane_id(); const int wr = L_.wr, wc = L_.wc, fr = L_.fr, fq = L_.fq;
        const int row0 = u.pm * BM + wr * 64 + fr, col0 = u.pn * BM + wc * 32 + 8 * fq;
        PG8_LAS f32x2* P = (PG8_LAS f32x2*)(xl + (PTAB_OFF - RING_BYTES));
#pragma unroll
        for (int ai = 0; ai < 2; ++ai)
#pragma unroll
            for (int m = 0; m < 4; ++m) {
                const int rl = ai * HALF + wr * 64 + m * 16 + fr; const size_t off = (size_t)(row0 + ai * HALF + m * 16) * D + col0;
                float s = 0.f, q = 0.f;
#pragma unroll
                for (int bj = 0; bj < 2; ++bj) {
                    const f32x4 x0 = *(const f32x4*)(xin + off + bj * HALF), x1 = *(const f32x4*)(xin + off + bj * HALF + 4);
                    const f32x4 y0 = x0 * alpha + acc[ai][bj][m][0], y1 = x1 * alpha + acc[ai][bj][m][1];
                    *(f32x4*)(yout + off + bj * HALF) = y0; *(f32x4*)(yout + off + bj * HALF + 4) = y1;
                    u32x4 w; w.x = cvt_pk_bf16(y0[0], y0[1]); w.y = cvt_pk_bf16(y0[2], y0[3]); w.z = cvt_pk_bf16(y1[0], y1[1]); w.w = cvt_pk_bf16(y1[2], y1[3]);
                    *(u32x4*)(yb + off + bj * HALF) = w;
                    PG8_ROWSUM(s, q, y0); PG8_ROWSUM(s, q, y1);
                }
                s += __shfl_xor(s, 16); q += __shfl_xor(q, 16); s += __shfl_xor(s, 32); q += __shfl_xor(q, 32);
                if (fq == 0) P[rl * 4 + wc] = (f32x2){s, q};
                asm volatile("" ::: "memory");
            }
        partials_to_st(st, u, xl);
    }
};
struct EpiGU {
    static constexpr bool PERM = true, AFTER_DRAIN = false;
    const float* st; const float* cs; const float* bw; bf16_t* H; PG8_LAS unsigned char* xl; float eps;
    __device__ __forceinline__ void operator()(const f32x4 (&acc)[2][2][4][2], const Unit& u, int, int, int, int) const {
        const LaneId L_ = lane_id(); const int wr = L_.wr, wc = L_.wc, fr = L_.fr, fq = L_.fq;
        stab_from_partials(st, u.pm, xl, eps);
        const PG8_LAS f32x2* S = (const PG8_LAS f32x2*)(xl + (STAB_OFF - RING_BYTES));
        const int row0 = u.pm * BM + wr * 64 + fr, col0 = u.pn * BM + wc * 32 + 8 * fq, hcol0 = u.pn * HALF + wc * 32 + 8 * fq;
        f32x4 csv[2][2], bwv[2][2];
#pragma unroll
        for (int bj = 0; bj < 2; ++bj)
#pragma unroll
            for (int n = 0; n < 2; ++n) { csv[bj][n] = *(const f32x4*)(cs + col0 + bj * HALF + 4 * n); bwv[bj][n] = *(const f32x4*)(bw + col0 + bj * HALF + 4 * n); }
#pragma unroll
        for (int ai = 0; ai < 2; ++ai)
#pragma unroll
            for (int m = 0; m < 4; ++m) {
                const int rl = ai * HALF + wr * 64 + m * 16 + fr; const f32x2 sr = S[rl];
                f32x4 h[2];
#pragma unroll
                for (int n = 0; n < 2; ++n) {
                    const f32x4 g = (acc[ai][0][m][n] - csv[0][n] * sr.x) * sr.y + bwv[0][n];
                    const f32x4 uu = (acc[ai][1][m][n] - csv[1][n] * sr.x) * sr.y + bwv[1][n];
#pragma unroll
                    for (int j = 0; j < 4; ++j) h[n][j] = g[j] * __builtin_amdgcn_rcpf(1.0f + __builtin_amdgcn_exp2f(-1.4426950408889634f * g[j])) * uu[j];
                }
                u32x4 w; w.x = cvt_pk_bf16(h[0][0], h[0][1]); w.y = cvt_pk_bf16(h[0][2], h[0][3]); w.z = cvt_pk_bf16(h[1][0], h[1][1]); w.w = cvt_pk_bf16(h[1][2], h[1][3]);
                *(u32x4*)(H + (size_t)(row0 + ai * HALF + m * 16) * FF + hcol0) = w;
            }
    }
};
struct EpiY2 {
    static constexpr bool PERM = true, AFTER_DRAIN = false;
    float* y; bf16_t* yb; const float* st1; float* st2; const float* lng; const float* lnb; PG8_LAS unsigned char* xl; float alpha, eps;
    __device__ __forceinline__ void operator()(const f32x4 (&acc)[2][2][4][2], const Unit& u, int, int, int, int) const {
        const LaneId L_ = lane_id(); const int wr = L_.wr, wc = L_.wc, fr = L_.fr, fq = L_.fq;
        stab_from_partials(st1, u.pm, xl, eps);
        const PG8_LAS f32x2* S = (const PG8_LAS f32x2*)(xl + (STAB_OFF - RING_BYTES));
        PG8_LAS f32x2* P = (PG8_LAS f32x2*)(xl + (PTAB_OFF - RING_BYTES));
        const int row0 = u.pm * BM + wr * 64 + fr, col0 = u.pn * BM + wc * 32 + 8 * fq;
        f32x4 gv[2][2], bv[2][2];
#pragma unroll
        for (int bj = 0; bj < 2; ++bj)
#pragma unroll
            for (int n = 0; n < 2; ++n) { gv[bj][n] = *(const f32x4*)(lng + col0 + bj * HALF + 4 * n); bv[bj][n] = *(const f32x4*)(lnb + col0 + bj * HALF + 4 * n); }
#pragma unroll
        for (int ai = 0; ai < 2; ++ai)
#pragma unroll
            for (int m = 0; m < 4; ++m) {
                const int rl = ai * HALF + wr * 64 + m * 16 + fr; const size_t off = (size_t)(row0 + ai * HALF + m * 16) * D + col0; const f32x2 sr = S[rl];
                float s = 0.f, q = 0.f;
#pragma unroll
                for (int bj = 0; bj < 2; ++bj) {
                    const f32x4 a0 = *(const f32x4*)(y + off + bj * HALF), a1 = *(const f32x4*)(y + off + bj * HALF + 4);
                    const f32x4 x0 = ((a0 - sr.x) * sr.y) * gv[bj][0] + bv[bj][0], x1 = ((a1 - sr.x) * sr.y) * gv[bj][1] + bv[bj][1];
                    const f32x4 y0 = x0 * alpha + acc[ai][bj][m][0], y1 = x1 * alpha + acc[ai][bj][m][1];
                    *(f32x4*)(y + off + bj * HALF) = y0; *(f32x4*)(y + off + bj * HALF + 4) = y1;
                    u32x4 w; w.x = cvt_pk_bf16(y0[0], y0[1]); w.y = cvt_pk_bf16(y0[2], y0[3]); w.z = cvt_pk_bf16(y1[0], y1[1]); w.w = cvt_pk_bf16(y1[2], y1[3]);
                    *(u32x4*)(yb + off + bj * HALF) = w;
                    PG8_ROWSUM(s, q, y0); PG8_ROWSUM(s, q, y1);
                }
                s += __shfl_xor(s, 16); q += __shfl_xor(q, 16); s += __shfl_xor(s, 32); q += __shfl_xor(q, 32);
                if (fq == 0) P[rl * 4 + wc] = (f32x2){s, q};
                asm volatile("" ::: "memory");
            }
        partials_to_st(st2, u, xl);
    }
};
struct EpiPLE {
    static constexpr bool PERM = true, AFTER_DRAIN = false;
    float* y; bf16_t* xb; const bf16_t* pp; const float* st2; const float* lng; const float* lnb; const float* cs; const float* bw; PG8_LAS unsigned char* xl; float eps;
    __device__ __forceinline__ void operator()(const f32x4 (&acc)[2][2][4][2], const Unit& u, int, int, int, int) const {
        const LaneId L_ = lane_id(); const int wr = L_.wr, wc = L_.wc, fr = L_.fr, fq = L_.fq;
        stab_from_partials(st2, u.pm, xl, eps);
        const PG8_LAS f32x2* S = (const PG8_LAS f32x2*)(xl + (STAB_OFF - RING_BYTES));
        const int row0 = u.pm * BM + wr * 64 + fr, col0 = u.pn * BM + wc * 32 + 8 * fq;
#pragma unroll
        for (int bj = 0; bj < 2; ++bj) {
            f32x4 gv[2], bv[2], csv[2], bwv[2];
#pragma unroll
            for (int n = 0; n < 2; ++n) { const int c = col0 + bj * HALF + 4 * n; gv[n] = *(const f32x4*)(lng + c); bv[n] = *(const f32x4*)(lnb + c); csv[n] = *(const f32x4*)(cs + c); bwv[n] = *(const f32x4*)(bw + c); }
#pragma unroll
            for (int ai = 0; ai < 2; ++ai)
#pragma unroll
                for (int m = 0; m < 4; ++m) {
                    const int rl = ai * HALF + wr * 64 + m * 16 + fr; const size_t off = (size_t)(row0 + ai * HALF + m * 16) * D + col0 + bj * HALF; const f32x2 sr = S[rl];
                    const f32x4 a0 = *(const f32x4*)(y + off), a1 = *(const f32x4*)(y + off + 4);
                    const u32x4 pw = *(const u32x4*)(pp + off);
                    f32x4 p0, p1; p0[0] = bf_lo(pw.x); p0[1] = bf_hi(pw.x); p0[2] = bf_lo(pw.y); p0[3] = bf_hi(pw.y); p1[0] = bf_lo(pw.z); p1[1] = bf_hi(pw.z); p1[2] = bf_lo(pw.w); p1[3] = bf_hi(pw.w);
                    const f32x4 x0 = ((a0 - sr.x) * sr.y) * gv[0] + bv[0], x1 = ((a1 - sr.x) * sr.y) * gv[1] + bv[1];
                    const f32x4 t0 = (acc[ai][bj][m][0] - csv[0] * sr.x) * sr.y + bwv[0], t1 = (acc[ai][bj][m][1] - csv[1] * sr.x) * sr.y + bwv[1];
                    f32x4 o0, o1;
#pragma unroll
                    for (int j = 0; j < 4; ++j) { o0[j] = x0[j] + sigmoidf_(t0[j]) * p0[j]; o1[j] = x1[j] + sigmoidf_(t1[j]) * p1[j]; }
                    *(f32x4*)(y + off) = o0; *(f32x4*)(y + off + 4) = o1;
                    if (xb) { u32x4 w; w.x = cvt_pk_bf16(o0[0], o0[1]); w.y = cvt_pk_bf16(o0[2], o0[3]); w.z = cvt_pk_bf16(o1[0], o1[1]); w.w = cvt_pk_bf16(o1[2], o1[3]); *(u32x4*)(xb + off) = w; }
                    asm volatile("" ::: "memory");
                }
        }
    }
};
}
namespace pg8 {
template <class Epi, class Sched, bool ALIGN_EPI = false, bool SP2 = false>
__device__ __forceinline__ void gemm_phase(PG8_LAS unsigned char* lds, const Gemm g, const Sched& S, const Epi& E) {
    int tid_ = threadIdx.x; asm volatile("" : "+v"(tid_)); const int tid = tid_, wid = __builtin_amdgcn_readfirstlane(tid >> 6), lane = tid & 63, wr = wid >> 2, wc = wid & 3, fr = lane & 15, fq = lane >> 4;
    const int K = g.K, nt = K / BK;
    unsigned voffA[2], voffB[2];
#pragma unroll
    for (int i = 0; i < 2; ++i) { int R, C; stage_rc(tid * 16 + i * 8192, R, C); const int Rb = Epi::PERM ? ((R & ~31) + perm32(R & 31)) : R;
        voffA[i] = (unsigned)(R * K + C) * 2u; voffB[i] = (unsigned)(Rb * K + C) * 2u; }
    const size_t kstep = (size_t)(BK * 2);
    const size_t hstep = (size_t)HALF * K * 2;
    const size_t tstep = 2 * hstep;
    const unsigned ldsw = (unsigned)wid * 1024u;
    const int aoff = lds_byte(wr * 64 + fr, fq * 8), boff = lds_byte(wc * 32 + fr, fq * 8);
#define PG8_SA(b, h) (((b) * 2 + (h)) * HTB)
#define PG8_SB(b, h) ((4 + (b) * 2 + (h)) * HTB)
#define PG8_STAGE(bufoff, gbase, voff) do { _Pragma("unroll") for (int _i = 0; _i < 2; ++_i) \
        __builtin_amdgcn_global_load_lds((const unsigned*)((const char*)(gbase) + (voff)[_i]), (PG8_LAS unsigned*)(lds + (bufoff) + ldsw + _i * 8192), 16, 0, 0); } while (0)
#define PG8_LDA(dst, b, h) do { _Pragma("unroll") for (int m = 0; m < 4; ++m) _Pragma("unroll") for (int k = 0; k < 2; ++k) dst[m][k] = *(const PG8_LAS bf16x8*)(lds + PG8_SA(b, h) + aoff + m * 2048 + k * 1024); } while (0)
#define PG8_LDB(dst, b, h) do { _Pragma("unroll") for (int n = 0; n < 2; ++n) _Pragma("unroll") for (int k = 0; k < 2; ++k) dst[n][k] = *(const PG8_LAS bf16x8*)(lds + PG8_SB(b, h) + boff + n * 2048 + k * 1024); } while (0)
#define PG8_MMA(ai, bj, At, Bt) do { __builtin_amdgcn_s_setprio(1); _Pragma("unroll") for (int m = 0; m < 4; ++m) _Pragma("unroll") for (int n = 0; n < 2; ++n) _Pragma("unroll") for (int k = 0; k < 2; ++k) \
        acc[ai][bj][m][n] = __builtin_amdgcn_mfma_f32_16x16x32_bf16(Bt[n][k], At[m][k], acc[ai][bj][m][n], 0, 0, 0); __builtin_amdgcn_s_setprio(0); } while (0)
#define PG8_WAIT_V(n) asm volatile("s_waitcnt vmcnt(" #n ")" ::: "memory")
#define PG8_WAIT_L(n) asm volatile("s_waitcnt lgkmcnt(" #n ")" ::: "memory")
#define PG8_BAR __builtin_amdgcn_s_barrier()
#define PG8_SCHED __builtin_amdgcn_sched_barrier(0)
    Unit cur, nxt; int ui = 0;
    if (!S.next(0, cur)) return;
    f32x4 acc[2][2][4][2];
#pragma unroll
    for (int a = 0; a < 2; ++a)
#pragma unroll
        for (int b = 0; b < 2; ++b)
#pragma unroll
            for (int m = 0; m < 4; ++m)
#pragma unroll
                for (int n = 0; n < 2; ++n) acc[a][b][m][n] = (f32x4){0.f, 0.f, 0.f, 0.f};
    bf16x8 At[4][2], B0[2][2], B1[2][2];
    const char* cA = (const char*)g.A + (size_t)cur.pm * tstep; const char* cB = (const char*)g.Bt + (size_t)cur.pn * tstep;
    S.a_ready(cur);
    if constexpr (SP2) {
        PG8_STAGE(PG8_SB(0, 0), cB, voffB); PG8_STAGE(PG8_SB(0, 1), cB + hstep, voffB); PG8_STAGE(PG8_SA(0, 0), cA, voffA); PG8_STAGE(PG8_SA(0, 1), cA + hstep, voffA);
        if (wr == 1) PG8_BAR;
        PG8_WAIT_V(2); PG8_BAR;
        PG8_STAGE(PG8_SB(1, 0), cB + kstep, voffB); PG8_STAGE(PG8_SA(1, 0), cA + kstep, voffA); PG8_STAGE(PG8_SB(1, 1), cB + hstep + kstep, voffB);
        PG8_WAIT_V(6); PG8_BAR;
    } else {
        PG8_STAGE(PG8_SB(0, 0), cB, voffB); PG8_STAGE(PG8_SA(0, 0), cA, voffA); PG8_STAGE(PG8_SB(0, 1), cB + hstep, voffB); PG8_STAGE(PG8_SA(0, 1), cA + hstep, voffA);
        if (wr == 1) PG8_BAR;
        PG8_WAIT_V(4); PG8_BAR;
        PG8_STAGE(PG8_SB(1, 0), cB + kstep, voffB); PG8_STAGE(PG8_SA(1, 0), cA + kstep, voffA); PG8_STAGE(PG8_SB(1, 1), cB + hstep + kstep, voffB);
        PG8_WAIT_V(6); PG8_BAR;
    }
    for (;;) {
        const bool has_next = S.next(ui + 1, nxt);
        const char* nA = has_next ? (const char*)g.A + (size_t)nxt.pm * tstep : cA; const char* nB = has_next ? (const char*)g.Bt + (size_t)nxt.pn * tstep : cB;
        for (int t = 0; t < nt; t += 2) {
            const bool last = (t == nt - 2);
            const char* a1 = cA + (size_t)(t + 1) * kstep;
            const char* a2 = last ? nA : cA + (size_t)(t + 2) * kstep; const char* b2 = last ? nB : cB + (size_t)(t + 2) * kstep;
            const char* a3 = a2 + kstep; const char* b3 = b2 + kstep;
            if (last && has_next) S.a_ready(nxt);
            if constexpr (SP2) {
            PG8_LDB(B0, 0, 0); PG8_LDB(B1, 0, 1); PG8_SCHED; PG8_LDA(At, 0, 0); PG8_STAGE(PG8_SA(1, 1), a1 + hstep, voffA);
            PG8_WAIT_V(8); PG8_WAIT_L(0); PG8_BAR; PG8_MMA(0, 0, At, B0); PG8_MMA(0, 1, At, B1); PG8_BAR; PG8_SCHED;
            PG8_LDA(At, 0, 1); PG8_STAGE(PG8_SB(0, 0), b2, voffB); PG8_STAGE(PG8_SB(0, 1), b2 + hstep, voffB); PG8_STAGE(PG8_SA(0, 0), a2, voffA);
            PG8_WAIT_V(8); PG8_WAIT_L(0); PG8_BAR; PG8_MMA(1, 0, At, B0); PG8_MMA(1, 1, At, B1); PG8_BAR; PG8_SCHED;
            PG8_LDB(B0, 1, 0); PG8_LDB(B1, 1, 1); PG8_SCHED; PG8_LDA(At, 1, 0); PG8_STAGE(PG8_SA(0, 1), a2 + hstep, voffA);
            PG8_WAIT_V(8); PG8_WAIT_L(0); PG8_BAR; PG8_MMA(0, 0, At, B0); PG8_MMA(0, 1, At, B1); PG8_BAR; PG8_SCHED;
            PG8_LDA(At, 1, 1); PG8_STAGE(PG8_SB(1, 0), b3, voffB); PG8_STAGE(PG8_SB(1, 1), b3 + hstep, voffB); PG8_STAGE(PG8_SA(1, 0), a3, voffA);
            PG8_WAIT_V(8); PG8_WAIT_L(0); PG8_BAR; PG8_MMA(1, 0, At, B0); PG8_MMA(1, 1, At, B1); PG8_BAR; PG8_SCHED;
            } else {
            PG8_LDB(B0, 0, 0); PG8_SCHED; PG8_LDA(At, 0, 0); PG8_STAGE(PG8_SA(1, 1), a1 + hstep, voffA);
            PG8_WAIT_L(8); PG8_BAR; PG8_WAIT_L(0); PG8_MMA(0, 0, At, B0); PG8_BAR; PG8_SCHED;
            PG8_LDB(B1, 0, 1); PG8_STAGE(PG8_SB(0, 0), b2, voffB);
            PG8_BAR; PG8_WAIT_L(0); PG8_MMA(0, 1, At, B1); PG8_BAR;
            PG8_LDA(At, 0, 1); PG8_STAGE(PG8_SA(0, 0), a2, voffA);
            PG8_BAR; PG8_WAIT_L(0); PG8_MMA(1, 0, At, B0); PG8_BAR; PG8_SCHED;
            PG8_STAGE(PG8_SB(0, 1), b2 + hstep, voffB);
            PG8_WAIT_V(6); PG8_BAR; PG8_MMA(1, 1, At, B1); PG8_BAR;
            PG8_LDB(B0, 1, 0); PG8_SCHED; PG8_LDA(At, 1, 0); PG8_STAGE(PG8_SA(0, 1), a2 + hstep, voffA);
            PG8_WAIT_L(8); PG8_BAR; PG8_WAIT_L(0); PG8_MMA(0, 0, At, B0); PG8_BAR; PG8_SCHED;
            PG8_LDB(B1, 1, 1); PG8_STAGE(PG8_SB(1, 0), b3, voffB);
            PG8_BAR; PG8_WAIT_L(0); PG8_MMA(0, 1, At, B1); PG8_BAR;
            PG8_LDA(At, 1, 1); PG8_STAGE(PG8_SA(1, 0), a3, voffA);
            PG8_BAR; PG8_WAIT_L(0); PG8_MMA(1, 0, At, B0); PG8_BAR; PG8_SCHED;
            PG8_STAGE(PG8_SB(1, 1), b3 + hstep, voffB);
            PG8_WAIT_V(6); PG8_BAR; PG8_MMA(1, 1, At, B1); PG8_BAR;
            }
        }
        if constexpr (ALIGN_EPI) { if (wr == 0) PG8_BAR; }
        if constexpr (!Epi::AFTER_DRAIN) { E(acc, cur, wr, wc, fr, fq); S.done(cur); }
        if (!has_next) break;
#pragma unroll
        for (int a = 0; a < 2; ++a)
#pragma unroll
            for (int b = 0; b < 2; ++b)
#pragma unroll
                for (int m = 0; m < 4; ++m)
#pragma unroll
                    for (int n = 0; n < 2; ++n) acc[a][b][m][n] = (f32x4){0.f, 0.f, 0.f, 0.f};
        cur = nxt; cA = nA; cB = nB; ++ui;
        if constexpr (ALIGN_EPI) { if (wr == 1) PG8_BAR; }
    }
    PG8_WAIT_V(0);
    if constexpr (!ALIGN_EPI) { if (wr == 0) PG8_BAR; }
    PG8_BAR;
    if constexpr (Epi::AFTER_DRAIN) { E.fused(acc, cur, wr, wc, fr, fq, lds, wid, lane); S.done(cur); }
#undef PG8_SA
#undef PG8_SB
#undef PG8_STAGE
#undef PG8_LDA
#undef PG8_LDB
#undef PG8_MMA
#undef PG8_WAIT_V
#undef PG8_WAIT_L
#undef PG8_BAR
#undef PG8_SCHED
}
}
#define XB_TMO      128
#define XB_XCNT(j)  (256  + 64 * (j))
#define XB_XSUB(j)  (1280 + 64 * (j))
#define XB_XGEN(j)  (2304 + 64 * (j))
#define XB_TOP      3328
#define XB_TOPGEN   3392
#define XCD_BAR_WORDS 3456
#define XB_SPIN_CAP (1u << 18)

__device__ __forceinline__ unsigned xb_ld(unsigned* p)              { return __hip_atomic_load(p, __ATOMIC_RELAXED, __HIP_MEMORY_SCOPE_AGENT); }
__device__ __forceinline__ unsigned xb_add(unsigned* p, unsigned v) { return __hip_atomic_fetch_add(p, v, __ATOMIC_RELAXED, __HIP_MEMORY_SCOPE_AGENT); }
__device__ __forceinline__ unsigned xb_xcc_id() { return (unsigned)__builtin_amdgcn_s_getreg((3 << 11) | 20) & 0xFu; }
#define XB_SPIN(cond, bar) do { unsigned _sp = 0; while (cond) { __builtin_amdgcn_s_sleep(1); \
    if ((++_sp & 255u) == 0u) { if (xb_ld(&(bar)[XB_TMO])) break; if (_sp > XB_SPIN_CAP) { atomicAdd(&(bar)[XB_TMO], 1u); break; } } } } while (0)

struct XcdBarrier {
    unsigned* bar; unsigned x;
    volatile LAS unsigned* st;
};

__device__ __forceinline__ XcdBarrier xcd_barrier_post(unsigned* bar, volatile LAS unsigned* st) {
    XcdBarrier b; b.bar = bar; b.x = xb_xcc_id(); b.st = st;
    if (threadIdx.x == 0) (void)xb_add(&bar[XB_XCNT(b.x)], 1u);
    return b;
}
__device__ __forceinline__ void xcd_barrier_complete(unsigned* bar, unsigned x, unsigned& nloc, unsigned& nx) {
    const unsigned G = gridDim.x * gridDim.y * gridDim.z;
    unsigned sum, cnt, mine, sp = 0u;
    for (;;) {
        sum = 0u; cnt = 0u; mine = 0u;
#pragma unroll
        for (unsigned j = 0; j < 16; ++j) { const unsigned c = xb_ld(&bar[XB_XCNT(j)]); sum += c; cnt += (c > 0u) ? 1u : 0u; mine = (j == x) ? c : mine; }
        if (sum == G) break;
        __builtin_amdgcn_s_sleep(1);
        if ((++sp & 255u) == 0u) { if (xb_ld(&bar[XB_TMO])) break; if (sp > XB_SPIN_CAP) { atomicAdd(&bar[XB_TMO], 1u); break; } }
    }
    nloc = mine > 0u ? mine : 1u; nx = cnt > 0u ? cnt : 1u;
}

__device__ __forceinline__ void xcd_barrier(const XcdBarrier& b) {
    asm volatile("s_waitcnt vmcnt(0)" ::: "memory");
    __syncthreads();
    if (threadIdx.x == 0) {
        unsigned* bar = b.bar;
        __builtin_amdgcn_s_waitcnt(0);
        unsigned nloc = b.st[0], nx = b.st[1];
        if (nloc == 0u) { xcd_barrier_complete(bar, b.x, nloc, nx); b.st[0] = nloc; b.st[1] = nx; }
        const unsigned old = xb_add(&bar[XB_XSUB(b.x)], 1u);
        const unsigned gen = old / nloc;
        if (old + 1u == (gen + 1u) * nloc) {
            __builtin_amdgcn_fence(__ATOMIC_RELEASE, "agent");
            asm volatile("s_waitcnt vmcnt(0)" ::: "memory");
            const unsigned og = xb_add(&bar[XB_TOP], 1u);
            const unsigned tg = og / nx;
            if (og + 1u == (tg + 1u) * nx) xb_add(&bar[XB_TOPGEN], 1u);
            else XB_SPIN(xb_ld(&bar[XB_TOPGEN]) == tg, bar);
            __builtin_amdgcn_fence(__ATOMIC_ACQUIRE, "agent");
            xb_add(&bar[XB_XGEN(b.x)], 1u);
            asm volatile("s_waitcnt vmcnt(0)" ::: "memory");
        } else {
            XB_SPIN(xb_ld(&bar[XB_XGEN(b.x)]) == gen, bar);
            __builtin_amdgcn_fence(__ATOMIC_ACQUIRE, "agent");
            asm volatile("s_waitcnt vmcnt(0)" ::: "memory");
        }
    }
    __syncthreads();
}

__device__ const float kInvFreq[16] = {1.000000000e+00f, 4.403665960e-01f, 1.939227432e-01f, 8.539710194e-02f, 3.760603070e-02f, 1.656044088e-02f, 7.292664610e-03f, 3.211446106e-03f,
                                       1.414213562e-03f, 6.227724371e-04f, 2.742481884e-04f, 1.207697351e-04f, 5.318295734e-05f, 2.341999971e-05f, 1.031338525e-05f, 4.541670478e-06f};

__device__ __forceinline__ void sincos_f64(float angf, float& so, float& co) {
    const double a = (double)angf;
    const double k = __builtin_rint(a * 0.63661977236758134308);
    const double r = __builtin_fma(-k, 6.123233995736766e-17, __builtin_fma(-k, 1.5707963267948966, a));
    const double r2 = r * r;
    double s = -7.6471637318198164759e-13; s = s * r2 + 1.6059043836821614599e-10; s = s * r2 - 2.5052108385441718775e-8; s = s * r2 + 2.7557319223985890653e-6;
    s = s * r2 - 1.9841269841269841270e-4; s = s * r2 + 8.3333333333333333333e-3; s = s * r2 - 1.6666666666666666667e-1; s = s * r2 * r + r;
    double c = 4.7794773323873852974e-14; c = c * r2 - 1.1470745597729724714e-11; c = c * r2 + 2.0876756987868098979e-9; c = c * r2 - 2.7557319223985890653e-7;
    c = c * r2 + 2.4801587301587301587e-5; c = c * r2 - 1.3888888888888888889e-3; c = c * r2 + 4.1666666666666666667e-2; c = c * r2 - 0.5; c = c * r2 + 1.0;
    const int q = (int)((long long)k & 3);
    const double sv = (q == 0) ? s : (q == 1) ? c : (q == 2) ? -s : -c;
    const double cv = (q == 0) ? c : (q == 1) ? -s : (q == 2) ? -c : s;
    so = (float)sv; co = (float)cv;
}

struct TJob { const float* W; int K, N; bf16* WT; int mode; const float* g; const float* b; float* pcs; float* pbw; };
__device__ __forceinline__ void tr_item(const TJob& J, LAS float* scr, int item, int lane) {
    const int nblk = J.N / 32, kb = item / nblk, nb = item - kb * nblk, k0 = 64 * kb, n0 = 32 * nb;
#pragma unroll 8
    for (int i = 0; i < 32; ++i) { const int kk = 2 * i + (lane >> 5); scr[kk * 33 + (lane & 31)] = J.W[(size_t)(k0 + kk) * J.N + n0 + (lane & 31)]; }
    LDS_WAIT(); asm volatile("" ::: "memory");
    int drow0 = n0;
    if (J.mode == 2) { const int isup = n0 >= FF ? 1 : 0, hc = n0 - isup * FF; drow0 = 256 * (hc >> 7) + 128 * isup + (hc & 127); }
    const int c = lane & 7;
    float gk[8];
#pragma unroll
    for (int j = 0; j < 8; ++j) gk[j] = J.mode ? J.g[k0 + 8 * c + j] : 1.0f;
#pragma unroll
    for (int j = 0; j < 4; ++j) { const int n = (lane >> 3) + 8 * j; const LAS float* s = scr + (8 * c) * 33 + n;
        v4u o; o.x = pk2(s[0 * 33] * gk[0], s[1 * 33] * gk[1]); o.y = pk2(s[2 * 33] * gk[2], s[3 * 33] * gk[3]); o.z = pk2(s[4 * 33] * gk[4], s[5 * 33] * gk[5]); o.w = pk2(s[6 * 33] * gk[6], s[7 * 33] * gk[7]);
        *(GAS v4u*)(J.WT + (size_t)(drow0 + n) * J.K + k0 + 8 * c) = o; }
    if (J.mode) {
        float cs = 0.f, bw = 0.f; const int kh = (lane >> 5) * 32;
#pragma unroll 8
        for (int t = 0; t < 32; ++t) { const int kk = kh + t; const float w = scr[kk * 33 + (lane & 31)]; cs += bf_round(w * J.g[k0 + kk]); bw += w * J.b[k0 + kk]; }
        cs += __shfl_xor(cs, 32); bw += __shfl_xor(bw, 32);
        if (lane < 32) { J.pcs[(size_t)kb * J.N + drow0 + lane] = cs; J.pbw[(size_t)kb * J.N + drow0 + lane] = bw; }
    }
    LDS_WAIT(); asm volatile("" ::: "memory");
}

struct Args { const float* in[20]; float* out; unsigned char* ws; int ph_lo, ph_hi; };
#define CAS __attribute__((address_space(4)))
__device__ __forceinline__ const unsigned char CAS* kargs_() { const unsigned char CAS* p = (const unsigned char CAS*)__builtin_amdgcn_kernarg_segment_ptr(); asm volatile("" : "+s"(p)); return p; }
__device__ __forceinline__ const float* arg_in(int i) { return (const float*)(const GAS float*)*(const float* const CAS*)(kargs_() + 8 * i); }
__device__ __forceinline__ float* arg_out() { return (float*)(GAS float*)*(float* const CAS*)(kargs_() + 160); }
__device__ __forceinline__ unsigned char* arg_ws() { return (unsigned char*)(GAS unsigned char*)*(unsigned char* const CAS*)(kargs_() + 168); }
static_assert(sizeof(Args) == 184, "Args layout");

__device__ __forceinline__ TJob make_job(int id) {
    unsigned char* ws = arg_ws(); float* part = (float*)(ws + WS_PART);
    TJob J; J.mode = 0; J.g = nullptr; J.b = nullptr; J.pcs = nullptr; J.pbw = nullptr;
    switch (id) {
    case 0: J.W = arg_in(4); J.K = D; J.N = HW; J.WT = (bf16*)(ws + WS_W_IN); break;
    case 1: J.W = arg_in(9); J.K = D; J.N = D; J.WT = (bf16*)(ws + WS_W_OA); break;
    case 2: J.W = arg_in(10); J.K = D; J.N = NQKV; J.WT = (bf16*)(ws + WS_W_QKV); break;
    case 3: J.W = arg_in(11); J.K = AW; J.N = D; J.WT = (bf16*)(ws + WS_W_OB); break;
    case 4: case 5: { const int l = id - 4; J.W = arg_in(14) + (size_t)l * D * NGU; J.K = D; J.N = NGU; J.WT = (bf16*)(ws + WS_W_GU + l * W_GU_STRIDE); J.mode = 2;
        J.g = arg_in(12) + l * D; J.b = arg_in(13) + l * D; J.pcs = part + PART_GU + l * PART_GU_L; J.pbw = J.pcs + (size_t)KB32 * NGU; break; }
    case 6: case 7: { const int l = id - 6; J.W = arg_in(15) + (size_t)l * FF * D; J.K = FF; J.N = D; J.WT = (bf16*)(ws + WS_W_DN + l * W_DN_STRIDE); break; }
    case 8: case 9: { const int l = id - 8; J.W = arg_in(18) + (size_t)l * D * D; J.K = D; J.N = D; J.WT = (bf16*)(ws + WS_W_GT + l * W_GT_STRIDE); J.mode = 1;
        J.g = arg_in(16) + l * D; J.b = arg_in(17) + l * D; J.pcs = part + PART_GT + l * PART_GT_L; J.pbw = J.pcs + (size_t)KB32 * D; break; }
    default: { const int l = id - 10; J.W = arg_in(19) + (size_t)l * PLE * D; J.K = PLE; J.N = D; J.WT = (bf16*)(ws + WS_W_PJ + l * W_PJ_STRIDE); break; }
    }
    return J;
}
__device__ __forceinline__ int job_items(int id) {
    switch (id) { case 0: return (D / 64) * (HW / 32); case 1: return (D / 64) * (D / 32); case 2: return (D / 64) * (NQKV / 32); case 3: return (AW / 64) * (D / 32);
        case 4: case 5: return (D / 64) * (NGU / 32); case 6: case 7: return (FF / 64) * (D / 32); case 8: case 9: return (D / 64) * (D / 32); default: return (PLE / 64) * (D / 32); }
}

__device__ __forceinline__ void conv_bf16(const float* src, bf16* dst, size_t n8, size_t gt, size_t nthr) {
    for (size_t i = gt; i < n8; i += nthr) {
        const f32x4 a = *(const GAS f32x4*)(src + 8 * i), b = *(const GAS f32x4*)(src + 8 * i + 4);
        v4u o; o.x = pk2(a[0], a[1]); o.y = pk2(a[2], a[3]); o.z = pk2(b[0], b[1]); o.w = pk2(b[2], b[3]);
        *(GAS v4u*)(dst + 8 * i) = o;
    }
}

__device__ __forceinline__ void prologue_phase(LAS unsigned char* lds, int G) {
    const int tid = opaque_tid(), lane = tid & 63, wave = tid >> 6;
    LAS float* scr = (LAS float*)(lds + wave * 16384);
    const int gw = blockIdx.x * NWAVES + wave, NGW = G * NWAVES;
#pragma unroll 1
    for (int id = 0; id < 12; ++id) {
        const TJob J = make_job(id); const int ni = job_items(id);
#pragma unroll 1
        for (int it = gw; it < ni; it += NGW) tr_item(J, scr, it, lane);
    }
    const size_t gt = (size_t)blockIdx.x * 512 + tid, nthr = (size_t)G * 512;
    conv_bf16(arg_in(7), (bf16*)(arg_ws() + WS_W_S), (size_t)16 * 128 * 128 / 8, gt, nthr);
    float* rot = (float*)(arg_ws() + WS_ROT);
    for (size_t i = gt; i < (size_t)16384 * 16; i += nthr) { const int pos = (int)(i >> 4), f = (int)(i & 15); float s, c; sincos_f64((float)pos * kInvFreq[f], s, c); rot[pos * 32 + f] = c; rot[pos * 32 + 16 + f] = s; }
}
__device__ __forceinline__ void finalize_vecs(int G) {
    const float* part = (const float*)(arg_ws() + WS_PART); float* vec = (float*)(arg_ws() + WS_VEC);
    const int gt = blockIdx.x * 512 + opaque_tid(), nthr = G * 512;
    for (int i = gt; i < 2 * 2 * NGU; i += nthr) {
        const float* p = part + PART_GU + (size_t)(i / NGU) * KB32 * NGU + (i % NGU); float s = 0.f;
        for (int kb = 0; kb < KB32; ++kb) s += p[(size_t)kb * NGU];
        vec[VEC_GU + i] = s;
    }
    for (int i = gt; i < 2 * 2 * D; i += nthr) {
        const float* p = part + PART_GT + (size_t)(i / D) * KB32 * D + (i % D); float s = 0.f;
        for (int kb = 0; kb < KB32; ++kb) s += p[(size_t)kb * D];
        vec[VEC_GT + i] = s;
    }
}

__device__ __forceinline__ void sgu_phase(LAS unsigned char* lds, const bf16* H, bf16* GATED, const bf16* WS, const float* bs, const float* lng, const float* lnb, int G) {
    const int tid = opaque_tid(), lane = tid & 63, wave = tid >> 6, i16 = lane & 15, kq = lane >> 4;
    LAS f32x2v* SV = (LAS f32x2v*)(lds + STAB_OFF);
#pragma unroll 1
    for (int chunk = blockIdx.x; chunk < MG / 128; chunk += G) {
        const size_t row0 = (size_t)chunk * 128;
#pragma unroll 1
        for (int rr = 0; rr < 16; ++rr) {
            const int r = wave * 16 + rr; const bf16* vrow = H + (row0 + r) * HW + D;
            v4u d[4]; float x[32]; float s = 0.f;
#pragma unroll
            for (int j = 0; j < 4; ++j) d[j] = *(const GAS v4u*)(vrow + 8 * (lane + 64 * j));
#pragma unroll
            for (int j = 0; j < 4; ++j) { x[8 * j + 0] = bf_lo(d[j].x); x[8 * j + 1] = bf_hi(d[j].x); x[8 * j + 2] = bf_lo(d[j].y); x[8 * j + 3] = bf_hi(d[j].y);
                x[8 * j + 4] = bf_lo(d[j].z); x[8 * j + 5] = bf_hi(d[j].z); x[8 * j + 6] = bf_lo(d[j].w); x[8 * j + 7] = bf_hi(d[j].w); }
#pragma unroll
            for (int j = 0; j < 32; ++j) s += x[j];
            const float mean = wave_sum(s) * (1.0f / D); float s2 = 0.f;
#pragma unroll
            for (int j = 0; j < 32; ++j) { const float t = x[j] - mean; s2 += t * t; }
            const float rstd = 1.0f / sqrtf(wave_sum(s2) * (1.0f / D) + LN_EPS);
            if (lane == 0) SV[r] = (f32x2v){mean, rstd};
        }
        WG_BAR();
        const int p = 16 * wave + i16;
#pragma unroll 1
        for (int g = 0; g < 16; ++g) {
            LAS unsigned char* img = lds + (g & 1) * 32768;
#pragma unroll
            for (int n = 0; n < 4; ++n) {
                const int id = tid + 512 * n, q = id >> 4, ch = id & 15; const int c0 = g * 128 + ch * 8;
                const v4u d = *(const GAS v4u*)(H + (row0 + q) * HW + D + c0);
                const f32x2v sr = SV[q];
                const f32x4 g0 = *(const GAS f32x4*)(lng + c0), g1 = *(const GAS f32x4*)(lng + c0 + 4), b0 = *(const GAS f32x4*)(lnb + c0), b1 = *(const GAS f32x4*)(lnb + c0 + 4);
                f32x4 x0, x1; x0[0] = bf_lo(d.x); x0[1] = bf_hi(d.x); x0[2] = bf_lo(d.y); x0[3] = bf_hi(d.y); x1[0] = bf_lo(d.z); x1[1] = bf_hi(d.z); x1[2] = bf_lo(d.w); x1[3] = bf_hi(d.w);
                x0 = ((x0 - sr.x) * sr.y) * g0 + b0; x1 = ((x1 - sr.x) * sr.y) * g1 + b1;
                v4u o; o.x = pk2(x0[0], x0[1]); o.y = pk2(x0[2], x0[3]); o.z = pk2(x1[0], x1[1]); o.w = pk2(x1[2], x1[3]);
                *(LAS v4u*)(img + off_b(q, ch)) = o;
            }
            bf16x8 wf[4];
#pragma unroll
            for (int s = 0; s < 4; ++s) wf[s] = *(const GAS bf16x8*)(WS + ((size_t)(g * 128 + p)) * 128 + 32 * s + 8 * kq);
            const float bias = bs[g * 128 + p];
            WG_BAR();
            f32x4 acc[8];
#pragma unroll
            for (int ct = 0; ct < 8; ++ct) {
                f32x4 c4 = (f32x4){0.f, 0.f, 0.f, 0.f};
#pragma unroll
                for (int s = 0; s < 4; ++s) {
                    const unsigned qq = (unsigned)(i16 >> 2), pp = (unsigned)(lane & 3);
                    const s16x4 lo = tr_read(img + off_b(32 * s + 8 * kq + qq, 2 * ct + (pp >> 1)) + 8 * (pp & 1));
                    const s16x4 hi = tr_read(img + off_b(32 * s + 8 * kq + 4 + qq, 2 * ct + (pp >> 1)) + 8 * (pp & 1));
                    const bf16x8 af = __builtin_shufflevector(lo, hi, 0, 1, 2, 3, 4, 5, 6, 7);
                    c4 = __builtin_amdgcn_mfma_f32_16x16x32_bf16(af, wf[s], c4, 0, 0, 0);
                }
                acc[ct] = c4;
            }
#pragma unroll
            for (int ct = 0; ct < 8; ++ct) {
                const int c = g * 128 + 16 * ct + 4 * kq;
                const v2u uw = *(const GAS v2u*)(H + (row0 + p) * HW + c);
                const float o0 = (acc[ct][0] + bias) * bf_lo(uw.x), o1 = (acc[ct][1] + bias) * bf_hi(uw.x), o2 = (acc[ct][2] + bias) * bf_lo(uw.y), o3 = (acc[ct][3] + bias) * bf_hi(uw.y);
                v2u ow; ow.x = pk2(o0, o1); ow.y = pk2(o2, o3);
                *(GAS v2u*)(GATED + (row0 + p) * D + c) = ow;
            }
        }
        WG_BAR();
    }
}

__device__ __forceinline__ void attn_phase(LAS unsigned char* lds, bf16* QKV, float* LSE, int S, int G) {
    const int tid = opaque_tid(), lane = tid & 63, wave = tid >> 6, iq = lane & 15, kq = lane >> 4;
    LAS unsigned char* Kimg = lds; LAS unsigned char* Vimg = lds + 65536;
    const int tps = S >> 7;
#pragma unroll 1
    for (int u = blockIdx.x; u < 3 * 8 * (MG / 128); u += G) {
        const int g = u / (8 * (MG / 128)), rem = u - g * (8 * (MG / 128)), h = rem & 7, ts = rem >> 3;
        const int ldil = 2 * g, dil = 1 << ldil;
        const int b = ts / tps, wslot = ts - b * tps;
        const int L = S >> ldil, tpr = L >> 7;
        const int r = wslot / tpr, it = wslot - r * tpr, i0 = it * 128;
        const size_t tok0 = (size_t)b * S + r;
        bf16* Qb = QKV + g * 3072 + h * 128; const bf16* Kb = Qb + 1024; const bf16* Vb = Qb + 2048;
#pragma unroll
        for (int n = 0; n < 8; ++n) {
            const int id = tid + 512 * n, kl = id >> 4, ch = id & 15, j = i0 - 64 + kl;
            v4u kv = (v4u){0u, 0u, 0u, 0u}, vv = (v4u){0u, 0u, 0u, 0u};
            if (j >= 0 && j < L) { const size_t off = (tok0 + (size_t)j * dil) * NQKV + ch * 8; kv = *(const GAS v4u*)(Kb + off); vv = *(const GAS v4u*)(Vb + off); }
            *(LAS v4u*)(Kimg + off_b(kl, ch)) = kv; *(LAS v4u*)(Vimg + off_b(kl, ch)) = vv;
        }
        const int qi = i0 + 16 * wave + iq; const size_t qtok = tok0 + (size_t)qi * dil;
        bf16x8 qf[4];
#pragma unroll
        for (int s = 0; s < 4; ++s) qf[s] = *(const GAS bf16x8*)(Qb + qtok * NQKV + 32 * s + 8 * kq);
        WG_BAR();
        f32x4 st[9];
#pragma unroll
        for (int T = 0; T < 9; ++T) {
            f32x4 c4 = (f32x4){0.f, 0.f, 0.f, 0.f};
#pragma unroll
            for (int s = 0; s < 4; ++s) { const bf16x8 kf = *(const LAS bf16x8*)(Kimg + off_b(16 * wave + 16 * T + iq, 4 * s + kq)); c4 = __builtin_amdgcn_mfma_f32_16x16x32_bf16(kf, qf[s], c4, 0, 0, 0); }
            st[T] = c4;
        }
        float mx = -3.0e38f;
#pragma unroll
        for (int T = 0; T < 9; ++T)
#pragma unroll
            for (int e = 0; e < 4; ++e) { const int kr = 16 * T + 4 * kq + e - iq, j = i0 + 16 * wave - 64 + 16 * T + 4 * kq + e;
                const bool ok = (kr >= 0) && (kr <= 128) && (j >= 0) && (j < L); st[T][e] = ok ? st[T][e] : -1.0e30f; mx = fmaxf(mx, st[T][e]); }
        mx = fmaxf(mx, __shfl_xor(mx, 16)); mx = fmaxf(mx, __shfl_xor(mx, 32));
        float den = 0.f;
#pragma unroll
        for (int T = 0; T < 9; ++T)
#pragma unroll
            for (int e = 0; e < 4; ++e) { const float pv = fast_exp2(st[T][e] - mx); st[T][e] = pv; den += pv; }
        den += __shfl_xor(den, 16); den += __shfl_xor(den, 32);
        bf16x8 pf[5];
#pragma unroll
        for (int s2 = 0; s2 < 5; ++s2) {
            v4u w; w.x = pk2(st[2 * s2][0], st[2 * s2][1]); w.y = pk2(st[2 * s2][2], st[2 * s2][3]);
            if (s2 < 4) { w.z = pk2(st[2 * s2 + 1][0], st[2 * s2 + 1][1]); w.w = pk2(st[2 * s2 + 1][2], st[2 * s2 + 1][3]); } else { w.z = 0u; w.w = 0u; }
            pf[s2] = __builtin_bit_cast(bf16x8, w);
        }
        const float inv = 1.0f / den;
        const unsigned qq = (unsigned)(iq >> 2), pp = (unsigned)(lane & 3);
#pragma unroll
        for (int c = 0; c < 8; ++c) {
            f32x4 o4 = (f32x4){0.f, 0.f, 0.f, 0.f};
#pragma unroll
            for (int s2 = 0; s2 < 5; ++s2) {
                unsigned r0 = 16 * wave + 32 * s2 + 4 * kq + qq, r1 = r0 + 16; r1 = r1 > 255u ? 255u : r1;
                const s16x4 lo = tr_read(Vimg + off_b(r0, 2 * c + (pp >> 1)) + 8 * (pp & 1));
                const s16x4 hi = tr_read(Vimg + off_b(r1, 2 * c + (pp >> 1)) + 8 * (pp & 1));
                const bf16x8 vf = __builtin_shufflevector(lo, hi, 0, 1, 2, 3, 4, 5, 6, 7);
                o4 = __builtin_amdgcn_mfma_f32_16x16x32_bf16(vf, pf[s2], o4, 0, 0, 0);
            }
            v2u ow; ow.x = pk2(o4[0] * inv, o4[1] * inv); ow.y = pk2(o4[2] * inv, o4[3] * inv);
            *(GAS v2u*)(Qb + qtok * NQKV + 16 * c + 4 * kq) = ow;
        }
        if (kq == 0) LSE[(qtok * 3 + g) * 8 + h] = (mx + __builtin_amdgcn_logf(den)) * LN2;
        WG_BAR();
    }
}
__device__ __forceinline__ void combine_phase(const bf16* QKV, const float* LSE, bf16* ATT, int G) {
    const size_t gt = (size_t)blockIdx.x * 512 + opaque_tid(), nthr = (size_t)G * 512;
    for (size_t i = gt; i < (size_t)MG * 128; i += nthr) {
        const size_t t = i >> 7; const int ch = (int)(i & 127), h = ch >> 4;
        const float l0 = LSE[(t * 3 + 0) * 8 + h], l1 = LSE[(t * 3 + 1) * 8 + h], l2 = LSE[(t * 3 + 2) * 8 + h];
        const float m = fmaxf(l0, fmaxf(l1, l2));
        float w0 = fast_exp2((l0 - m) * 1.4426950408889634f), w1 = fast_exp2((l1 - m) * 1.4426950408889634f), w2 = fast_exp2((l2 - m) * 1.4426950408889634f);
        const float inv = 1.0f / (w0 + w1 + w2); w0 *= inv; w1 *= inv; w2 *= inv;
        const v4u a = *(const GAS v4u*)(QKV + t * NQKV + ch * 8), b = *(const GAS v4u*)(QKV + t * NQKV + 3072 + ch * 8), c = *(const GAS v4u*)(QKV + t * NQKV + 6144 + ch * 8);
        v4u o;
        o.x = pk2(w0 * bf_lo(a.x) + w1 * bf_lo(b.x) + w2 * bf_lo(c.x), w0 * bf_hi(a.x) + w1 * bf_hi(b.x) + w2 * bf_hi(c.x));
        o.y = pk2(w0 * bf_lo(a.y) + w1 * bf_lo(b.y) + w2 * bf_lo(c.y), w0 * bf_hi(a.y) + w1 * bf_hi(b.y) + w2 * bf_hi(c.y));
        o.z = pk2(w0 * bf_lo(a.z) + w1 * bf_lo(b.z) + w2 * bf_lo(c.z), w0 * bf_hi(a.z) + w1 * bf_hi(b.z) + w2 * bf_hi(c.z));
        o.w = pk2(w0 * bf_lo(a.w) + w1 * bf_lo(b.w) + w2 * bf_lo(c.w), w0 * bf_hi(a.w) + w1 * bf_hi(b.w) + w2 * bf_hi(c.w));
        *(GAS v4u*)(ATT + t * AW + ch * 8) = o;
    }
}

#ifndef MK_PER_PHASE
#define MK_PER_PHASE 0
#endif
constexpr int N_PHASES = 1 + 2 * (1 + 2 + 4 + 3 + 4);

__global__ void __launch_bounds__(NWAVES * 64, 2) trunk_fwd(Args args) {
    extern __shared__ __attribute__((aligned(16))) unsigned char lds_raw[];
    LAS unsigned char* lds = (LAS unsigned char*)lds_raw;
    LAS unsigned char* xl = lds + RING_BYTES;
    const int G = gridDim.x;
    for (int u = threadIdx.x; u < (LDS_BYTES - RING_BYTES) / 4; u += NWAVES * 64) ((LAS unsigned*)(lds + RING_BYTES))[u] = 0u;
    __syncthreads();
    const int lo = args.ph_lo, hi = args.ph_hi;
    XcdBarrier bar; bar.bar = (unsigned*)(arg_ws() + WS_CTL); bar.x = 0; bar.st = (volatile LAS unsigned*)(lds + MISC_OFF) + 8;
    if (hi - lo > 1) bar = xcd_barrier_post((unsigned*)(arg_ws() + WS_CTL), (volatile LAS unsigned*)(lds + MISC_OFF) + 8);
    int pc = 0;
#define RUN_PH (pc >= lo && pc < hi)
#define SEAM() do { if (pc >= lo && pc + 1 < hi) { XcdBarrier b2_ = bar; asm volatile("" : "+s"(b2_.bar), "+s"(b2_.x)); b2_.bar = (unsigned*)(GAS unsigned*)b2_.bar; xcd_barrier(b2_); } ++pc; } while (0)
#define WSP(T, off) ((T*)(arg_ws() + (off)))
#define BIGP(T, off) ((T*)(arg_ws() + WS_BIG + (off)))
#define XOUT(grp) (arg_out() + (size_t)(grp) * MG * D)
#define VECP() ((const float*)(arg_ws() + WS_VEC))

    if (RUN_PH) { prologue_phase(lds, G); }
    SEAM();
#pragma unroll 1
    for (int grp = 0; grp < 2; ++grp) {
        const int S = grp == 0 ? 2048 : 16384;
        if (RUN_PH) {
            conv_bf16(arg_in(grp), WSP(bf16, WS_XB), (size_t)MG * D / 8, (size_t)blockIdx.x * 512 + opaque_tid(), (size_t)G * 512);
            if (grp == 0) finalize_vecs(G);
        }
        SEAM();
#pragma unroll 1
        for (int layer = 0; layer < 2; ++layer) {
            if (layer == 0) {
                if (RUN_PH) {
                    pg8::Gemm g{WSP(bf16, WS_XB), WSP(const bf16, WS_W_IN), MG, HW, D}; pg8::StaticOrder So; So.init(MG, HW, G, (int)blockIdx.x);
                    pg8::EpiPlain<1> E{BIGP(bf16, BIG_H), HW};
                    pg8::gemm_phase<pg8::EpiPlain<1>, pg8::StaticOrder, true, true>(lds, g, So, E);
                }
                SEAM();
                if (RUN_PH) { sgu_phase(lds, BIGP(const bf16, BIG_H), BIGP(bf16, BIG_GATED), WSP(const bf16, WS_W_S), arg_in(8), arg_in(5), arg_in(6), G); }
                SEAM();
            } else {
                if (RUN_PH) {
                    pg8::Gemm g{WSP(bf16, WS_XB), WSP(const bf16, WS_W_QKV), MG, NQKV, D}; pg8::StaticOrder So; So.init(MG, NQKV, G, (int)blockIdx.x);
                    pg8::EpiQKV E{BIGP(bf16, BIG_QKV), WSP(const float, WS_ROT), S - 1, QSCALE};
                    pg8::gemm_phase<pg8::EpiQKV, pg8::StaticOrder, true, true>(lds, g, So, E);
                }
                SEAM();
                if (RUN_PH) { attn_phase(lds, BIGP(bf16, BIG_QKV), BIGP(float, BIG_LSE), S, G); }
                SEAM();
                if (RUN_PH) { combine_phase(BIGP(const bf16, BIG_QKV), BIGP(const float, BIG_LSE), BIGP(bf16, BIG_ATT), G); }
                SEAM();
            }
            if (RUN_PH) {
                conv_bf16(arg_in(2 + grp) + (size_t)layer * MG * PLE, BIGP(bf16, BIG_PB), (size_t)MG * PLE / 8, (size_t)blockIdx.x * 512 + opaque_tid(), (size_t)G * 512);
                pg8::Gemm g{layer == 0 ? BIGP(const bf16, BIG_GATED) : BIGP(const bf16, BIG_ATT), layer == 0 ? WSP(const bf16, WS_W_OA) : WSP(const bf16, WS_W_OB), MG, D, layer == 0 ? D : AW};
                pg8::StaticOrder So; So.init(MG, D, G, (int)blockIdx.x);
                pg8::EpiY1 E{layer == 0 ? arg_in(grp) : (const float*)XOUT(grp), XOUT(grp), WSP(bf16, WS_XB), WSP(float, WS_ST1), xl, ALPHA};
                pg8::gemm_phase<pg8::EpiY1, pg8::StaticOrder, true, true>(lds, g, So, E);
            }
            SEAM();
            if (RUN_PH) {
                { pg8::Gemm g{BIGP(const bf16, BIG_PB), WSP(const bf16, WS_W_PJ + layer * W_PJ_STRIDE), MG, D, PLE}; pg8::StaticOrder So; So.init(MG, D, G, (int)blockIdx.x);
                  pg8::EpiPlain<0> E{BIGP(bf16, BIG_PP), D};
                  pg8::gemm_phase<pg8::EpiPlain<0>, pg8::StaticOrder, true, true>(lds, g, So, E); }
                { pg8::Gemm g{WSP(const bf16, WS_XB), WSP(const bf16, WS_W_GU + layer * W_GU_STRIDE), MG, NGU, D}; pg8::StaticOrder So; So.init(MG, NGU, G, (int)blockIdx.x);
                  pg8::EpiGU E{WSP(const float, WS_ST1), VECP() + VEC_GU + layer * VEC_GU_L, VECP() + VEC_GU + layer * VEC_GU_L + NGU, BIGP(bf16, BIG_HB), xl, LN_EPS};
                  pg8::gemm_phase<pg8::EpiGU, pg8::StaticOrder, true, true>(lds, g, So, E); }
            }
            SEAM();
            if (RUN_PH) {
                pg8::Gemm g{BIGP(const bf16, BIG_HB), WSP(const bf16, WS_W_DN + layer * W_DN_STRIDE), MG, D, FF}; pg8::StaticOrder So; So.init(MG, D, G, (int)blockIdx.x);
                pg8::EpiY2 E{XOUT(grp), BIGP(bf16, BIG_XB2), WSP(const float, WS_ST1), WSP(float, WS_ST2), arg_in(12) + layer * D, arg_in(13) + layer * D, xl, ALPHA, LN_EPS};
                pg8::gemm_phase<pg8::EpiY2, pg8::StaticOrder, true, true>(lds, g, So, E);
            }
            SEAM();
            if (RUN_PH) {
                pg8::Gemm g{BIGP(const bf16, BIG_XB2), WSP(const bf16, WS_W_GT + layer * W_GT_STRIDE), MG, D, D}; pg8::StaticOrder So; So.init(MG, D, G, (int)blockIdx.x);
                pg8::EpiPLE E{XOUT(grp), layer == 0 ? WSP(bf16, WS_XB) : (bf16*)nullptr, BIGP(const bf16, BIG_PP), WSP(const float, WS_ST2), arg_in(16) + layer * D, arg_in(17) + layer * D,
                              VECP() + VEC_GT + layer * VEC_GT_L, VECP() + VEC_GT + layer * VEC_GT_L + D, xl, LN_EPS};
                pg8::gemm_phase<pg8::EpiPLE, pg8::StaticOrder, true, true>(lds, g, So, E);
            }
            SEAM();
        }
    }
#undef RUN_PH
#undef SEAM
}

extern "C" void kernel_launch(void* const* d_in, const int* in_sizes, int n_in, void* d_out, int out_size, void* d_ws, size_t ws_size, hipStream_t stream) {
    static int grid = 0;
    if (grid == 0) {
        if (n_in != 20 || in_sizes[0] != MG * D || in_sizes[1] != MG * D || out_size != 2 * MG * D || ws_size < WS_END) {
            fprintf(stderr, "kernel_launch: unexpected shapes (n_in %d, in0 %d, out %d, ws %zu < %zu); nothing launched\n", n_in, n_in > 0 ? in_sizes[0] : -1, out_size, ws_size, (size_t)WS_END); grid = -1; return; }
        int dev = 0, cus = 0, per_cu = 0;
        if (hipGetDevice(&dev) != hipSuccess || hipDeviceGetAttribute(&cus, hipDeviceAttributeMultiprocessorCount, dev) != hipSuccess) { grid = -1; return; }
        if (hipFuncSetAttribute((const void*)trunk_fwd, hipFuncAttributeMaxDynamicSharedMemorySize, LDS_BYTES) != hipSuccess) { fprintf(stderr, "kernel_launch: hipFuncSetAttribute failed\n"); grid = -1; return; }
        if (hipOccupancyMaxActiveBlocksPerMultiprocessor(&per_cu, (const void*)trunk_fwd, NWAVES * 64, LDS_BYTES) != hipSuccess || per_cu < 1)
            fprintf(stderr, "kernel_launch: note: occupancy query reports %d workgroups per CU\n", per_cu);
        (void)hipGetLastError();
        grid = cus;
    }
    if (grid < 0) return;
    if (hipMemsetAsync((char*)d_ws + WS_CTL, 0, CTL_ZERO_BYTES, stream) != hipSuccess) return;
    Args a{};
    for (int i = 0; i < 20; ++i) a.in[i] = (const float*)d_in[i];
    a.out = (float*)d_out; a.ws = (unsigned char*)d_ws;
#if MK_PER_PHASE
    for (int p = 0; p < N_PHASES; ++p) { a.ph_lo = p; a.ph_hi = p + 1; hipLaunchKernelGGL(trunk_fwd, dim3(grid), dim3(NWAVES * 64), LDS_BYTES, stream, a); }
#else
    a.ph_lo = 0; a.ph_hi = N_PHASES;
    hipLaunchKernelGGL(trunk_fwd, dim3(grid), dim3(NWAVES * 64), LDS_BYTES, stream, a);
#endif
    const hipError_t le = hipPeekAtLastError();
    if (le != hipSuccess) fprintf(stderr, "kernel_launch: launch failed: %s\n", hipGetErrorName(le));
}
```

```cpp
#include <hip/hip_runtime.h>
#include <cstdio>
#include <cstdint>
namespace pg8 {
#define PG8_LAS __attribute__((address_space(3)))
typedef unsigned short bf16_t;
typedef short bf16x8 __attribute__((ext_vector_type(8)));
typedef float f32x4 __attribute__((ext_vector_type(4)));
typedef unsigned u32x4 __attribute__((ext_vector_type(4)));
constexpr int BM = 256, BK = 64, HALF = 128, HTB = HALF * BK * 2  , STAGE_BYTES = 8 * HTB, NXCD = 8, WGM = 8;

__host__ __device__ __forceinline__ int lds_byte(int r, int c) { const int st = (r >> 4) * 2 + (c >> 5), rr = r & 15, cc = c & 31, ob = rr * 64 + cc * 2; return st * 1024 + (ob ^ (((ob >> 9) & 1) << 5)); }
__host__ __device__ __forceinline__ void stage_rc(int b, int& R, int& C) { const int st = b / 1024, sb = b % 1024, swz = sb ^ (((sb >> 9) & 1) << 5); R = (st >> 1) * 16 + swz / 64; C = (st & 1) * 32 + (swz % 64) / 2; }
__host__ __device__ __forceinline__ int perm32(int rho) { const int n = rho >> 4, i = rho & 15; return 8 * (i >> 2) + 4 * n + (i & 3); }

struct Unit { int pm, pn; };
struct Gemm { const bf16_t* A; const bf16_t* Bt; int M, N, K, wid0; };

struct StaticOrder {
    int nM, nN, nwg, G, c;
    __host__ __device__ void init(int M, int N, int G_, int c_) { nM = M / BM; nN = N / BM; nwg = nM * nN; G = G_; c = c_; }
    __host__ __device__ bool next(int i, Unit& u) const {
        const long L = (long)i * G + c; if (L >= nwg) return false;
        int wgid = (int)L; { const int q = nwg / NXCD, r = nwg % NXCD, xcd = wgid % NXCD, off = wgid / NXCD; wgid = (xcd < r ? xcd * (q + 1) : r * (q + 1) + (xcd - r) * q) + off; }
        const int nig = WGM * nN, gid = wgid / nig, fm = gid * WGM, gsz = (nM - fm) < WGM ? (nM - fm) : WGM;
        u.pm = fm + ((wgid % nig) % gsz); u.pn = (wgid % nig) / gsz; return true;
    }
    __device__ __forceinline__ void a_ready(const Unit&) const {}
    __device__ __forceinline__ void done(const Unit&) const {}
};
typedef _Float16 h16x2 __attribute__((ext_vector_type(2)));
typedef _Float16 h16x8 __attribute__((ext_vector_type(8)));
typedef float f32x2p __attribute__((ext_vector_type(2)));
__device__ __forceinline__ unsigned cvt_pk16(float lo, float hi) { const f32x2p v = {lo, hi}; return __builtin_bit_cast(unsigned, __builtin_convertvector(v, h16x2)); }
#define PG8_MFMA16(a, b, c) __builtin_amdgcn_mfma_f32_16x16x32_f16(__builtin_bit_cast(pg8::h16x8, (a)), __builtin_bit_cast(pg8::h16x8, (b)), (c), 0, 0, 0)
typedef float f32x2 __attribute__((ext_vector_type(2)));
__device__ __forceinline__ f32x2 gelu_pk(f32x2 v) {
    const f32x2 av = __builtin_elementwise_abs(v), d = av * 0.2316418882f + 1.0f;
    f32x2 t; t.x = __builtin_amdgcn_rcpf(d.x); t.y = __builtin_amdgcn_rcpf(d.y);
    f32x2 q = t * 0.5307027145f + (-0.7265760135f); q = q * t + 0.7107068705f; q = q * t + (-0.142248368f); q = q * t + 0.127414796f; q = q * t;
    const f32x2 s = (v * v) * (-0.72134752044f);
    f32x2 e; e.x = __builtin_amdgcn_exp2f(s.x); e.y = __builtin_amdgcn_exp2f(s.y);
    const f32x2 m = v * (q * e), r = v - m;
    f32x2 o; o.x = v.x < 0.f ? m.x : r.x; o.y = v.y < 0.f ? m.y : r.y; return o;
}

template <int ACT  > struct EpiBf16 {
    static constexpr bool PERM = true, AFTER_DRAIN = false; static_assert(ACT == 0 || ACT == 1, "EpiBf16: ACT is 0 (none) or 1 (gelu_pk)");
    bf16_t* O; int ldc; const float* bias; int split_cols; size_t split_stride; float scale0;
    __device__ __forceinline__ void operator()(const f32x4 (&acc)[2][2][4][2], const Unit& u, int wr, int wc, int fr, int fq) const {
        const int row0 = u.pm * BM + wr * 64 + fr; int colt = u.pn * BM; bf16_t* base = O;
        float sc = 1.f; if (split_cols) { const int t = colt / split_cols; base += (size_t)t * split_stride; colt -= t * split_cols; if (t == 0) sc = scale0; }
        const int col0 = colt + wc * 32 + 8 * fq, bcol0 = u.pn * BM + wc * 32 + 8 * fq;
        f32x4 bv[2][2];
#pragma unroll
        for (int bj = 0; bj < 2; ++bj)
#pragma unroll
            for (int n = 0; n < 2; ++n) bv[bj][n] = bias ? *(const f32x4*)(bias + bcol0 + bj * HALF + 4 * n) : (f32x4){0.f, 0.f, 0.f, 0.f};
#pragma unroll
        for (int ai = 0; ai < 2; ++ai)
#pragma unroll
            for (int m = 0; m < 4; ++m) { bf16_t* rowp = base + (size_t)(row0 + ai * HALF + m * 16) * ldc + col0;
#pragma unroll
                for (int bj = 0; bj < 2; ++bj) { f32x4 v0 = acc[ai][bj][m][0] + bv[bj][0], v1 = acc[ai][bj][m][1] + bv[bj][1];
                    if (ACT == 1) { f32x2 a = gelu_pk((f32x2){v0[0], v0[1]}), b = gelu_pk((f32x2){v0[2], v0[3]}), c = gelu_pk((f32x2){v1[0], v1[1]}), d = gelu_pk((f32x2){v1[2], v1[3]});
                        v0 = (f32x4){a.x, a.y, b.x, b.y}; v1 = (f32x4){c.x, c.y, d.x, d.y}; }
                    v0 = v0 * sc; v1 = v1 * sc; u32x4 w; w.x = cvt_pk16(v0[0], v0[1]); w.y = cvt_pk16(v0[2], v0[3]); w.z = cvt_pk16(v1[0], v1[1]); w.w = cvt_pk16(v1[2], v1[3]);
                    *(u32x4*)(rowp + bj * HALF) = w; } }
    }
};
}

constexpr int D = 2048, FF = 5632, NGU = 2 * FF, NQKV = 9216, AW = 1024, PLE = 256, HW = 4096;
constexpr int MG = 32768;
constexpr float LN_EPS = 1e-5f;
constexpr float ALPHA = 1.4142135623730951f;
constexpr float QSCALE = 0.08838834764831845f * 1.4426950408889634f;
constexpr float LN2 = 0.6931471805599453f;
constexpr int NWAVES = 8;

constexpr size_t MiB = 1u << 20;
constexpr size_t WS_CTL = 0, CTL_ZERO_BYTES = 65536;
constexpr size_t WS_ROT = 2 * MiB;
constexpr size_t WS_ST1 = 4 * MiB, WS_ST2 = 6 * MiB;
constexpr size_t WS_PART = 8 * MiB;
constexpr size_t WS_VEC = 16 * MiB;
constexpr size_t WS_W_IN = 17 * MiB, WS_W_OA = 33 * MiB, WS_W_S = 41 * MiB, WS_W_QKV = 42 * MiB, WS_W_OB = 78 * MiB;
constexpr size_t WS_W_GU = 82 * MiB, W_GU_STRIDE = 44 * MiB, WS_W_DN = 170 * MiB, W_DN_STRIDE = 22 * MiB;
constexpr size_t WS_W_GT = 214 * MiB, W_GT_STRIDE = 8 * MiB, WS_W_PJ = 230 * MiB, W_PJ_STRIDE = 1 * MiB;
constexpr size_t WS_XB = 232 * MiB;
constexpr size_t WS_BIG = 360 * MiB;
constexpr size_t BIG_H = 0, BIG_GATED = 256 * MiB, BIG_PB = 384 * MiB, BIG_XB2 = 384 * MiB, BIG_HB = 0, BIG_PP = 512 * MiB;
constexpr size_t BIG_QKV = 0, BIG_ATT = 576 * MiB, BIG_LSE = 640 * MiB;
constexpr size_t WS_END = WS_BIG + 643 * MiB;
constexpr int KB32 = 32;
constexpr size_t PART_GU = 0, PART_GU_L = (size_t)2 * KB32 * NGU, PART_GT = 2 * PART_GU_L, PART_GT_L = (size_t)2 * KB32 * D;
constexpr size_t VEC_GU = 0, VEC_GU_L = 2 * NGU, VEC_GT = 2 * VEC_GU_L, VEC_GT_L = 2 * D;
static_assert((PART_GT + 2 * PART_GT_L) * 4 <= 8 * MiB && (VEC_GT + 2 * VEC_GT_L) * 4 <= 1 * MiB, "partials");

constexpr int RING_BYTES = 131072;
constexpr int MISC_OFF = RING_BYTES + 320;
constexpr int STAB_OFF = RING_BYTES + 512;
constexpr int PTAB_OFF = STAB_OFF + 2048;
constexpr int LDS_BYTES = 147456;
static_assert(PTAB_OFF + 8192 <= LDS_BYTES, "LDS map");

#define GAS __attribute__((address_space(1)))
#define LAS __attribute__((address_space(3)))
typedef unsigned short bf16;
typedef unsigned v4u __attribute__((ext_vector_type(4)));
typedef unsigned v2u __attribute__((ext_vector_type(2)));
typedef float f32x4 __attribute__((ext_vector_type(4)));
typedef float f32x2v __attribute__((ext_vector_type(2)));
typedef short bf16x8 __attribute__((ext_vector_type(8)));
typedef short s16x4 __attribute__((ext_vector_type(4)));
#define LDS_WAIT() asm volatile("s_waitcnt lgkmcnt(0)" ::: "memory")
#define VM_WAIT() asm volatile("s_waitcnt vmcnt(0)" ::: "memory")
#define WG_BAR() do { asm volatile("s_waitcnt lgkmcnt(0)" ::: "memory"); __builtin_amdgcn_s_barrier(); asm volatile("" ::: "memory"); } while (0)

__device__ __forceinline__ float bf_round(float f) { return (float)(_Float16)f; }
__device__ __forceinline__ unsigned pk2(float lo, float hi) { return pg8::cvt_pk16(lo, hi); }
__device__ __forceinline__ float bf_lo(unsigned w) { return (float)__builtin_bit_cast(pg8::h16x2, w).x; }
__device__ __forceinline__ float bf_hi(unsigned w) { return (float)__builtin_bit_cast(pg8::h16x2, w).y; }
__device__ __forceinline__ int opaque_tid(int wid0) { int t; asm volatile("v_mbcnt_lo_u32_b32 %0, -1, 0\n\tv_mbcnt_hi_u32_b32 %0, -1, %0" : "=v"(t)); return (wid0 << 6) | t; }
__device__ __forceinline__ float shx(float v, int mask, int lane) { return __builtin_bit_cast(float, __builtin_amdgcn_ds_bpermute((lane ^ mask) << 2, __builtin_bit_cast(int, v))); }
__device__ __forceinline__ float wave_sum(float v, int lane) {
#pragma unroll
    for (int o = 1; o < 64; o <<= 1) v += shx(v, o, lane);
    return v;
}
__device__ __forceinline__ float fast_exp2(float x) { return __builtin_amdgcn_exp2f(x); }
__device__ __forceinline__ float fast_rcp(float x) { return __builtin_amdgcn_rcpf(x); }
__device__ __forceinline__ float sigmoidf_(float x) { return fast_rcp(1.0f + fast_exp2(-1.4426950408889634f * x)); }
__device__ __forceinline__ unsigned off_b(unsigned row, unsigned ch) { return 256u * row + 16u * (ch ^ (((row & 3u) << 2) | ((row >> 2) & 3u))); }
typedef short v4i16_t __attribute__((ext_vector_type(4)));
__device__ __forceinline__ s16x4 tr_read(LAS const unsigned char* p) { return __builtin_bit_cast(s16x4, __builtin_amdgcn_ds_read_tr16_b64_v4i16((LAS v4i16_t*)p)); }

namespace pg8 {
__device__ __forceinline__ void stab_from_partials(const float* st, int pm, PG8_LAS unsigned char* xl, float eps, int wid0) {
    const int tid = opaque_tid(wid0);
    if (tid < 256) {
        const f32x4* p = (const f32x4*)(st + ((size_t)(pm * BM + tid)) * 16);
        const f32x4 a = p[0], b = p[1], c = p[2], d = p[3];
        const float S = ((a[0] + a[2]) + (b[0] + b[2])) + ((c[0] + c[2]) + (d[0] + d[2]));
        const float Q = ((a[1] + a[3]) + (b[1] + b[3])) + ((c[1] + c[3]) + (d[1] + d[3]));
        const float mean = S * (1.0f / 2048.0f); float var = Q * (1.0f / 2048.0f) - mean * mean; var = var < 0.f ? 0.f : var;
        ((PG8_LAS f32x2*)(xl + (STAB_OFF - RING_BYTES)))[tid] = (f32x2){mean, 1.0f / sqrtf(var + eps)};
    }
    asm volatile("s_waitcnt lgkmcnt(0)" ::: "memory"); __builtin_amdgcn_s_barrier(); asm volatile("" ::: "memory");
}
__device__ __forceinline__ void partials_to_st(float* st, const Unit& u, PG8_LAS unsigned char* xl, int wid0) {
    asm volatile("s_waitcnt lgkmcnt(0)" ::: "memory"); __builtin_amdgcn_s_barrier(); asm volatile("" ::: "memory");
    const int tid = opaque_tid(wid0);
    if (tid < 256) {
        const PG8_LAS f32x4* P = (const PG8_LAS f32x4*)(xl + (PTAB_OFF - RING_BYTES)) + tid * 2;
        const f32x4 a = P[0], b = P[1];
        f32x2 o; o.x = (a[0] + a[2]) + (b[0] + b[2]); o.y = (a[1] + a[3]) + (b[1] + b[3]);
        *(f32x2*)(st + ((size_t)(u.pm * BM + tid) * 8 + u.pn) * 2) = o;
    }
}
struct LaneId { int wr, wc, fr, fq; };
__device__ __forceinline__ LaneId lane_id(int wid0) { const int t = opaque_tid(wid0); const int wid = wid0, lane = t & 63; LaneId L; L.wr = wid >> 2; L.wc = wid & 3; L.fr = lane & 15; L.fq = lane >> 4; return L; }
#define PG8_ROWSUM(s, q, v) do { s += ((v)[0] + (v)[1]) + ((v)[2] + (v)[3]); q += ((v)[0] * (v)[0] + (v)[1] * (v)[1]) + ((v)[2] * (v)[2] + (v)[3] * (v)[3]); } while (0)

template <int ACT> struct EpiPlain {
    static constexpr bool PERM = true, AFTER_DRAIN = false;
    bf16_t* O; int ldc; int wid0;
    __device__ __forceinline__ void operator()(const f32x4 (&acc)[2][2][4][2], const Unit& u, int, int, int, int) const {
        const LaneId L_ = lane_id(wid0); const int wr = L_.wr, wc = L_.wc, fr = L_.fr, fq = L_.fq;
        const int row0 = u.pm * BM + wr * 64 + fr, col0 = u.pn * BM + wc * 32 + 8 * fq;
#pragma unroll
        for (int ai = 0; ai < 2; ++ai)
#pragma unroll
            for (int m = 0; m < 4; ++m) { bf16_t* rowp = O + (size_t)(row0 + ai * HALF + m * 16) * ldc + col0;
#pragma unroll
                for (int bj = 0; bj < 2; ++bj) { f32x4 v0 = acc[ai][bj][m][0], v1 = acc[ai][bj][m][1];
                    if (ACT == 1) { f32x2 a = gelu_pk((f32x2){v0[0], v0[1]}), b = gelu_pk((f32x2){v0[2], v0[3]}), c = gelu_pk((f32x2){v1[0], v1[1]}), d = gelu_pk((f32x2){v1[2], v1[3]});
                        v0 = (f32x4){a.x, a.y, b.x, b.y}; v1 = (f32x4){c.x, c.y, d.x, d.y}; }
                    u32x4 w; w.x = cvt_pk16(v0[0], v0[1]); w.y = cvt_pk16(v0[2], v0[3]); w.z = cvt_pk16(v1[0], v1[1]); w.w = cvt_pk16(v1[2], v1[3]);
                    *(u32x4*)(rowp + bj * HALF) = w; } }
    }
};
struct EpiQKV {
    static constexpr bool PERM = true, AFTER_DRAIN = false;
    bf16_t* O; const float* rot; int seq_mask; float qscale; int wid0;
    __device__ __forceinline__ void operator()(const f32x4 (&acc)[2][2][4][2], const Unit& u, int, int, int, int) const {
        const LaneId L_ = lane_id(wid0); const int wr = L_.wr, wc = L_.wc, fr = L_.fr, fq = L_.fq;
        const int colt = u.pn * BM, tsel = (colt % 3072) / 1024;
        const float sc = tsel == 0 ? qscale : 1.0f;
        const bool dorot = (tsel < 2) && (wc == 0);
        const int row0 = u.pm * BM + wr * 64 + fr, col0 = colt + wc * 32 + 8 * fq;
        const float sgn = fq < 2 ? -1.0f : 1.0f;
#pragma unroll
        for (int ai = 0; ai < 2; ++ai)
#pragma unroll
            for (int m = 0; m < 4; ++m) {
                const int row = row0 + ai * HALF + m * 16;
                f32x4 cs[2], sn[2];
                if (dorot) { const float* rp = rot + (size_t)(row & seq_mask) * 32 + 8 * (fq & 1);
                    cs[0] = *(const f32x4*)(rp); cs[1] = *(const f32x4*)(rp + 4); sn[0] = *(const f32x4*)(rp + 16); sn[1] = *(const f32x4*)(rp + 20); }
#pragma unroll
                for (int bj = 0; bj < 2; ++bj) {
                    f32x4 v[2] = {acc[ai][bj][m][0], acc[ai][bj][m][1]};
                    if (dorot) {
#pragma unroll
                        for (int n = 0; n < 2; ++n) { f32x4 pr;
#pragma unroll
                            for (int j = 0; j < 4; ++j) pr[j] = shx(v[n][j], 32, fr + 16 * fq);
                            v[n] = v[n] * cs[n] + (pr * sn[n]) * sgn; }
                    }
                    v[0] = v[0] * sc; v[1] = v[1] * sc;
                    u32x4 w; w.x = cvt_pk16(v[0][0], v[0][1]); w.y = cvt_pk16(v[0][2], v[0][3]); w.z = cvt_pk16(v[1][0], v[1][1]); w.w = cvt_pk16(v[1][2], v[1][3]);
                    *(u32x4*)(O + (size_t)row * NQKV + col0 + bj * HALF) = w;
                }
            }
    }
};
#define PG8_UNPACK8(W_, v0, v1) do { v0[0] = bf_lo((W_)[0]); v0[1] = bf_hi((W_)[0]); v0[2] = bf_lo((W_)[1]); v0[3] = bf_hi((W_)[1]); v1[0] = bf_lo((W_)[2]); v1[1] = bf_hi((W_)[2]); v1[2] = bf_lo((W_)[3]); v1[3] = bf_hi((W_)[3]); } while (0)
#define PG8_PACK8(W_, v0, v1) do { (W_)[0] = cvt_pk16(v0[0], v0[1]); (W_)[1] = cvt_pk16(v0[2], v0[3]); (W_)[2] = cvt_pk16(v1[0], v1[1]); (W_)[3] = cvt_pk16(v1[2], v1[3]); } while (0)
struct EpiY1 {
    static constexpr bool PERM = true, AFTER_DRAIN = false;
    const float* xin32; const bf16_t* xin16; bf16_t* yb; float* st; PG8_LAS unsigned char* xl; float alpha; int wid0;
    __device__ __forceinline__ void operator()(const f32x4 (&acc)[2][2][4][2], const Unit& u, int, int, int, int) const {
        const LaneId L_ = lane_id(wid0); const int wr = L_.wr, wc = L_.wc, fr = L_.fr, fq = L_.fq;
        const int row0 = u.pm * BM + wr * 64 + fr, col0 = u.pn * BM + wc * 32 + 8 * fq;
        PG8_LAS f32x2* P = (PG8_LAS f32x2*)(xl + (PTAB_OFF - RING_BYTES));
#pragma unroll
        for (int ai = 0; ai < 2; ++ai)
#pragma unroll
            for (int m = 0; m < 4; ++m) {
                const int rl = ai * HALF + wr * 64 + m * 16 + fr; const size_t off = (size_t)(row0 + ai * HALF + m * 16) * D + col0;
                float s = 0.f, q = 0.f;
#pragma unroll
                for (int bj = 0; bj < 2; ++bj) {
                    f32x4 x0, x1;
                    if (xin32) { x0 = *(const f32x4*)(xin32 + off + bj * HALF); x1 = *(const f32x4*)(xin32 + off + bj * HALF + 4); }
                    else { const u32x4 xw = *(const u32x4*)(xin16 + off + bj * HALF); PG8_UNPACK8(xw, x0, x1); }
                    const f32x4 y0 = x0 * alpha + acc[ai][bj][m][0], y1 = x1 * alpha + acc[ai][bj][m][1];
                    u32x4 w; PG8_PACK8(w, y0, y1);
                    *(u32x4*)(yb + off + bj * HALF) = w;
                    PG8_ROWSUM(s, q, y0); PG8_ROWSUM(s, q, y1);
                }
                { const int ln_ = fr + 16 * fq; s += shx(s, 16, ln_); q += shx(q, 16, ln_); s += shx(s, 32, ln_); q += shx(q, 32, ln_); }
                if (fq == 0) P[rl * 4 + wc] = (f32x2){s, q};
                asm volatile("" ::: "memory");
            }
        partials_to_st(st, u, xl, wid0);
    }
};
struct EpiGU {
    static constexpr bool PERM = true, AFTER_DRAIN = false;
    const float* st; const float* cs; const float* bw; bf16_t* H; PG8_LAS unsigned char* xl; float eps; int wid0;
    __device__ __forceinline__ void operator()(const f32x4 (&acc)[2][2][4][2], const Unit& u, int, int, int, int) const {
        const LaneId L_ = lane_id(wid0); const int wr = L_.wr, wc = L_.wc, fr = L_.fr, fq = L_.fq;
        stab_from_partials(st, u.pm, xl, eps, wid0);
        const PG8_LAS f32x2* S = (const PG8_LAS f32x2*)(xl + (STAB_OFF - RING_BYTES));
        const int row0 = u.pm * BM + wr * 64 + fr, col0 = u.pn * BM + wc * 32 + 8 * fq, hcol0 = u.pn * HALF + wc * 32 + 8 * fq;
        f32x4 csv[2][2], bwv[2][2];
#pragma unroll
        for (int bj = 0; bj < 2; ++bj)
#pragma unroll
            for (int n = 0; n < 2; ++n) { csv[bj][n] = *(const f32x4*)(cs + col0 + bj * HALF + 4 * n); bwv[bj][n] = *(const f32x4*)(bw + col0 + bj * HALF + 4 * n); }
#pragma unroll
        for (int ai = 0; ai < 2; ++ai)
#pragma unroll
            for (int m = 0; m < 4; ++m) {
                const int rl = ai * HALF + wr * 64 + m * 16 + fr; const f32x2 sr = S[rl];
                f32x4 h[2];
#pragma unroll
                for (int n = 0; n < 2; ++n) {
                    const f32x4 g = (acc[ai][0][m][n] - csv[0][n] * sr.x) * sr.y + bwv[0][n];
                    const f32x4 uu = (acc[ai][1][m][n] - csv[1][n] * sr.x) * sr.y + bwv[1][n];
#pragma unroll
                    for (int j = 0; j < 4; ++j) h[n][j] = g[j] * __builtin_amdgcn_rcpf(1.0f + __builtin_amdgcn_exp2f(-1.4426950408889634f * g[j])) * uu[j];
                }
                u32x4 w; w.x = cvt_pk16(h[0][0], h[0][1]); w.y = cvt_pk16(h[0][2], h[0][3]); w.z = cvt_pk16(h[1][0], h[1][1]); w.w = cvt_pk16(h[1][2], h[1][3]);
                *(u32x4*)(H + (size_t)(row0 + ai * HALF + m * 16) * FF + hcol0) = w;
            }
    }
};
struct EpiY2 {
    static constexpr bool PERM = true, AFTER_DRAIN = false;
    const bf16_t* y1b; bf16_t* yb; const float* st1; float* st2; const float* lng; const float* lnb; PG8_LAS unsigned char* xl; float alpha, eps; int wid0;
    __device__ __forceinline__ void operator()(const f32x4 (&acc)[2][2][4][2], const Unit& u, int, int, int, int) const {
        const LaneId L_ = lane_id(wid0); const int wr = L_.wr, wc = L_.wc, fr = L_.fr, fq = L_.fq;
        stab_from_partials(st1, u.pm, xl, eps, wid0);
        const PG8_LAS f32x2* S = (const PG8_LAS f32x2*)(xl + (STAB_OFF - RING_BYTES));
        PG8_LAS f32x2* P = (PG8_LAS f32x2*)(xl + (PTAB_OFF - RING_BYTES));
        const int row0 = u.pm * BM + wr * 64 + fr, col0 = u.pn * BM + wc * 32 + 8 * fq;
        f32x4 gv[2][2], bv[2][2];
#pragma unroll
        for (int bj = 0; bj < 2; ++bj)
#pragma unroll
            for (int n = 0; n < 2; ++n) { gv[bj][n] = *(const f32x4*)(lng + col0 + bj * HALF + 4 * n); bv[bj][n] = *(const f32x4*)(lnb + col0 + bj * HALF + 4 * n); }
#pragma unroll
        for (int ai = 0; ai < 2; ++ai)
#pragma unroll
            for (int m = 0; m < 4; ++m) {
                const int rl = ai * HALF + wr * 64 + m * 16 + fr; const size_t off = (size_t)(row0 + ai * HALF + m * 16) * D + col0; const f32x2 sr = S[rl];
                float s = 0.f, q = 0.f;
#pragma unroll
                for (int bj = 0; bj < 2; ++bj) {
                    const u32x4 aw = *(const u32x4*)(y1b + off + bj * HALF); f32x4 a0, a1; PG8_UNPACK8(aw, a0, a1);
                    const f32x4 x0 = ((a0 - sr.x) * sr.y) * gv[bj][0] + bv[bj][0], x1 = ((a1 - sr.x) * sr.y) * gv[bj][1] + bv[bj][1];
                    const f32x4 y0 = x0 * alpha + acc[ai][bj][m][0], y1 = x1 * alpha + acc[ai][bj][m][1];
                    u32x4 w; PG8_PACK8(w, y0, y1);
                    *(u32x4*)(yb + off + bj * HALF) = w;
                    PG8_ROWSUM(s, q, y0); PG8_ROWSUM(s, q, y1);
                }
                { const int ln_ = fr + 16 * fq; s += shx(s, 16, ln_); q += shx(q, 16, ln_); s += shx(s, 32, ln_); q += shx(q, 32, ln_); }
                if (fq == 0) P[rl * 4 + wc] = (f32x2){s, q};
                asm volatile("" ::: "memory");
            }
        partials_to_st(st2, u, xl, wid0);
    }
};
struct EpiPLE {
    static constexpr bool PERM = true, AFTER_DRAIN = false;
    const bf16_t* y2b; float* out32; bf16_t* xb; const bf16_t* pp; const float* st2; const float* lng; const float* lnb; const float* cs; const float* bw; PG8_LAS unsigned char* xl; float eps; int wid0;
    __device__ __forceinline__ void operator()(const f32x4 (&acc)[2][2][4][2], const Unit& u, int, int, int, int) const {
        const LaneId L_ = lane_id(wid0); const int wr = L_.wr, wc = L_.wc, fr = L_.fr, fq = L_.fq;
        stab_from_partials(st2, u.pm, xl, eps, wid0);
        const PG8_LAS f32x2* S = (const PG8_LAS f32x2*)(xl + (STAB_OFF - RING_BYTES));
        const int row0 = u.pm * BM + wr * 64 + fr, col0 = u.pn * BM + wc * 32 + 8 * fq;
#pragma unroll
        for (int bj = 0; bj < 2; ++bj) {
            f32x4 gv[2], bv[2], csv[2], bwv[2];
#pragma unroll
            for (int n = 0; n < 2; ++n) { const int c = col0 + bj * HALF + 4 * n; gv[n] = *(const f32x4*)(lng + c); bv[n] = *(const f32x4*)(lnb + c); csv[n] = *(const f32x4*)(cs + c); bwv[n] = *(const f32x4*)(bw + c); }
#pragma unroll
            for (int ai = 0; ai < 2; ++ai)
#pragma unroll
                for (int m = 0; m < 4; ++m) {
                    const int rl = ai * HALF + wr * 64 + m * 16 + fr; const size_t off = (size_t)(row0 + ai * HALF + m * 16) * D + col0 + bj * HALF; const f32x2 sr = S[rl];
                    const u32x4 aw = *(const u32x4*)(y2b + off); const u32x4 pw = *(const u32x4*)(pp + off);
                    f32x4 a0, a1, p0, p1; PG8_UNPACK8(aw, a0, a1); PG8_UNPACK8(pw, p0, p1);
                    const f32x4 x0 = ((a0 - sr.x) * sr.y) * gv[0] + bv[0], x1 = ((a1 - sr.x) * sr.y) * gv[1] + bv[1];
                    const f32x4 t0 = (acc[ai][bj][m][0] - csv[0] * sr.x) * sr.y + bwv[0], t1 = (acc[ai][bj][m][1] - csv[1] * sr.x) * sr.y + bwv[1];
                    f32x4 o0, o1;
#pragma unroll
                    for (int j = 0; j < 4; ++j) { o0[j] = x0[j] + sigmoidf_(t0[j]) * p0[j]; o1[j] = x1[j] + sigmoidf_(t1[j]) * p1[j]; }
                    if (out32) { *(f32x4*)(out32 + off) = o0; *(f32x4*)(out32 + off + 4) = o1; }
                    else { u32x4 w; PG8_PACK8(w, o0, o1); *(u32x4*)(xb + off) = w; }
                    asm volatile("" ::: "memory");
                }
        }
    }
};
}
namespace pg8 {
template <class Epi, class Sched, bool ALIGN_EPI = false, bool SP2 = false>
__device__ __forceinline__ void gemm_phase(PG8_LAS unsigned char* lds, const Gemm g, const Sched& S, const Epi& E) {
    const int tid = opaque_tid(g.wid0), wid = g.wid0, lane = tid & 63, wr = wid >> 2, wc = wid & 3, fr = lane & 15, fq = lane >> 4;
    const int K = g.K, nt = K / BK;
    unsigned voffA[2], voffB[2];
#pragma unroll
    for (int i = 0; i < 2; ++i) { int R, C; stage_rc(tid * 16 + i * 8192, R, C); const int Rb = Epi::PERM ? ((R & ~31) + perm32(R & 31)) : R;
        voffA[i] = (unsigned)(R * K + C) * 2u; voffB[i] = (unsigned)(Rb * K + C) * 2u; }
    const size_t kstep = (size_t)(BK * 2);
    const size_t hstep = (size_t)HALF * K * 2;
    const size_t tstep = 2 * hstep;
    const unsigned ldsw = (unsigned)wid * 1024u;
    const int aoff = lds_byte(wr * 64 + fr, fq * 8), boff = lds_byte(wc * 32 + fr, fq * 8);
#define PG8_SA(b, h) (((b) * 2 + (h)) * HTB)
#define PG8_SB(b, h) ((4 + (b) * 2 + (h)) * HTB)
#define PG8_STAGE(bufoff, gbase, voff) do { _Pragma("unroll") for (int _i = 0; _i < 2; ++_i) \
        __builtin_amdgcn_global_load_lds((const unsigned*)((const char*)(gbase) + (voff)[_i]), (PG8_LAS unsigned*)(lds + (bufoff) + ldsw + _i * 8192), 16, 0, 0); } while (0)
#define PG8_LDA(dst, b, h) do { _Pragma("unroll") for (int m = 0; m < 4; ++m) _Pragma("unroll") for (int k = 0; k < 2; ++k) dst[m][k] = *(const PG8_LAS bf16x8*)(lds + PG8_SA(b, h) + aoff + m * 2048 + k * 1024); } while (0)
#define PG8_LDB(dst, b, h) do { _Pragma("unroll") for (int n = 0; n < 2; ++n) _Pragma("unroll") for (int k = 0; k < 2; ++k) dst[n][k] = *(const PG8_LAS bf16x8*)(lds + PG8_SB(b, h) + boff + n * 2048 + k * 1024); } while (0)
#define PG8_MMA(ai, bj, At, Bt) do { __builtin_amdgcn_s_setprio(1); _Pragma("unroll") for (int m = 0; m < 4; ++m) _Pragma("unroll") for (int n = 0; n < 2; ++n) _Pragma("unroll") for (int k = 0; k < 2; ++k) \
        acc[ai][bj][m][n] = PG8_MFMA16(Bt[n][k], At[m][k], acc[ai][bj][m][n]); __builtin_amdgcn_s_setprio(0); } while (0)
#define PG8_WAIT_V(n) asm volatile("s_waitcnt vmcnt(" #n ")" ::: "memory")
#define PG8_WAIT_L(n) asm volatile("s_waitcnt lgkmcnt(" #n ")" ::: "memory")
#define PG8_BAR __builtin_amdgcn_s_barrier()
#define PG8_SCHED __builtin_amdgcn_sched_barrier(0)
    Unit cur, nxt; int ui = 0;
    if (!S.next(0, cur)) return;
    f32x4 acc[2][2][4][2];
#pragma unroll
    for (int a = 0; a < 2; ++a)
#pragma unroll
        for (int b = 0; b < 2; ++b)
#pragma unroll
            for (int m = 0; m < 4; ++m)
#pragma unroll
                for (int n = 0; n < 2; ++n) acc[a][b][m][n] = (f32x4){0.f, 0.f, 0.f, 0.f};
    bf16x8 At[4][2], B0[2][2], B1[2][2];
    const char* cA = (const char*)g.A + (size_t)cur.pm * tstep; const char* cB = (const char*)g.Bt + (size_t)cur.pn * tstep;
    S.a_ready(cur);
    if constexpr (SP2) {
        PG8_STAGE(PG8_SB(0, 0), cB, voffB); PG8_STAGE(PG8_SB(0, 1), cB + hstep, voffB); PG8_STAGE(PG8_SA(0, 0), cA, voffA); PG8_STAGE(PG8_SA(0, 1), cA + hstep, voffA);
        if (wr == 1) PG8_BAR;
        PG8_WAIT_V(2); PG8_BAR;
        PG8_STAGE(PG8_SB(1, 0), cB + kstep, voffB); PG8_STAGE(PG8_SA(1, 0), cA + kstep, voffA); PG8_STAGE(PG8_SB(1, 1), cB + hstep + kstep, voffB);
        PG8_WAIT_V(6); PG8_BAR;
    } else {
        PG8_STAGE(PG8_SB(0, 0), cB, voffB); PG8_STAGE(PG8_SA(0, 0), cA, voffA); PG8_STAGE(PG8_SB(0, 1), cB + hstep, voffB); PG8_STAGE(PG8_SA(0, 1), cA + hstep, voffA);
        if (wr == 1) PG8_BAR;
        PG8_WAIT_V(4); PG8_BAR;
        PG8_STAGE(PG8_SB(1, 0), cB + kstep, voffB); PG8_STAGE(PG8_SA(1, 0), cA + kstep, voffA); PG8_STAGE(PG8_SB(1, 1), cB + hstep + kstep, voffB);
        PG8_WAIT_V(6); PG8_BAR;
    }
    for (;;) {
        const bool has_next = S.next(ui + 1, nxt);
        const char* nA = has_next ? (const char*)g.A + (size_t)nxt.pm * tstep : cA; const char* nB = has_next ? (const char*)g.Bt + (size_t)nxt.pn * tstep : cB;
        for (int t = 0; t < nt; t += 2) {
            const bool last = (t == nt - 2);
            const char* a1 = cA + (size_t)(t + 1) * kstep;
            const char* a2 = last ? nA : cA + (size_t)(t + 2) * kstep; const char* b2 = last ? nB : cB + (size_t)(t + 2) * kstep;
            const char* a3 = a2 + kstep; const char* b3 = b2 + kstep;
            if (last && has_next) S.a_ready(nxt);
            if constexpr (SP2) {
            PG8_LDB(B0, 0, 0); PG8_LDB(B1, 0, 1); PG8_SCHED; PG8_LDA(At, 0, 0); PG8_STAGE(PG8_SA(1, 1), a1 + hstep, voffA);
            PG8_WAIT_V(8); PG8_WAIT_L(0); PG8_BAR; PG8_MMA(0, 0, At, B0); PG8_MMA(0, 1, At, B1); PG8_BAR; PG8_SCHED;
            PG8_LDA(At, 0, 1); PG8_STAGE(PG8_SB(0, 0), b2, voffB); PG8_STAGE(PG8_SB(0, 1), b2 + hstep, voffB); PG8_STAGE(PG8_SA(0, 0), a2, voffA);
            PG8_WAIT_V(8); PG8_WAIT_L(0); PG8_BAR; PG8_MMA(1, 0, At, B0); PG8_MMA(1, 1, At, B1); PG8_BAR; PG8_SCHED;
            PG8_LDB(B0, 1, 0); PG8_LDB(B1, 1, 1); PG8_SCHED; PG8_LDA(At, 1, 0); PG8_STAGE(PG8_SA(0, 1), a2 + hstep, voffA);
            PG8_WAIT_V(8); PG8_WAIT_L(0); PG8_BAR; PG8_MMA(0, 0, At, B0); PG8_MMA(0, 1, At, B1); PG8_BAR; PG8_SCHED;
            PG8_LDA(At, 1, 1); PG8_STAGE(PG8_SB(1, 0), b3, voffB); PG8_STAGE(PG8_SB(1, 1), b3 + hstep, voffB); PG8_STAGE(PG8_SA(1, 0), a3, voffA);
            PG8_WAIT_V(8); PG8_WAIT_L(0); PG8_BAR; PG8_MMA(1, 0, At, B0); PG8_MMA(1, 1, At, B1); PG8_BAR; PG8_SCHED;
            } else {
            PG8_LDB(B0, 0, 0); PG8_SCHED; PG8_LDA(At, 0, 0); PG8_STAGE(PG8_SA(1, 1), a1 + hstep, voffA);
            PG8_WAIT_L(8); PG8_BAR; PG8_WAIT_L(0); PG8_MMA(0, 0, At, B0); PG8_BAR; PG8_SCHED;
            PG8_LDB(B1, 0, 1); PG8_STAGE(PG8_SB(0, 0), b2, voffB);
            PG8_BAR; PG8_WAIT_L(0); PG8_MMA(0, 1, At, B1); PG8_BAR;
            PG8_LDA(At, 0, 1); PG8_STAGE(PG8_SA(0, 0), a2, voffA);
            PG8_BAR; PG8_WAIT_L(0); PG8_MMA(1, 0, At, B0); PG8_BAR; PG8_SCHED;
            PG8_STAGE(PG8_SB(0, 1), b2 + hstep, voffB);
            PG8_WAIT_V(6); PG8_BAR; PG8_MMA(1, 1, At, B1); PG8_BAR;
            PG8_LDB(B0, 1, 0); PG8_SCHED; PG8_LDA(At, 1, 0); PG8_STAGE(PG8_SA(0, 1), a2 + hstep, voffA);
            PG8_WAIT_L(8); PG8_BAR; PG8_WAIT_L(0); PG8_MMA(0, 0, At, B0); PG8_BAR; PG8_SCHED;
            PG8_LDB(B1, 1, 1); PG8_STAGE(PG8_SB(1, 0), b3, voffB);
            PG8_BAR; PG8_WAIT_L(0); PG8_MMA(0, 1, At, B1); PG8_BAR;
            PG8_LDA(At, 1, 1); PG8_STAGE(PG8_SA(1, 0), a3, voffA);
            PG8_BAR; PG8_WAIT_L(0); PG8_MMA(1, 0, At, B0); PG8_BAR; PG8_SCHED;
            PG8_STAGE(PG8_SB(1, 1), b3 + hstep, voffB);
            PG8_WAIT_V(6); PG8_BAR; PG8_MMA(1, 1, At, B1); PG8_BAR;
            }
        }
        if constexpr (ALIGN_EPI) { if (wr == 0) PG8_BAR; }
        if constexpr (!Epi::AFTER_DRAIN) { E(acc, cur, wr, wc, fr, fq); S.done(cur); }
        if (!has_next) break;
#pragma unroll
        for (int a = 0; a < 2; ++a)
#pragma unroll
            for (int b = 0; b < 2; ++b)
#pragma unroll
                for (int m = 0; m < 4; ++m)
#pragma unroll
                    for (int n = 0; n < 2; ++n) acc[a][b][m][n] = (f32x4){0.f, 0.f, 0.f, 0.f};
        cur = nxt; cA = nA; cB = nB; ++ui;
        if constexpr (ALIGN_EPI) { if (wr == 1) PG8_BAR; }
    }
    PG8_WAIT_V(0);
    if constexpr (!ALIGN_EPI) { if (wr == 0) PG8_BAR; }
    PG8_BAR;
    if constexpr (Epi::AFTER_DRAIN) { E.fused(acc, cur, wr, wc, fr, fq, lds, wid, lane); S.done(cur); }
#undef PG8_SA
#undef PG8_SB
#undef PG8_STAGE
#undef PG8_LDA
#undef PG8_LDB
#undef PG8_MMA
#undef PG8_WAIT_V
#undef PG8_WAIT_L
#undef PG8_BAR
#undef PG8_SCHED
}
}
#define XB_TMO      128
#define XB_XCNT(j)  (256  + 64 * (j))
#define XB_XSUB(j)  (1280 + 64 * (j))
#define XB_XGEN(j)  (2304 + 64 * (j))
#define XB_TOP      3328
#define XB_TOPGEN   3392
#define XCD_BAR_WORDS 3456
#define XB_SPIN_CAP (1u << 18)

__device__ __forceinline__ unsigned xb_ld(unsigned* p)              { return __hip_atomic_load(p, __ATOMIC_RELAXED, __HIP_MEMORY_SCOPE_AGENT); }
__device__ __forceinline__ unsigned xb_add(unsigned* p, unsigned v) { return __hip_atomic_fetch_add(p, v, __ATOMIC_RELAXED, __HIP_MEMORY_SCOPE_AGENT); }
__device__ __forceinline__ unsigned xb_xcc_id() { return (unsigned)__builtin_amdgcn_s_getreg((3 << 11) | 20) & 0xFu; }
#define XB_SPIN(cond, bar) do { unsigned _sp = 0; while (cond) { __builtin_amdgcn_s_sleep(1); \
    if ((++_sp & 255u) == 0u) { if (xb_ld(&(bar)[XB_TMO])) break; if (_sp > XB_SPIN_CAP) { atomicAdd(&(bar)[XB_TMO], 1u); break; } } } } while (0)

struct XcdBarrier {
    int wid0;
    unsigned* bar; unsigned x;
    volatile LAS unsigned* st;
};

__device__ __forceinline__ XcdBarrier xcd_barrier_post(unsigned* bar, volatile LAS unsigned* st) {
    XcdBarrier b; b.bar = bar; b.x = xb_xcc_id(); b.st = st;
    if (threadIdx.x == 0) (void)xb_add(&bar[XB_XCNT(b.x)], 1u);
    return b;
}
__device__ __forceinline__ void xcd_barrier_complete(unsigned* bar, unsigned x, unsigned& nloc, unsigned& nx) {
    const unsigned G = gridDim.x * gridDim.y * gridDim.z;
    unsigned sum, cnt, mine, sp = 0u;
    for (;;) {
        sum = 0u; cnt = 0u; mine = 0u;
#pragma unroll
        for (unsigned j = 0; j < 16; ++j) { const unsigned c = xb_ld(&bar[XB_XCNT(j)]); sum += c; cnt += (c > 0u) ? 1u : 0u; mine = (j == x) ? c : mine; }
        if (sum == G) break;
        __builtin_amdgcn_s_sleep(1);
        if ((++sp & 255u) == 0u) { if (xb_ld(&bar[XB_TMO])) break; if (sp > XB_SPIN_CAP) { atomicAdd(&bar[XB_TMO], 1u); break; } }
    }
    nloc = mine > 0u ? mine : 1u; nx = cnt > 0u ? cnt : 1u;
}

__device__ __forceinline__ void xcd_barrier(const XcdBarrier& b) {
    asm volatile("s_waitcnt vmcnt(0)" ::: "memory");
    __syncthreads();
    if (opaque_tid(b.wid0) == 0) {
        unsigned* bar = b.bar;
        __builtin_amdgcn_s_waitcnt(0);
        unsigned nloc = b.st[0], nx = b.st[1];
        if (nloc == 0u) { xcd_barrier_complete(bar, b.x, nloc, nx); b.st[0] = nloc; b.st[1] = nx; }
        const unsigned old = xb_add(&bar[XB_XSUB(b.x)], 1u);
        const unsigned gen = old / nloc;
        if (old + 1u == (gen + 1u) * nloc) {
            __builtin_amdgcn_fence(__ATOMIC_RELEASE, "agent");
            asm volatile("s_waitcnt vmcnt(0)" ::: "memory");
            const unsigned og = xb_add(&bar[XB_TOP], 1u);
            const unsigned tg = og / nx;
            if (og + 1u == (tg + 1u) * nx) xb_add(&bar[XB_TOPGEN], 1u);
            else XB_SPIN(xb_ld(&bar[XB_TOPGEN]) == tg, bar);
            __builtin_amdgcn_fence(__ATOMIC_ACQUIRE, "agent");
            xb_add(&bar[XB_XGEN(b.x)], 1u);
            asm volatile("s_waitcnt vmcnt(0)" ::: "memory");
        } else {
            XB_SPIN(xb_ld(&bar[XB_XGEN(b.x)]) == gen, bar);
            __builtin_amdgcn_fence(__ATOMIC_ACQUIRE, "agent");
            asm volatile("s_waitcnt vmcnt(0)" ::: "memory");
        }
    }
    __syncthreads();
}

__device__ const float kInvFreq[16] = {1.000000000e+00f, 4.403665960e-01f, 1.939227432e-01f, 8.539710194e-02f, 3.760603070e-02f, 1.656044088e-02f, 7.292664610e-03f, 3.211446106e-03f,
                                       1.414213562e-03f, 6.227724371e-04f, 2.742481884e-04f, 1.207697351e-04f, 5.318295734e-05f, 2.341999971e-05f, 1.031338525e-05f, 4.541670478e-06f};

__device__ __forceinline__ void sincos_f64(float angf, float& so, float& co) {
    const double a = (double)angf;
    const double k = __builtin_rint(a * 0.63661977236758134308);
    const double r = __builtin_fma(-k, 6.123233995736766e-17, __builtin_fma(-k, 1.5707963267948966, a));
    const double r2 = r * r;
    double s = -7.6471637318198164759e-13; s = s * r2 + 1.6059043836821614599e-10; s = s * r2 - 2.5052108385441718775e-8; s = s * r2 + 2.7557319223985890653e-6;
    s = s * r2 - 1.9841269841269841270e-4; s = s * r2 + 8.3333333333333333333e-3; s = s * r2 - 1.6666666666666666667e-1; s = s * r2 * r + r;
    double c = 4.7794773323873852974e-14; c = c * r2 - 1.1470745597729724714e-11; c = c * r2 + 2.0876756987868098979e-9; c = c * r2 - 2.7557319223985890653e-7;
    c = c * r2 + 2.4801587301587301587e-5; c = c * r2 - 1.3888888888888888889e-3; c = c * r2 + 4.1666666666666666667e-2; c = c * r2 - 0.5; c = c * r2 + 1.0;
    const int q = (int)((long long)k & 3);
    const double sv = (q == 0) ? s : (q == 1) ? c : (q == 2) ? -s : -c;
    const double cv = (q == 0) ? c : (q == 1) ? -s : (q == 2) ? -c : s;
    so = (float)sv; co = (float)cv;
}

struct TJob { const float* W; int K, N; bf16* WT; int mode; const float* g; const float* b; float* pcs; float* pbw; };
__device__ __forceinline__ void tr_item(const TJob& J, LAS float* scr, int item, int lane) {
    const int nblk = J.N / 32, kb = item / nblk, nb = item - kb * nblk, k0 = 64 * kb, n0 = 32 * nb;
#pragma unroll 8
    for (int i = 0; i < 32; ++i) { const int kk = 2 * i + (lane >> 5); scr[kk * 33 + (lane & 31)] = J.W[(size_t)(k0 + kk) * J.N + n0 + (lane & 31)]; }
    LDS_WAIT(); asm volatile("" ::: "memory");
    int drow0 = n0;
    if (J.mode == 2) { const int isup = n0 >= FF ? 1 : 0, hc = n0 - isup * FF; drow0 = 256 * (hc >> 7) + 128 * isup + (hc & 127); }
    const int c = lane & 7;
    float gk[8];
#pragma unroll
    for (int j = 0; j < 8; ++j) gk[j] = J.mode ? J.g[k0 + 8 * c + j] : 1.0f;
#pragma unroll
    for (int j = 0; j < 4; ++j) { const int n = (lane >> 3) + 8 * j; const LAS float* s = scr + (8 * c) * 33 + n;
        v4u o; o.x = pk2(s[0 * 33] * gk[0], s[1 * 33] * gk[1]); o.y = pk2(s[2 * 33] * gk[2], s[3 * 33] * gk[3]); o.z = pk2(s[4 * 33] * gk[4], s[5 * 33] * gk[5]); o.w = pk2(s[6 * 33] * gk[6], s[7 * 33] * gk[7]);
        *(GAS v4u*)(J.WT + (size_t)(drow0 + n) * J.K + k0 + 8 * c) = o; }
    if (J.mode) {
        float cs = 0.f, bw = 0.f; const int kh = (lane >> 5) * 32;
#pragma unroll 8
        for (int t = 0; t < 32; ++t) { const int kk = kh + t; const float w = scr[kk * 33 + (lane & 31)]; cs += bf_round(w * J.g[k0 + kk]); bw += w * J.b[k0 + kk]; }
        cs += shx(cs, 32, lane); bw += shx(bw, 32, lane);
        if (lane < 32) { J.pcs[(size_t)kb * J.N + drow0 + lane] = cs; J.pbw[(size_t)kb * J.N + drow0 + lane] = bw; }
    }
    LDS_WAIT(); asm volatile("" ::: "memory");
}

struct Args { const float* in[20]; float* out; unsigned char* ws; int ph_lo, ph_hi; };
#define CAS __attribute__((address_space(4)))
__device__ __forceinline__ const unsigned char CAS* kargs_() { const unsigned char CAS* p = (const unsigned char CAS*)__builtin_amdgcn_kernarg_segment_ptr(); asm volatile("" : "+s"(p)); return p; }
__device__ __forceinline__ const float* arg_in(int i) { return (const float*)(const GAS float*)*(const float* const CAS*)(kargs_() + 8 * i); }
__device__ __forceinline__ float* arg_out() { return (float*)(GAS float*)*(float* const CAS*)(kargs_() + 160); }
__device__ __forceinline__ unsigned char* arg_ws() { return (unsigned char*)(GAS unsigned char*)*(unsigned char* const CAS*)(kargs_() + 168); }
static_assert(sizeof(Args) == 184, "Args layout");

__device__ __forceinline__ TJob make_job(int id) {
    unsigned char* ws = arg_ws(); float* part = (float*)(ws + WS_PART);
    TJob J; J.mode = 0; J.g = nullptr; J.b = nullptr; J.pcs = nullptr; J.pbw = nullptr;
    switch (id) {
    case 0: J.W = arg_in(4); J.K = D; J.N = HW; J.WT = (bf16*)(ws + WS_W_IN); break;
    case 1: J.W = arg_in(9); J.K = D; J.N = D; J.WT = (bf16*)(ws + WS_W_OA); break;
    case 2: J.W = arg_in(10); J.K = D; J.N = NQKV; J.WT = (bf16*)(ws + WS_W_QKV); break;
    case 3: J.W = arg_in(11); J.K = AW; J.N = D; J.WT = (bf16*)(ws + WS_W_OB); break;
    case 4: case 5: { const int l = id - 4; J.W = arg_in(14) + (size_t)l * D * NGU; J.K = D; J.N = NGU; J.WT = (bf16*)(ws + WS_W_GU + l * W_GU_STRIDE); J.mode = 2;
        J.g = arg_in(12) + l * D; J.b = arg_in(13) + l * D; J.pcs = part + PART_GU + l * PART_GU_L; J.pbw = J.pcs + (size_t)KB32 * NGU; break; }
    case 6: case 7: { const int l = id - 6; J.W = arg_in(15) + (size_t)l * FF * D; J.K = FF; J.N = D; J.WT = (bf16*)(ws + WS_W_DN + l * W_DN_STRIDE); break; }
    case 8: case 9: { const int l = id - 8; J.W = arg_in(18) + (size_t)l * D * D; J.K = D; J.N = D; J.WT = (bf16*)(ws + WS_W_GT + l * W_GT_STRIDE); J.mode = 1;
        J.g = arg_in(16) + l * D; J.b = arg_in(17) + l * D; J.pcs = part + PART_GT + l * PART_GT_L; J.pbw = J.pcs + (size_t)KB32 * D; break; }
    default: { const int l = id - 10; J.W = arg_in(19) + (size_t)l * PLE * D; J.K = PLE; J.N = D; J.WT = (bf16*)(ws + WS_W_PJ + l * W_PJ_STRIDE); break; }
    }
    return J;
}
__device__ __forceinline__ int job_items(int id) {
    switch (id) { case 0: return (D / 64) * (HW / 32); case 1: return (D / 64) * (D / 32); case 2: return (D / 64) * (NQKV / 32); case 3: return (AW / 64) * (D / 32);
        case 4: case 5: return (D / 64) * (NGU / 32); case 6: case 7: return (FF / 64) * (D / 32); case 8: case 9: return (D / 64) * (D / 32); default: return (PLE / 64) * (D / 32); }
}

__device__ __forceinline__ void conv_bf16(const float* src, bf16* dst, size_t n8, size_t gt, size_t nthr) {
    for (size_t i = gt; i < n8; i += nthr) {
        const f32x4 a = *(const GAS f32x4*)(src + 8 * i), b = *(const GAS f32x4*)(src + 8 * i + 4);
        v4u o; o.x = pk2(a[0], a[1]); o.y = pk2(a[2], a[3]); o.z = pk2(b[0], b[1]); o.w = pk2(b[2], b[3]);
        *(GAS v4u*)(dst + 8 * i) = o;
    }
}

__device__ __forceinline__ void prologue_phase(LAS unsigned char* lds, int G, int wid0) {
    const int tid = opaque_tid(wid0), lane = tid & 63, wave = tid >> 6;
    LAS float* scr = (LAS float*)(lds + wave * 16384);
    const int gw = blockIdx.x * NWAVES + wave, NGW = G * NWAVES;
#pragma unroll 1
    for (int id = 0; id < 12; ++id) {
        const TJob J = make_job(id); const int ni = job_items(id);
#pragma unroll 1
        for (int it = gw; it < ni; it += NGW) tr_item(J, scr, it, lane);
    }
    const size_t gt = (size_t)blockIdx.x * 512 + tid, nthr = (size_t)G * 512;
    conv_bf16(arg_in(7), (bf16*)(arg_ws() + WS_W_S), (size_t)16 * 128 * 128 / 8, gt, nthr);
    float* rot = (float*)(arg_ws() + WS_ROT);
    for (size_t i = gt; i < (size_t)16384 * 16; i += nthr) { const int pos = (int)(i >> 4), f = (int)(i & 15); float s, c; sincos_f64((float)pos * kInvFreq[f], s, c); rot[pos * 32 + f] = c; rot[pos * 32 + 16 + f] = s; }
}
__device__ __forceinline__ void finalize_vecs(int G, int wid0) {
    const float* part = (const float*)(arg_ws() + WS_PART); float* vec = (float*)(arg_ws() + WS_VEC);
    const int gt = blockIdx.x * 512 + opaque_tid(wid0), nthr = G * 512;
    for (int i = gt; i < 2 * 2 * NGU; i += nthr) {
        const float* p = part + PART_GU + (size_t)(i / NGU) * KB32 * NGU + (i % NGU); float s = 0.f;
        for (int kb = 0; kb < KB32; ++kb) s += p[(size_t)kb * NGU];
        vec[VEC_GU + i] = s;
    }
    for (int i = gt; i < 2 * 2 * D; i += nthr) {
        const float* p = part + PART_GT + (size_t)(i / D) * KB32 * D + (i % D); float s = 0.f;
        for (int kb = 0; kb < KB32; ++kb) s += p[(size_t)kb * D];
        vec[VEC_GT + i] = s;
    }
}

__device__ __forceinline__ void sgu_phase(LAS unsigned char* lds, const bf16* H, bf16* GATED, const bf16* WS, const float* bs, const float* lng, const float* lnb, int G, int wid0) {
    const int tid = opaque_tid(wid0), lane = tid & 63, wave = tid >> 6, i16 = lane & 15, kq = lane >> 4;
    LAS f32x2v* SV = (LAS f32x2v*)(lds + STAB_OFF);
#pragma unroll 1
    for (int chunk = blockIdx.x; chunk < MG / 128; chunk += G) {
        const size_t row0 = (size_t)chunk * 128;
#pragma unroll 1
        for (int rr = 0; rr < 16; ++rr) {
            const int r = wave * 16 + rr; const bf16* vrow = H + (row0 + r) * HW + D;
            v4u d[4]; float x[32]; float s = 0.f;
#pragma unroll
            for (int j = 0; j < 4; ++j) d[j] = *(const GAS v4u*)(vrow + 8 * (lane + 64 * j));
#pragma unroll
            for (int j = 0; j < 4; ++j) { x[8 * j + 0] = bf_lo(d[j].x); x[8 * j + 1] = bf_hi(d[j].x); x[8 * j + 2] = bf_lo(d[j].y); x[8 * j + 3] = bf_hi(d[j].y);
                x[8 * j + 4] = bf_lo(d[j].z); x[8 * j + 5] = bf_hi(d[j].z); x[8 * j + 6] = bf_lo(d[j].w); x[8 * j + 7] = bf_hi(d[j].w); }
#pragma unroll
            for (int j = 0; j < 32; ++j) s += x[j];
            const float mean = wave_sum(s, lane) * (1.0f / D); float s2 = 0.f;
#pragma unroll
            for (int j = 0; j < 32; ++j) { const float t = x[j] - mean; s2 += t * t; }
            const float rstd = 1.0f / sqrtf(wave_sum(s2, lane) * (1.0f / D) + LN_EPS);
            if (lane == 0) SV[r] = (f32x2v){mean, rstd};
        }
        WG_BAR();
        const int p = 16 * wave + i16;
#pragma unroll 1
        for (int g = 0; g < 16; ++g) {
            LAS unsigned char* img = lds + (g & 1) * 32768;
#pragma unroll
            for (int n = 0; n < 4; ++n) {
                const int id = tid + 512 * n, q = id >> 4, ch = id & 15; const int c0 = g * 128 + ch * 8;
                const v4u d = *(const GAS v4u*)(H + (row0 + q) * HW + D + c0);
                const f32x2v sr = SV[q];
                const f32x4 g0 = *(const GAS f32x4*)(lng + c0), g1 = *(const GAS f32x4*)(lng + c0 + 4), b0 = *(const GAS f32x4*)(lnb + c0), b1 = *(const GAS f32x4*)(lnb + c0 + 4);
                f32x4 x0, x1; x0[0] = bf_lo(d.x); x0[1] = bf_hi(d.x); x0[2] = bf_lo(d.y); x0[3] = bf_hi(d.y); x1[0] = bf_lo(d.z); x1[1] = bf_hi(d.z); x1[2] = bf_lo(d.w); x1[3] = bf_hi(d.w);
                x0 = ((x0 - sr.x) * sr.y) * g0 + b0; x1 = ((x1 - sr.x) * sr.y) * g1 + b1;
                v4u o; o.x = pk2(x0[0], x0[1]); o.y = pk2(x0[2], x0[3]); o.z = pk2(x1[0], x1[1]); o.w = pk2(x1[2], x1[3]);
                *(LAS v4u*)(img + off_b(q, ch)) = o;
            }
            bf16x8 wf[4];
#pragma unroll
            for (int s = 0; s < 4; ++s) wf[s] = *(const GAS bf16x8*)(WS + ((size_t)(g * 128 + p)) * 128 + 32 * s + 8 * kq);
            const float bias = bs[g * 128 + p];
            WG_BAR();
            f32x4 acc[8];
#pragma unroll
            for (int ct = 0; ct < 8; ++ct) {
                f32x4 c4 = (f32x4){0.f, 0.f, 0.f, 0.f};
#pragma unroll
                for (int s = 0; s < 4; ++s) {
                    const unsigned qq = (unsigned)(i16 >> 2), pp = (unsigned)(lane & 3);
                    const s16x4 lo = tr_read(img + off_b(32 * s + 8 * kq + qq, 2 * ct + (pp >> 1)) + 8 * (pp & 1));
                    const s16x4 hi = tr_read(img + off_b(32 * s + 8 * kq + 4 + qq, 2 * ct + (pp >> 1)) + 8 * (pp & 1));
                    const bf16x8 af = __builtin_shufflevector(lo, hi, 0, 1, 2, 3, 4, 5, 6, 7);
                    c4 = PG8_MFMA16(af, wf[s], c4);
                }
                acc[ct] = c4;
            }
#pragma unroll
            for (int ct = 0; ct < 8; ++ct) {
                const int c = g * 128 + 16 * ct + 4 * kq;
                const v2u uw = *(const GAS v2u*)(H + (row0 + p) * HW + c);
                const float o0 = (acc[ct][0] + bias) * bf_lo(uw.x), o1 = (acc[ct][1] + bias) * bf_hi(uw.x), o2 = (acc[ct][2] + bias) * bf_lo(uw.y), o3 = (acc[ct][3] + bias) * bf_hi(uw.y);
                v2u ow; ow.x = pk2(o0, o1); ow.y = pk2(o2, o3);
                *(GAS v2u*)(GATED + (row0 + p) * D + c) = ow;
            }
        }
        WG_BAR();
    }
}

__device__ __forceinline__ void attn_phase(LAS unsigned char* lds, bf16* QKV, float* LSE, int S, int G, bool dry, int wid0) {
    const int tid = opaque_tid(wid0), lane = tid & 63, wave = tid >> 6, iq = lane & 15, kq = lane >> 4;
    LAS unsigned char* Kimg = lds; LAS unsigned char* Vimg = lds + 65536;
    const int tps = S >> 7;
#pragma unroll 1
    for (int u = blockIdx.x; u < 3 * 8 * (MG / 128); u += G) {
        const int g = u / (8 * (MG / 128)), rem = u - g * (8 * (MG / 128)), h = rem & 7, ts = rem >> 3;
        const int ldil = 2 * g, dil = 1 << ldil;
        const int b = ts / tps, wslot = ts - b * tps;
        const int L = S >> ldil, tpr = L >> 7;
        const int r = wslot / tpr, it = wslot - r * tpr, i0 = it * 128;
        const size_t tok0 = (size_t)b * S + r;
        bf16* Qb = QKV + g * 3072 + h * 128; const bf16* Kb = Qb + 1024; const bf16* Vb = Qb + 2048;
#pragma unroll
        for (int n = 0; n < 8; ++n) {
            const int id = tid + 512 * n, kl = id >> 4, ch = id & 15, j = i0 - 64 + kl;
            v4u kv = (v4u){0u, 0u, 0u, 0u}, vv = (v4u){0u, 0u, 0u, 0u};
            if (j >= 0 && j < L) { const size_t off = (tok0 + (size_t)j * dil) * NQKV + ch * 8; kv = *(const GAS v4u*)(Kb + off); vv = *(const GAS v4u*)(Vb + off); }
            *(LAS v4u*)(Kimg + off_b(kl, ch)) = kv; *(LAS v4u*)(Vimg + off_b(kl, ch)) = vv;
        }
        const int qi = i0 + 16 * wave + iq; const size_t qtok = tok0 + (size_t)qi * dil;
        bf16x8 qf[4];
#pragma unroll
        for (int s = 0; s < 4; ++s) qf[s] = *(const GAS bf16x8*)(Qb + qtok * NQKV + 32 * s + 8 * kq);
        WG_BAR();
        f32x4 st[9];
#pragma unroll
        for (int T = 0; T < 9; ++T) {
            f32x4 c4 = (f32x4){0.f, 0.f, 0.f, 0.f};
#pragma unroll
            for (int s = 0; s < 4; ++s) { const bf16x8 kf = *(const LAS bf16x8*)(Kimg + off_b(16 * wave + 16 * T + iq, 4 * s + kq)); c4 = PG8_MFMA16(kf, qf[s], c4); }
            st[T] = c4;
        }
        float mx = -3.0e38f;
#pragma unroll
        for (int T = 0; T < 9; ++T)
#pragma unroll
            for (int e = 0; e < 4; ++e) { const int kr = 16 * T + 4 * kq + e - iq, j = i0 + 16 * wave - 64 + 16 * T + 4 * kq + e;
                const bool ok = (kr >= 0) && (kr <= 128) && (j >= 0) && (j < L); st[T][e] = ok ? st[T][e] : -1.0e30f; mx = fmaxf(mx, st[T][e]); }
        mx = fmaxf(mx, shx(mx, 16, lane)); mx = fmaxf(mx, shx(mx, 32, lane));
        float den = 0.f;
#pragma unroll
        for (int T = 0; T < 9; ++T)
#pragma unroll
            for (int e = 0; e < 4; ++e) { const float pv = fast_exp2(st[T][e] - mx); st[T][e] = pv; den += pv; }
        den += shx(den, 16, lane); den += shx(den, 32, lane);
        bf16x8 pf[5];
#pragma unroll
        for (int s2 = 0; s2 < 5; ++s2) {
            v4u w; w.x = pk2(st[2 * s2][0], st[2 * s2][1]); w.y = pk2(st[2 * s2][2], st[2 * s2][3]);
            if (s2 < 4) { w.z = pk2(st[2 * s2 + 1][0], st[2 * s2 + 1][1]); w.w = pk2(st[2 * s2 + 1][2], st[2 * s2 + 1][3]); } else { w.z = 0u; w.w = 0u; }
            pf[s2] = __builtin_bit_cast(bf16x8, w);
        }
        const float inv = 1.0f / den;
        const unsigned qq = (unsigned)(iq >> 2), pp = (unsigned)(lane & 3);
#pragma unroll
        for (int c = 0; c < 8; ++c) {
            f32x4 o4 = (f32x4){0.f, 0.f, 0.f, 0.f};
#pragma unroll
            for (int s2 = 0; s2 < 5; ++s2) {
                unsigned r0 = 16 * wave + 32 * s2 + 4 * kq + qq, r1 = r0 + 16; r1 = r1 > 255u ? 255u : r1;
                const s16x4 lo = tr_read(Vimg + off_b(r0, 2 * c + (pp >> 1)) + 8 * (pp & 1));
                const s16x4 hi = tr_read(Vimg + off_b(r1, 2 * c + (pp >> 1)) + 8 * (pp & 1));
                const bf16x8 vf = __builtin_shufflevector(lo, hi, 0, 1, 2, 3, 4, 5, 6, 7);
                o4 = PG8_MFMA16(vf, pf[s2], o4);
            }
            v2u ow; ow.x = pk2(o4[0] * inv, o4[1] * inv); ow.y = pk2(o4[2] * inv, o4[3] * inv);
            if (!dry) *(GAS v2u*)(Qb + qtok * NQKV + 16 * c + 4 * kq) = ow;
        }
        if (kq == 0 && !dry) LSE[(qtok * 3 + g) * 8 + h] = (mx + __builtin_amdgcn_logf(den)) * LN2;
        WG_BAR();
    }
}
__device__ __forceinline__ void combine_phase(const bf16* QKV, const float* LSE, bf16* ATT, int G, int wid0) {
    const size_t gt = (size_t)blockIdx.x * 512 + opaque_tid(wid0), nthr = (size_t)G * 512;
    for (size_t i = gt; i < (size_t)MG * 128; i += nthr) {
        const size_t t = i >> 7; const int ch = (int)(i & 127), h = ch >> 4;
        const float l0 = LSE[(t * 3 + 0) * 8 + h], l1 = LSE[(t * 3 + 1) * 8 + h], l2 = LSE[(t * 3 + 2) * 8 + h];
        const float m = fmaxf(l0, fmaxf(l1, l2));
        float w0 = fast_exp2((l0 - m) * 1.4426950408889634f), w1 = fast_exp2((l1 - m) * 1.4426950408889634f), w2 = fast_exp2((l2 - m) * 1.4426950408889634f);
        const float inv = 1.0f / (w0 + w1 + w2); w0 *= inv; w1 *= inv; w2 *= inv;
        const v4u a = *(const GAS v4u*)(QKV + t * NQKV + ch * 8), b = *(const GAS v4u*)(QKV + t * NQKV + 3072 + ch * 8), c = *(const GAS v4u*)(QKV + t * NQKV + 6144 + ch * 8);
        v4u o;
        o.x = pk2(w0 * bf_lo(a.x) + w1 * bf_lo(b.x) + w2 * bf_lo(c.x), w0 * bf_hi(a.x) + w1 * bf_hi(b.x) + w2 * bf_hi(c.x));
        o.y = pk2(w0 * bf_lo(a.y) + w1 * bf_lo(b.y) + w2 * bf_lo(c.y), w0 * bf_hi(a.y) + w1 * bf_hi(b.y) + w2 * bf_hi(c.y));
        o.z = pk2(w0 * bf_lo(a.z) + w1 * bf_lo(b.z) + w2 * bf_lo(c.z), w0 * bf_hi(a.z) + w1 * bf_hi(b.z) + w2 * bf_hi(c.z));
        o.w = pk2(w0 * bf_lo(a.w) + w1 * bf_lo(b.w) + w2 * bf_lo(c.w), w0 * bf_hi(a.w) + w1 * bf_hi(b.w) + w2 * bf_hi(c.w));
        *(GAS v4u*)(ATT + t * AW + ch * 8) = o;
    }
}

#ifndef MK_PER_PHASE
#define MK_PER_PHASE 0
#endif
constexpr int N_PHASES = 1 + 2 * (1 + 2 + 4 + 3 + 4);
#ifndef PROBE_SITE
#define PROBE_SITE 0
#endif
#define REPS(site, cond) ((PROBE_SITE == (site) && (cond)) ? 2 : 1)

__global__ void __launch_bounds__(NWAVES * 64, 2) trunk_fwd(Args args) {
    extern __shared__ __attribute__((aligned(16))) unsigned char lds_raw[];
    LAS unsigned char* lds = (LAS unsigned char*)lds_raw;
    LAS unsigned char* xl = lds + RING_BYTES;
    const int G = gridDim.x;
    const int wid0 = __builtin_amdgcn_readfirstlane((int)threadIdx.x >> 6);
    for (int u = threadIdx.x; u < (LDS_BYTES - RING_BYTES) / 4; u += NWAVES * 64) ((LAS unsigned*)(lds + RING_BYTES))[u] = 0u;
    __syncthreads();
    const int lo = args.ph_lo, hi = args.ph_hi;
    XcdBarrier bar; bar.wid0 = wid0; bar.bar = (unsigned*)(arg_ws() + WS_CTL); bar.x = 0; bar.st = (volatile LAS unsigned*)(lds + MISC_OFF) + 8;
    if (hi - lo > 1) { bar = xcd_barrier_post((unsigned*)(arg_ws() + WS_CTL), (volatile LAS unsigned*)(lds + MISC_OFF) + 8); bar.wid0 = wid0; }
    int pc = 0;
#define RUN_PH (pc >= lo && pc < hi)
#define SEAM() do { if (pc >= lo && pc + 1 < hi) { XcdBarrier b2_ = bar; asm volatile("" : "+s"(b2_.bar), "+s"(b2_.x)); b2_.bar = (unsigned*)(GAS unsigned*)b2_.bar; xcd_barrier(b2_); } ++pc; } while (0)
#define WSP(T, off) ((T*)(arg_ws() + (off)))
#define BIGP(T, off) ((T*)(arg_ws() + WS_BIG + (off)))
#define XOUT(grp) (arg_out() + (size_t)(grp) * MG * D)
#define VECP() ((const float*)(arg_ws() + WS_VEC))
#define PH_LOCALS int grp_ = grp, layer_ = layer; asm volatile("" : "+s"(grp_), "+s"(layer_)); const int S_ = grp_ == 0 ? 2048 : 16384; (void)layer_; (void)S_

    if (RUN_PH) { _Pragma("unroll 1") for (int rep = 0; rep < REPS(1, true); ++rep) prologue_phase(lds, G, wid0); }
    SEAM();
#pragma unroll 1
    for (int grp = 0; grp < 2; ++grp) {
        if (RUN_PH) { int grp_ = grp; asm volatile("" : "+s"(grp_)); _Pragma("unroll 1") for (int rep = 0; rep < REPS(2, grp_ == 0); ++rep)
            conv_bf16(arg_in(grp_), WSP(bf16, WS_XB), (size_t)MG * D / 8, (size_t)blockIdx.x * 512 + opaque_tid(wid0), (size_t)G * 512);
            if (grp_ == 0) finalize_vecs(G, wid0);
        }
        SEAM();
#pragma unroll 1
        for (int layer = 0; layer < 2; ++layer) {
            if (layer == 0) {
                if (RUN_PH) { PH_LOCALS; _Pragma("unroll 1") for (int rep = 0; rep < REPS(3, grp_ == 0); ++rep) {
                    pg8::Gemm g{WSP(bf16, WS_XB), WSP(const bf16, WS_W_IN), MG, HW, D, wid0}; pg8::StaticOrder So; So.init(MG, HW, G, (int)blockIdx.x);
                    pg8::EpiPlain<1> E{BIGP(bf16, BIG_H), HW, wid0};
                    pg8::gemm_phase<pg8::EpiPlain<1>, pg8::StaticOrder, true, true>(lds, g, So, E);
                } }
                SEAM();
                if (RUN_PH) { PH_LOCALS; _Pragma("unroll 1") for (int rep = 0; rep < REPS(4, grp_ == 0); ++rep) sgu_phase(lds, BIGP(const bf16, BIG_H), BIGP(bf16, BIG_GATED), WSP(const bf16, WS_W_S), arg_in(8), arg_in(5), arg_in(6), G, wid0); }
                SEAM();
            } else {
                if (RUN_PH) { PH_LOCALS; _Pragma("unroll 1") for (int rep = 0; rep < REPS(5, grp_ == 0); ++rep) {
                    pg8::Gemm g{WSP(bf16, WS_XB), WSP(const bf16, WS_W_QKV), MG, NQKV, D, wid0}; pg8::StaticOrder So; So.init(MG, NQKV, G, (int)blockIdx.x);
                    pg8::EpiQKV E{BIGP(bf16, BIG_QKV), WSP(const float, WS_ROT), S_ - 1, QSCALE, wid0};
                    pg8::gemm_phase<pg8::EpiQKV, pg8::StaticOrder, true, true>(lds, g, So, E);
                } }
                SEAM();
                if (RUN_PH) { PH_LOCALS; _Pragma("unroll 1") for (int rep = REPS(6, grp_ == 0) - 1; rep >= 0; --rep) attn_phase(lds, BIGP(bf16, BIG_QKV), BIGP(float, BIG_LSE), S_, G, rep != 0, wid0); }
                SEAM();
                if (RUN_PH) { PH_LOCALS; _Pragma("unroll 1") for (int rep = 0; rep < REPS(7, grp_ == 0); ++rep) combine_phase(BIGP(const bf16, BIG_QKV), BIGP(const float, BIG_LSE), BIGP(bf16, BIG_ATT), G, wid0); }
                SEAM();
            }
            if (RUN_PH) { PH_LOCALS; _Pragma("unroll 1") for (int rep = 0; rep < REPS(8, grp_ == 0 && layer_ == 0); ++rep) {
                conv_bf16(arg_in(2 + grp_) + (size_t)layer_ * MG * PLE, BIGP(bf16, BIG_PB), (size_t)MG * PLE / 8, (size_t)blockIdx.x * 512 + opaque_tid(wid0), (size_t)G * 512);
                pg8::Gemm g{layer_ == 0 ? BIGP(const bf16, BIG_GATED) : BIGP(const bf16, BIG_ATT), layer_ == 0 ? WSP(const bf16, WS_W_OA) : WSP(const bf16, WS_W_OB), MG, D, layer_ == 0 ? D : AW, wid0};
                pg8::StaticOrder So; So.init(MG, D, G, (int)blockIdx.x);
                pg8::EpiY1 E{layer_ == 0 ? arg_in(grp_) : (const float*)nullptr, WSP(const bf16, WS_XB), WSP(bf16, WS_XB), WSP(float, WS_ST1), xl, ALPHA, wid0};
                pg8::gemm_phase<pg8::EpiY1, pg8::StaticOrder, true, true>(lds, g, So, E);
            } }
            SEAM();
            if (RUN_PH) { PH_LOCALS; _Pragma("unroll 1") for (int rep = 0; rep < REPS(9, grp_ == 0 && layer_ == 0); ++rep) {
                { pg8::Gemm g{BIGP(const bf16, BIG_PB), WSP(const bf16, WS_W_PJ + layer_ * W_PJ_STRIDE), MG, D, PLE, wid0}; pg8::StaticOrder So; So.init(MG, D, G, (int)blockIdx.x);
                  pg8::EpiPlain<0> E{BIGP(bf16, BIG_PP), D, wid0};
                  pg8::gemm_phase<pg8::EpiPlain<0>, pg8::StaticOrder, true, true>(lds, g, So, E); }
                { pg8::Gemm g{WSP(const bf16, WS_XB), WSP(const bf16, WS_W_GU + layer_ * W_GU_STRIDE), MG, NGU, D, wid0}; pg8::StaticOrder So; So.init(MG, NGU, G, (int)blockIdx.x);
                  pg8::EpiGU E{WSP(const float, WS_ST1), VECP() + VEC_GU + layer_ * VEC_GU_L, VECP() + VEC_GU + layer_ * VEC_GU_L + NGU, BIGP(bf16, BIG_HB), xl, LN_EPS, wid0};
                  pg8::gemm_phase<pg8::EpiGU, pg8::StaticOrder, true, true>(lds, g, So, E); }
            } }
            SEAM();
            if (RUN_PH) { PH_LOCALS;
                pg8::Gemm g{BIGP(const bf16, BIG_HB), WSP(const bf16, WS_W_DN + layer_ * W_DN_STRIDE), MG, D, FF, wid0}; pg8::StaticOrder So; So.init(MG, D, G, (int)blockIdx.x);
                pg8::EpiY2 E{WSP(const bf16, WS_XB), BIGP(bf16, BIG_XB2), WSP(const float, WS_ST1), WSP(float, WS_ST2), arg_in(12) + layer_ * D, arg_in(13) + layer_ * D, xl, ALPHA, LN_EPS, wid0};
                pg8::gemm_phase<pg8::EpiY2, pg8::StaticOrder, true, true>(lds, g, So, E);
            }
            SEAM();
            if (RUN_PH) { PH_LOCALS;
                pg8::Gemm g{BIGP(const bf16, BIG_XB2), WSP(const bf16, WS_W_GT + layer_ * W_GT_STRIDE), MG, D, D, wid0}; pg8::StaticOrder So; So.init(MG, D, G, (int)blockIdx.x);
                pg8::EpiPLE E{BIGP(const bf16, BIG_XB2), layer_ == 0 ? (float*)nullptr : XOUT(grp_), WSP(bf16, WS_XB), BIGP(const bf16, BIG_PP), WSP(const float, WS_ST2), arg_in(16) + layer_ * D, arg_in(17) + layer_ * D,
                              VECP() + VEC_GT + layer_ * VEC_GT_L, VECP() + VEC_GT + layer_ * VEC_GT_L + D, xl, LN_EPS, wid0};
                pg8::gemm_phase<pg8::EpiPLE, pg8::StaticOrder, true, true>(lds, g, So, E);
            }
            SEAM();
        }
    }
#undef RUN_PH
#undef SEAM
}

extern "C" void kernel_launch(void* const* d_in, const int* in_sizes, int n_in, void* d_out, int out_size, void* d_ws, size_t ws_size, hipStream_t stream) {
    static int grid = 0;
    if (grid == 0) {
        if (n_in != 20 || in_sizes[0] != MG * D || in_sizes[1] != MG * D || out_size != 2 * MG * D || ws_size < WS_END) {
            fprintf(stderr, "kernel_launch: unexpected shapes (n_in %d, in0 %d, out %d, ws %zu < %zu); nothing launched\n", n_in, n_in > 0 ? in_sizes[0] : -1, out_size, ws_size, (size_t)WS_END); grid = -1; return; }
        int dev = 0, cus = 0, per_cu = 0;
        if (hipGetDevice(&dev) != hipSuccess || hipDeviceGetAttribute(&cus, hipDeviceAttributeMultiprocessorCount, dev) != hipSuccess) { grid = -1; return; }
        if (hipFuncSetAttribute((const void*)trunk_fwd, hipFuncAttributeMaxDynamicSharedMemorySize, LDS_BYTES) != hipSuccess) { fprintf(stderr, "kernel_launch: hipFuncSetAttribute failed\n"); grid = -1; return; }
        if (hipOccupancyMaxActiveBlocksPerMultiprocessor(&per_cu, (const void*)trunk_fwd, NWAVES * 64, LDS_BYTES) != hipSuccess || per_cu < 1)
            fprintf(stderr, "kernel_launch: note: occupancy query reports %d workgroups per CU\n", per_cu);
        (void)hipGetLastError();
        grid = cus;
    }
    if (grid < 0) return;
    if (hipMemsetAsync((char*)d_ws + WS_CTL, 0, CTL_ZERO_BYTES, stream) != hipSuccess) return;
    Args a{};
    for (int i = 0; i < 20; ++i) a.in[i] = (const float*)d_in[i];
    a.out = (float*)d_out; a.ws = (unsigned char*)d_ws;
#if MK_PER_PHASE
    for (int p = 0; p < N_PHASES; ++p) { a.ph_lo = p; a.ph_hi = p + 1; hipLaunchKernelGGL(trunk_fwd, dim3(grid), dim3(NWAVES * 64), LDS_BYTES, stream, a); }
#else
    a.ph_lo = 0; a.ph_hi = N_PHASES;
    hipLaunchKernelGGL(trunk_fwd, dim3(grid), dim3(NWAVES * 64), LDS_BYTES, stream, a);
#endif
    const hipError_t le = hipPeekAtLastError();
    if (le != hipSuccess) fprintf(stderr, "kernel_launch: launch failed: %s\n", hipGetErrorName(le));
}
```

```cpp
#include <hip/hip_runtime.h>
#include <cstdio>
#include <cstdint>
namespace pg8 {
#define PG8_LAS __attribute__((address_space(3)))
typedef unsigned short bf16_t;
typedef short bf16x8 __attribute__((ext_vector_type(8)));
typedef float f32x4 __attribute__((ext_vector_type(4)));
typedef unsigned u32x4 __attribute__((ext_vector_type(4)));
constexpr int BM = 256, BK = 64, HALF = 128, HTB = HALF * BK * 2  , STAGE_BYTES = 8 * HTB, NXCD = 8, WGM = 8;

__host__ __device__ __forceinline__ int lds_byte(int r, int c) { const int st = (r >> 4) * 2 + (c >> 5), rr = r & 15, cc = c & 31, ob = rr * 64 + cc * 2; return st * 1024 + (ob ^ (((ob >> 9) & 1) << 5)); }
__host__ __device__ __forceinline__ void stage_rc(int b, int& R, int& C) { const int st = b / 1024, sb = b % 1024, swz = sb ^ (((sb >> 9) & 1) << 5); R = (st >> 1) * 16 + swz / 64; C = (st & 1) * 32 + (swz % 64) / 2; }
__host__ __device__ __forceinline__ int perm32(int rho) { const int n = rho >> 4, i = rho & 15; return 8 * (i >> 2) + 4 * n + (i & 3); }

struct Unit { int pm, pn; };
struct Gemm { const bf16_t* A; const bf16_t* Bt; int M, N, K, wid0; };

struct StaticOrder {
    int nM, nN, nwg, G, c;
    __host__ __device__ void init(int M, int N, int G_, int c_) { nM = M / BM; nN = N / BM; nwg = nM * nN; G = G_; c = c_; }
    __host__ __device__ bool next(int i, Unit& u) const {
        const long L = (long)i * G + c; if (L >= nwg) return false;
        int wgid = (int)L; { const int q = nwg / NXCD, r = nwg % NXCD, xcd = wgid % NXCD, off = wgid / NXCD; wgid = (xcd < r ? xcd * (q + 1) : r * (q + 1) + (xcd - r) * q) + off; }
        const int nig = WGM * nN, gid = wgid / nig, fm = gid * WGM, gsz = (nM - fm) < WGM ? (nM - fm) : WGM;
        u.pm = fm + ((wgid % nig) % gsz); u.pn = (wgid % nig) / gsz; return true;
    }
    __device__ __forceinline__ void a_ready(const Unit&) const {}
    __device__ __forceinline__ void done(const Unit&) const {}
};
typedef _Float16 h16x2 __attribute__((ext_vector_type(2)));
typedef _Float16 h16x8 __attribute__((ext_vector_type(8)));
typedef float f32x2p __attribute__((ext_vector_type(2)));
__device__ __forceinline__ unsigned cvt_pk16(float lo, float hi) { const f32x2p v = {lo, hi}; return __builtin_bit_cast(unsigned, __builtin_convertvector(v, h16x2)); }
#define PG8_MFMA16(a, b, c) __builtin_amdgcn_mfma_f32_16x16x32_f16(__builtin_bit_cast(pg8::h16x8, (a)), __builtin_bit_cast(pg8::h16x8, (b)), (c), 0, 0, 0)
typedef float f32x2 __attribute__((ext_vector_type(2)));
__device__ __forceinline__ f32x2 gelu_pk(f32x2 v) {
    const f32x2 av = __builtin_elementwise_abs(v), d = av * 0.2316418882f + 1.0f;
    f32x2 t; t.x = __builtin_amdgcn_rcpf(d.x); t.y = __builtin_amdgcn_rcpf(d.y);
    f32x2 q = t * 0.5307027145f + (-0.7265760135f); q = q * t + 0.7107068705f; q = q * t + (-0.142248368f); q = q * t + 0.127414796f; q = q * t;
    const f32x2 s = (v * v) * (-0.72134752044f);
    f32x2 e; e.x = __builtin_amdgcn_exp2f(s.x); e.y = __builtin_amdgcn_exp2f(s.y);
    const f32x2 m = v * (q * e), r = v - m;
    f32x2 o; o.x = v.x < 0.f ? m.x : r.x; o.y = v.y < 0.f ? m.y : r.y; return o;
}

template <int ACT  > struct EpiBf16 {
    static constexpr bool PERM = true, AFTER_DRAIN = false; static_assert(ACT == 0 || ACT == 1, "EpiBf16: ACT is 0 (none) or 1 (gelu_pk)");
    bf16_t* O; int ldc; const float* bias; int split_cols; size_t split_stride; float scale0;
    __device__ __forceinline__ void operator()(const f32x4 (&acc)[2][2][4][2], const Unit& u, int wr, int wc, int fr, int fq) const {
        const int row0 = u.pm * BM + wr * 64 + fr; int colt = u.pn * BM; bf16_t* base = O;
        float sc = 1.f; if (split_cols) { const int t = colt / split_cols; base += (size_t)t * split_stride; colt -= t * split_cols; if (t == 0) sc = scale0; }
        const int col0 = colt + wc * 32 + 8 * fq, bcol0 = u.pn * BM + wc * 32 + 8 * fq;
        f32x4 bv[2][2];
#pragma unroll
        for (int bj = 0; bj < 2; ++bj)
#pragma unroll
            for (int n = 0; n < 2; ++n) bv[bj][n] = bias ? *(const f32x4*)(bias + bcol0 + bj * HALF + 4 * n) : (f32x4){0.f, 0.f, 0.f, 0.f};
#pragma unroll
        for (int ai = 0; ai < 2; ++ai)
#pragma unroll
            for (int m = 0; m < 4; ++m) { bf16_t* rowp = base + (size_t)(row0 + ai * HALF + m * 16) * ldc + col0;
#pragma unroll
                for (int bj = 0; bj < 2; ++bj) { f32x4 v0 = acc[ai][bj][m][0] + bv[bj][0], v1 = acc[ai][bj][m][1] + bv[bj][1];
                    if (ACT == 1) { f32x2 a = gelu_pk((f32x2){v0[0], v0[1]}), b = gelu_pk((f32x2){v0[2], v0[3]}), c = gelu_pk((f32x2){v1[0], v1[1]}), d = gelu_pk((f32x2){v1[2], v1[3]});
                        v0 = (f32x4){a.x, a.y, b.x, b.y}; v1 = (f32x4){c.x, c.y, d.x, d.y}; }
                    v0 = v0 * sc; v1 = v1 * sc; u32x4 w; w.x = cvt_pk16(v0[0], v0[1]); w.y = cvt_pk16(v0[2], v0[3]); w.z = cvt_pk16(v1[0], v1[1]); w.w = cvt_pk16(v1[2], v1[3]);
                    *(u32x4*)(rowp + bj * HALF) = w; } }
    }
};
}

constexpr int D = 2048, FF = 5632, NGU = 2 * FF, NQKV = 9216, AW = 1024, PLE = 256, HW = 4096;
constexpr int MG = 32768;
constexpr float LN_EPS = 1e-5f;
constexpr float ALPHA = 1.4142135623730951f;
constexpr float QSCALE = 0.08838834764831845f * 1.4426950408889634f;
constexpr float LN2 = 0.6931471805599453f;
constexpr int NWAVES = 8;

constexpr size_t MiB = 1u << 20;
constexpr size_t WS_CTL = 0, CTL_ZERO_BYTES = 65536;
constexpr size_t WS_ROT = 2 * MiB;
constexpr size_t WS_ST1 = 4 * MiB, WS_ST2 = 6 * MiB;
constexpr size_t WS_PART = 8 * MiB;
constexpr size_t WS_VEC = 16 * MiB;
constexpr size_t WS_W_IN = 17 * MiB, WS_W_OA = 33 * MiB, WS_W_S = 41 * MiB, WS_W_QKV = 42 * MiB, WS_W_OB = 78 * MiB;
constexpr size_t WS_W_GU = 82 * MiB, W_GU_STRIDE = 44 * MiB, WS_W_DN = 170 * MiB, W_DN_STRIDE = 22 * MiB;
constexpr size_t WS_W_GT = 214 * MiB, W_GT_STRIDE = 8 * MiB, WS_W_PJ = 230 * MiB, W_PJ_STRIDE = 1 * MiB;
constexpr size_t WS_XB = 232 * MiB;
constexpr size_t WS_BIG = 360 * MiB;
constexpr size_t BIG_H = 0, BIG_GATED = 256 * MiB, BIG_PB = 384 * MiB, BIG_XB2 = 384 * MiB, BIG_HB = 0, BIG_PP = 512 * MiB;
constexpr size_t BIG_QKV = 0, BIG_ATT = 576 * MiB, BIG_LSE = 640 * MiB;
constexpr size_t WS_END = WS_BIG + 643 * MiB;
constexpr int KB32 = 32;
constexpr size_t PART_GU = 0, PART_GU_L = (size_t)2 * KB32 * NGU, PART_GT = 2 * PART_GU_L, PART_GT_L = (size_t)2 * KB32 * D;
constexpr size_t VEC_GU = 0, VEC_GU_L = 2 * NGU, VEC_GT = 2 * VEC_GU_L, VEC_GT_L = 2 * D;
static_assert((PART_GT + 2 * PART_GT_L) * 4 <= 8 * MiB && (VEC_GT + 2 * VEC_GT_L) * 4 <= 1 * MiB, "partials");

constexpr int RING_BYTES = 131072;
constexpr int MISC_OFF = RING_BYTES + 320;
constexpr int STAB_OFF = RING_BYTES + 512;
constexpr int PTAB_OFF = STAB_OFF + 2048;
constexpr int LDS_BYTES = 147456;
static_assert(PTAB_OFF + 8192 <= LDS_BYTES, "LDS map");

#define GAS __attribute__((address_space(1)))
#define LAS __attribute__((address_space(3)))
typedef unsigned short bf16;
typedef unsigned v4u __attribute__((ext_vector_type(4)));
typedef unsigned v2u __attribute__((ext_vector_type(2)));
typedef float f32x4 __attribute__((ext_vector_type(4)));
typedef float f32x2v __attribute__((ext_vector_type(2)));
typedef short bf16x8 __attribute__((ext_vector_type(8)));
typedef short s16x4 __attribute__((ext_vector_type(4)));
#define LDS_WAIT() asm volatile("s_waitcnt lgkmcnt(0)" ::: "memory")
#define VM_WAIT() asm volatile("s_waitcnt vmcnt(0)" ::: "memory")
#define WG_BAR() do { asm volatile("s_waitcnt lgkmcnt(0)" ::: "memory"); __builtin_amdgcn_s_barrier(); asm volatile("" ::: "memory"); } while (0)

__device__ __forceinline__ float bf_round(float f) { return (float)(_Float16)f; }
__device__ __forceinline__ unsigned pk2(float lo, float hi) { return pg8::cvt_pk16(lo, hi); }
__device__ __forceinline__ float bf_lo(unsigned w) { return (float)__builtin_bit_cast(pg8::h16x2, w).x; }
__device__ __forceinline__ float bf_hi(unsigned w) { return (float)__builtin_bit_cast(pg8::h16x2, w).y; }
__device__ __forceinline__ int opaque_tid(int wid0) { int t; asm volatile("v_mbcnt_lo_u32_b32 %0, -1, 0\n\tv_mbcnt_hi_u32_b32 %0, -1, %0" : "=v"(t)); return (wid0 << 6) | t; }
__device__ __forceinline__ float shx(float v, int mask, int lane) { return __builtin_bit_cast(float, __builtin_amdgcn_ds_bpermute((lane ^ mask) << 2, __builtin_bit_cast(int, v))); }
__device__ __forceinline__ float wave_sum(float v, int lane) {
#pragma unroll
    for (int o = 1; o < 64; o <<= 1) v += shx(v, o, lane);
    return v;
}
__device__ __forceinline__ float fast_exp2(float x) { return __builtin_amdgcn_exp2f(x); }
__device__ __forceinline__ float fast_rcp(float x) { return __builtin_amdgcn_rcpf(x); }
__device__ __forceinline__ float sigmoidf_(float x) { return fast_rcp(1.0f + fast_exp2(-1.4426950408889634f * x)); }
__device__ __forceinline__ unsigned off_b(unsigned row, unsigned ch) { return 256u * row + 16u * (ch ^ (((row & 3u) << 2) | ((row >> 2) & 3u))); }
typedef short v4i16_t __attribute__((ext_vector_type(4)));
__device__ __forceinline__ s16x4 tr_read(LAS const unsigned char* p) { return __builtin_bit_cast(s16x4, __builtin_amdgcn_ds_read_tr16_b64_v4i16((LAS v4i16_t*)p)); }

namespace pg8 {
__device__ __forceinline__ void stab_from_partials(const float* st, int pm, PG8_LAS unsigned char* xl, float eps, int wid0) {
    const int tid = opaque_tid(wid0);
    if (tid < 256) {
        const f32x4* p = (const f32x4*)(st + ((size_t)(pm * BM + tid)) * 16);
        const f32x4 a = p[0], b = p[1], c = p[2], d = p[3];
        const float S = ((a[0] + a[2]) + (b[0] + b[2])) + ((c[0] + c[2]) + (d[0] + d[2]));
        const float Q = ((a[1] + a[3]) + (b[1] + b[3])) + ((c[1] + c[3]) + (d[1] + d[3]));
        const float mean = S * (1.0f / 2048.0f); float var = Q * (1.0f / 2048.0f) - mean * mean; var = var < 0.f ? 0.f : var;
        ((PG8_LAS f32x2*)(xl + (STAB_OFF - RING_BYTES)))[tid] = (f32x2){mean, 1.0f / sqrtf(var + eps)};
    }
    asm volatile("s_waitcnt lgkmcnt(0)" ::: "memory"); __builtin_amdgcn_s_barrier(); asm volatile("" ::: "memory");
}
__device__ __forceinline__ void partials_to_st(float* st, const Unit& u, PG8_LAS unsigned char* xl, int wid0) {
    asm volatile("s_waitcnt lgkmcnt(0)" ::: "memory"); __builtin_amdgcn_s_barrier(); asm volatile("" ::: "memory");
    const int tid = opaque_tid(wid0);
    if (tid < 256) {
        const PG8_LAS f32x4* P = (const PG8_LAS f32x4*)(xl + (PTAB_OFF - RING_BYTES)) + tid * 2;
        const f32x4 a = P[0], b = P[1];
        f32x2 o; o.x = (a[0] + a[2]) + (b[0] + b[2]); o.y = (a[1] + a[3]) + (b[1] + b[3]);
        *(f32x2*)(st + ((size_t)(u.pm * BM + tid) * 8 + u.pn) * 2) = o;
    }
}
struct LaneId { int wr, wc, fr, fq; };
__device__ __forceinline__ LaneId lane_id(int wid0) { const int t = opaque_tid(wid0); const int wid = wid0, lane = t & 63; LaneId L; L.wr = wid >> 2; L.wc = wid & 3; L.fr = lane & 15; L.fq = lane >> 4; return L; }
#define PG8_ROWSUM(s, q, v) do { s += ((v)[0] + (v)[1]) + ((v)[2] + (v)[3]); q += ((v)[0] * (v)[0] + (v)[1] * (v)[1]) + ((v)[2] * (v)[2] + (v)[3] * (v)[3]); } while (0)

template <int ACT> struct EpiPlain {
    static constexpr bool PERM = true, AFTER_DRAIN = false;
    bf16_t* O; int ldc; int wid0;
    __device__ __forceinline__ void operator()(const f32x4 (&acc)[2][2][4][2], const Unit& u, int, int, int, int) const {
        const LaneId L_ = lane_id(wid0); const int wr = L_.wr, wc = L_.wc, fr = L_.fr, fq = L_.fq;
        const int row0 = u.pm * BM + wr * 64 + fr, col0 = u.pn * BM + wc * 32 + 8 * fq;
#pragma unroll
        for (int ai = 0; ai < 2; ++ai)
#pragma unroll
            for (int m = 0; m < 4; ++m) { bf16_t* rowp = O + (size_t)(row0 + ai * HALF + m * 16) * ldc + col0;
#pragma unroll
                for (int bj = 0; bj < 2; ++bj) { f32x4 v0 = acc[ai][bj][m][0], v1 = acc[ai][bj][m][1];
                    if (ACT == 1) { f32x2 a = gelu_pk((f32x2){v0[0], v0[1]}), b = gelu_pk((f32x2){v0[2], v0[3]}), c = gelu_pk((f32x2){v1[0], v1[1]}), d = gelu_pk((f32x2){v1[2], v1[3]});
                        v0 = (f32x4){a.x, a.y, b.x, b.y}; v1 = (f32x4){c.x, c.y, d.x, d.y}; }
                    u32x4 w; w.x = cvt_pk16(v0[0], v0[1]); w.y = cvt_pk16(v0[2], v0[3]); w.z = cvt_pk16(v1[0], v1[1]); w.w = cvt_pk16(v1[2], v1[3]);
                    *(u32x4*)(rowp + bj * HALF) = w; } }
    }
};
struct EpiQKV {
    static constexpr bool PERM = true, AFTER_DRAIN = false;
    bf16_t* O; const float* rot; int seq_mask; float qscale; int wid0;
    __device__ __forceinline__ void operator()(const f32x4 (&acc)[2][2][4][2], const Unit& u, int, int, int, int) const {
        const LaneId L_ = lane_id(wid0); const int wr = L_.wr, wc = L_.wc, fr = L_.fr, fq = L_.fq;
        const int colt = u.pn * BM, tsel = (colt % 3072) / 1024;
        const float sc = tsel == 0 ? qscale : 1.0f;
        const bool dorot = (tsel < 2) && (wc == 0);
        const int row0 = u.pm * BM + wr * 64 + fr, col0 = colt + wc * 32 + 8 * fq;
        const float sgn = fq < 2 ? -1.0f : 1.0f;
#pragma unroll
        for (int ai = 0; ai < 2; ++ai)
#pragma unroll
            for (int m = 0; m < 4; ++m) {
                const int row = row0 + ai * HALF + m * 16;
                f32x4 cs[2], sn[2];
                if (dorot) { const float* rp = rot + (size_t)(row & seq_mask) * 32 + 8 * (fq & 1);
                    cs[0] = *(const f32x4*)(rp); cs[1] = *(const f32x4*)(rp + 4); sn[0] = *(const f32x4*)(rp + 16); sn[1] = *(const f32x4*)(rp + 20); }
#pragma unroll
                for (int bj = 0; bj < 2; ++bj) {
                    f32x4 v[2] = {acc[ai][bj][m][0], acc[ai][bj][m][1]};
                    if (dorot) {
#pragma unroll
                        for (int n = 0; n < 2; ++n) { f32x4 pr;
#pragma unroll
                            for (int j = 0; j < 4; ++j) pr[j] = shx(v[n][j], 32, fr + 16 * fq);
                            v[n] = v[n] * cs[n] + (pr * sn[n]) * sgn; }
                    }
                    v[0] = v[0] * sc; v[1] = v[1] * sc;
                    u32x4 w; w.x = cvt_pk16(v[0][0], v[0][1]); w.y = cvt_pk16(v[0][2], v[0][3]); w.z = cvt_pk16(v[1][0], v[1][1]); w.w = cvt_pk16(v[1][2], v[1][3]);
                    *(u32x4*)(O + (size_t)row * NQKV + col0 + bj * HALF) = w;
                }
            }
    }
};
#define PG8_UNPACK8(W_, v0, v1) do { v0[0] = bf_lo((W_)[0]); v0[1] = bf_hi((W_)[0]); v0[2] = bf_lo((W_)[1]); v0[3] = bf_hi((W_)[1]); v1[0] = bf_lo((W_)[2]); v1[1] = bf_hi((W_)[2]); v1[2] = bf_lo((W_)[3]); v1[3] = bf_hi((W_)[3]); } while (0)
#define PG8_PACK8(W_, v0, v1) do { (W_)[0] = cvt_pk16(v0[0], v0[1]); (W_)[1] = cvt_pk16(v0[2], v0[3]); (W_)[2] = cvt_pk16(v1[0], v1[1]); (W_)[3] = cvt_pk16(v1[2], v1[3]); } while (0)
struct EpiY1 {
    static constexpr bool PERM = true, AFTER_DRAIN = false;
    const float* xin32; const bf16_t* xin16; bf16_t* yb; float* st; PG8_LAS unsigned char* xl; float alpha; int wid0;
    __device__ __forceinline__ void operator()(const f32x4 (&acc)[2][2][4][2], const Unit& u, int, int, int, int) const {
        const LaneId L_ = lane_id(wid0); const int wr = L_.wr, wc = L_.wc, fr = L_.fr, fq = L_.fq;
        const int row0 = u.pm * BM + wr * 64 + fr, col0 = u.pn * BM + wc * 32 + 8 * fq, ln_ = fr + 16 * fq;
        PG8_LAS f32x2* P = (PG8_LAS f32x2*)(xl + (PTAB_OFF - RING_BYTES));
#pragma unroll
        for (int ai = 0; ai < 2; ++ai) {
            float s[4] = {0.f, 0.f, 0.f, 0.f}, q[4] = {0.f, 0.f, 0.f, 0.f};
#pragma unroll
            for (int bj = 0; bj < 2; ++bj) {
                if (xin32) {
                    f32x4 x[4][2];
#pragma unroll
                    for (int m = 0; m < 4; ++m) { const size_t off = (size_t)(row0 + ai * HALF + m * 16) * D + col0 + bj * HALF; x[m][0] = *(const f32x4*)(xin32 + off); x[m][1] = *(const f32x4*)(xin32 + off + 4); }
#pragma unroll
                    for (int m = 0; m < 4; ++m) { const size_t off = (size_t)(row0 + ai * HALF + m * 16) * D + col0 + bj * HALF;
                        const f32x4 y0 = x[m][0] * alpha + acc[ai][bj][m][0], y1 = x[m][1] * alpha + acc[ai][bj][m][1];
                        u32x4 w; PG8_PACK8(w, y0, y1); *(u32x4*)(yb + off) = w;
                        PG8_ROWSUM(s[m], q[m], y0); PG8_ROWSUM(s[m], q[m], y1); }
                } else {
                    u32x4 xw[4];
#pragma unroll
                    for (int m = 0; m < 4; ++m) xw[m] = *(const u32x4*)(xin16 + (size_t)(row0 + ai * HALF + m * 16) * D + col0 + bj * HALF);
#pragma unroll
                    for (int m = 0; m < 4; ++m) { const size_t off = (size_t)(row0 + ai * HALF + m * 16) * D + col0 + bj * HALF;
                        f32x4 x0, x1; PG8_UNPACK8(xw[m], x0, x1);
                        const f32x4 y0 = x0 * alpha + acc[ai][bj][m][0], y1 = x1 * alpha + acc[ai][bj][m][1];
                        u32x4 w; PG8_PACK8(w, y0, y1); *(u32x4*)(yb + off) = w;
                        PG8_ROWSUM(s[m], q[m], y0); PG8_ROWSUM(s[m], q[m], y1); }
                }
                asm volatile("" ::: "memory");
            }
#pragma unroll
            for (int m = 0; m < 4; ++m) { float ss = s[m], qq = q[m]; ss += shx(ss, 16, ln_); qq += shx(qq, 16, ln_); ss += shx(ss, 32, ln_); qq += shx(qq, 32, ln_);
                if (fq == 0) P[(ai * HALF + wr * 64 + m * 16 + fr) * 4 + wc] = (f32x2){ss, qq}; }
        }
        partials_to_st(st, u, xl, wid0);
    }
};
struct EpiGU {
    static constexpr bool PERM = true, AFTER_DRAIN = false;
    const float* st; const float* cs; const float* bw; bf16_t* H; PG8_LAS unsigned char* xl; float eps; int wid0;
    __device__ __forceinline__ void operator()(const f32x4 (&acc)[2][2][4][2], const Unit& u, int, int, int, int) const {
        const LaneId L_ = lane_id(wid0); const int wr = L_.wr, wc = L_.wc, fr = L_.fr, fq = L_.fq;
        stab_from_partials(st, u.pm, xl, eps, wid0);
        const PG8_LAS f32x2* S = (const PG8_LAS f32x2*)(xl + (STAB_OFF - RING_BYTES));
        const int row0 = u.pm * BM + wr * 64 + fr, col0 = u.pn * BM + wc * 32 + 8 * fq, hcol0 = u.pn * HALF + wc * 32 + 8 * fq;
        f32x4 csv[2][2], bwv[2][2];
#pragma unroll
        for (int bj = 0; bj < 2; ++bj)
#pragma unroll
            for (int n = 0; n < 2; ++n) { csv[bj][n] = *(const f32x4*)(cs + col0 + bj * HALF + 4 * n); bwv[bj][n] = *(const f32x4*)(bw + col0 + bj * HALF + 4 * n); }
#pragma unroll
        for (int ai = 0; ai < 2; ++ai)
#pragma unroll
            for (int m = 0; m < 4; ++m) {
                const int rl = ai * HALF + wr * 64 + m * 16 + fr; const f32x2 sr = S[rl];
                f32x4 h[2];
#pragma unroll
                for (int n = 0; n < 2; ++n) {
                    const f32x4 g = (acc[ai][0][m][n] - csv[0][n] * sr.x) * sr.y + bwv[0][n];
                    const f32x4 uu = (acc[ai][1][m][n] - csv[1][n] * sr.x) * sr.y + bwv[1][n];
#pragma unroll
                    for (int j = 0; j < 4; ++j) h[n][j] = g[j] * __builtin_amdgcn_rcpf(1.0f + __builtin_amdgcn_exp2f(-1.4426950408889634f * g[j])) * uu[j];
                }
                u32x4 w; w.x = cvt_pk16(h[0][0], h[0][1]); w.y = cvt_pk16(h[0][2], h[0][3]); w.z = cvt_pk16(h[1][0], h[1][1]); w.w = cvt_pk16(h[1][2], h[1][3]);
                *(u32x4*)(H + (size_t)(row0 + ai * HALF + m * 16) * FF + hcol0) = w;
            }
    }
};
struct EpiY2 {
    static constexpr bool PERM = true, AFTER_DRAIN = false;
    const bf16_t* y1b; bf16_t* yb; const float* st1; float* st2; const float* lng; const float* lnb; PG8_LAS unsigned char* xl; float alpha, eps; int wid0;
    __device__ __forceinline__ void operator()(const f32x4 (&acc)[2][2][4][2], const Unit& u, int, int, int, int) const {
        const LaneId L_ = lane_id(wid0); const int wr = L_.wr, wc = L_.wc, fr = L_.fr, fq = L_.fq;
        const int row0 = u.pm * BM + wr * 64 + fr, col0 = u.pn * BM + wc * 32 + 8 * fq, ln_ = fr + 16 * fq;
        u32x4 aw[4];
#pragma unroll
        for (int m = 0; m < 4; ++m) aw[m] = *(const u32x4*)(y1b + (size_t)(row0 + m * 16) * D + col0);
        stab_from_partials(st1, u.pm, xl, eps, wid0);
        const PG8_LAS f32x2* S = (const PG8_LAS f32x2*)(xl + (STAB_OFF - RING_BYTES));
        PG8_LAS f32x2* P = (PG8_LAS f32x2*)(xl + (PTAB_OFF - RING_BYTES));
#pragma unroll
        for (int ai = 0; ai < 2; ++ai) {
            float s[4] = {0.f, 0.f, 0.f, 0.f}, q[4] = {0.f, 0.f, 0.f, 0.f}; f32x2 sr[4];
#pragma unroll
            for (int m = 0; m < 4; ++m) sr[m] = S[ai * HALF + wr * 64 + m * 16 + fr];
#pragma unroll
            for (int bj = 0; bj < 2; ++bj) {
                f32x4 gv[2], bv[2];
#pragma unroll
                for (int n = 0; n < 2; ++n) { gv[n] = *(const f32x4*)(lng + col0 + bj * HALF + 4 * n); bv[n] = *(const f32x4*)(lnb + col0 + bj * HALF + 4 * n); }
                if (ai + bj > 0) {
#pragma unroll
                    for (int m = 0; m < 4; ++m) aw[m] = *(const u32x4*)(y1b + (size_t)(row0 + ai * HALF + m * 16) * D + col0 + bj * HALF);
                }
#pragma unroll
                for (int m = 0; m < 4; ++m) { const size_t off = (size_t)(row0 + ai * HALF + m * 16) * D + col0 + bj * HALF;
                    f32x4 a0, a1; PG8_UNPACK8(aw[m], a0, a1);
                    const f32x4 x0 = ((a0 - sr[m].x) * sr[m].y) * gv[0] + bv[0], x1 = ((a1 - sr[m].x) * sr[m].y) * gv[1] + bv[1];
                    const f32x4 y0 = x0 * alpha + acc[ai][bj][m][0], y1 = x1 * alpha + acc[ai][bj][m][1];
                    u32x4 w; PG8_PACK8(w, y0, y1); *(u32x4*)(yb + off) = w;
                    PG8_ROWSUM(s[m], q[m], y0); PG8_ROWSUM(s[m], q[m], y1); }
                asm volatile("" ::: "memory");
            }
#pragma unroll
            for (int m = 0; m < 4; ++m) { float ss = s[m], qq = q[m]; ss += shx(ss, 16, ln_); qq += shx(qq, 16, ln_); ss += shx(ss, 32, ln_); qq += shx(qq, 32, ln_);
                if (fq == 0) P[(ai * HALF + wr * 64 + m * 16 + fr) * 4 + wc] = (f32x2){ss, qq}; }
        }
        partials_to_st(st2, u, xl, wid0);
    }
};
struct EpiPLE {
    static constexpr bool PERM = true, AFTER_DRAIN = false;
    const bf16_t* y2b; float* out32; bf16_t* xb; const bf16_t* pp; const float* st2; const float* lng; const float* lnb; const float* cs; const float* bw; PG8_LAS unsigned char* xl; float eps; int wid0;
    __device__ __forceinline__ void operator()(const f32x4 (&acc)[2][2][4][2], const Unit& u, int, int, int, int) const {
        const LaneId L_ = lane_id(wid0); const int wr = L_.wr, wc = L_.wc, fr = L_.fr, fq = L_.fq;
        const int row0 = u.pm * BM + wr * 64 + fr, col0 = u.pn * BM + wc * 32 + 8 * fq;
        u32x4 aw[4], pw[4];
#pragma unroll
        for (int m = 0; m < 4; ++m) { const size_t off = (size_t)(row0 + m * 16) * D + col0; aw[m] = *(const u32x4*)(y2b + off); pw[m] = *(const u32x4*)(pp + off); }
        stab_from_partials(st2, u.pm, xl, eps, wid0);
        const PG8_LAS f32x2* S = (const PG8_LAS f32x2*)(xl + (STAB_OFF - RING_BYTES));
#pragma unroll
        for (int bj = 0; bj < 2; ++bj) {
            f32x4 gv[2], bv[2], csv[2], bwv[2];
#pragma unroll
            for (int n = 0; n < 2; ++n) { const int c = col0 + bj * HALF + 4 * n; gv[n] = *(const f32x4*)(lng + c); bv[n] = *(const f32x4*)(lnb + c); csv[n] = *(const f32x4*)(cs + c); bwv[n] = *(const f32x4*)(bw + c); }
#pragma unroll
            for (int ai = 0; ai < 2; ++ai) {
                if (bj + ai > 0) {
#pragma unroll
                    for (int m = 0; m < 4; ++m) { const size_t off = (size_t)(row0 + ai * HALF + m * 16) * D + col0 + bj * HALF; aw[m] = *(const u32x4*)(y2b + off); pw[m] = *(const u32x4*)(pp + off); }
                }
#pragma unroll
                for (int m = 0; m < 4; ++m) {
                    const int rl = ai * HALF + wr * 64 + m * 16 + fr; const size_t off = (size_t)(row0 + ai * HALF + m * 16) * D + col0 + bj * HALF; const f32x2 sr = S[rl];
                    f32x4 a0, a1, p0, p1; PG8_UNPACK8(aw[m], a0, a1); PG8_UNPACK8(pw[m], p0, p1);
                    const f32x4 x0 = ((a0 - sr.x) * sr.y) * gv[0] + bv[0], x1 = ((a1 - sr.x) * sr.y) * gv[1] + bv[1];
                    const f32x4 t0 = (acc[ai][bj][m][0] - csv[0] * sr.x) * sr.y + bwv[0], t1 = (acc[ai][bj][m][1] - csv[1] * sr.x) * sr.y + bwv[1];
                    f32x4 o0, o1;
#pragma unroll
                    for (int j = 0; j < 4; ++j) { o0[j] = x0[j] + sigmoidf_(t0[j]) * p0[j]; o1[j] = x1[j] + sigmoidf_(t1[j]) * p1[j]; }
                    if (out32) { *(f32x4*)(out32 + off) = o0; *(f32x4*)(out32 + off + 4) = o1; }
                    else { u32x4 w; PG8_PACK8(w, o0, o1); *(u32x4*)(xb + off) = w; }
                }
                asm volatile("" ::: "memory");
            }
        }
    }
};
}
namespace pg8 {
template <class Epi, class Sched, bool ALIGN_EPI = false, bool SP2 = false>
__device__ __forceinline__ void gemm_phase(PG8_LAS unsigned char* lds, const Gemm g, const Sched& S, const Epi& E) {
    const int tid = opaque_tid(g.wid0), wid = g.wid0, lane = tid & 63, wr = wid >> 2, wc = wid & 3, fr = lane & 15, fq = lane >> 4;
    const int K = g.K, nt = K / BK;
    unsigned voffA[2], voffB[2];
#pragma unroll
    for (int i = 0; i < 2; ++i) { int R, C; stage_rc(tid * 16 + i * 8192, R, C); const int Rb = Epi::PERM ? ((R & ~31) + perm32(R & 31)) : R;
        voffA[i] = (unsigned)(R * K + C) * 2u; voffB[i] = (unsigned)(Rb * K + C) * 2u; }
    const size_t kstep = (size_t)(BK * 2);
    const size_t hstep = (size_t)HALF * K * 2;
    const size_t tstep = 2 * hstep;
    const unsigned ldsw = (unsigned)wid * 1024u;
    const int aoff = lds_byte(wr * 64 + fr, fq * 8), boff = lds_byte(wc * 32 + fr, fq * 8);
#define PG8_SA(b, h) (((b) * 2 + (h)) * HTB)
#define PG8_SB(b, h) ((4 + (b) * 2 + (h)) * HTB)
#define PG8_STAGE(bufoff, gbase, voff) do { _Pragma("unroll") for (int _i = 0; _i < 2; ++_i) \
        __builtin_amdgcn_global_load_lds((const unsigned*)((const char*)(gbase) + (voff)[_i]), (PG8_LAS unsigned*)(lds + (bufoff) + ldsw + _i * 8192), 16, 0, 0); } while (0)
#define PG8_LDA(dst, b, h) do { _Pragma("unroll") for (int m = 0; m < 4; ++m) _Pragma("unroll") for (int k = 0; k < 2; ++k) dst[m][k] = *(const PG8_LAS bf16x8*)(lds + PG8_SA(b, h) + aoff + m * 2048 + k * 1024); } while (0)
#define PG8_LDB(dst, b, h) do { _Pragma("unroll") for (int n = 0; n < 2; ++n) _Pragma("unroll") for (int k = 0; k < 2; ++k) dst[n][k] = *(const PG8_LAS bf16x8*)(lds + PG8_SB(b, h) + boff + n * 2048 + k * 1024); } while (0)
#define PG8_MMA(ai, bj, At, Bt) do { __builtin_amdgcn_s_setprio(1); _Pragma("unroll") for (int m = 0; m < 4; ++m) _Pragma("unroll") for (int n = 0; n < 2; ++n) _Pragma("unroll") for (int k = 0; k < 2; ++k) \
        acc[ai][bj][m][n] = PG8_MFMA16(Bt[n][k], At[m][k], acc[ai][bj][m][n]); __builtin_amdgcn_s_setprio(0); } while (0)
#define PG8_WAIT_V(n) asm volatile("s_waitcnt vmcnt(" #n ")" ::: "memory")
#define PG8_WAIT_L(n) asm volatile("s_waitcnt lgkmcnt(" #n ")" ::: "memory")
#define PG8_BAR __builtin_amdgcn_s_barrier()
#define PG8_SCHED __builtin_amdgcn_sched_barrier(0)
    Unit cur, nxt; int ui = 0;
    if (!S.next(0, cur)) return;
    f32x4 acc[2][2][4][2];
#pragma unroll
    for (int a = 0; a < 2; ++a)
#pragma unroll
        for (int b = 0; b < 2; ++b)
#pragma unroll
            for (int m = 0; m < 4; ++m)
#pragma unroll
                for (int n = 0; n < 2; ++n) acc[a][b][m][n] = (f32x4){0.f, 0.f, 0.f, 0.f};
    bf16x8 At[4][2], B0[2][2], B1[2][2];
    const char* cA = (const char*)g.A + (size_t)cur.pm * tstep; const char* cB = (const char*)g.Bt + (size_t)cur.pn * tstep;
    S.a_ready(cur);
    if constexpr (SP2) {
        PG8_STAGE(PG8_SB(0, 0), cB, voffB); PG8_STAGE(PG8_SB(0, 1), cB + hstep, voffB); PG8_STAGE(PG8_SA(0, 0), cA, voffA); PG8_STAGE(PG8_SA(0, 1), cA + hstep, voffA);
        if (wr == 1) PG8_BAR;
        PG8_WAIT_V(2); PG8_BAR;
        PG8_STAGE(PG8_SB(1, 0), cB + kstep, voffB); PG8_STAGE(PG8_SA(1, 0), cA + kstep, voffA); PG8_STAGE(PG8_SB(1, 1), cB + hstep + kstep, voffB);
        PG8_WAIT_V(6); PG8_BAR;
    } else {
        PG8_STAGE(PG8_SB(0, 0), cB, voffB); PG8_STAGE(PG8_SA(0, 0), cA, voffA); PG8_STAGE(PG8_SB(0, 1), cB + hstep, voffB); PG8_STAGE(PG8_SA(0, 1), cA + hstep, voffA);
        if (wr == 1) PG8_BAR;
        PG8_WAIT_V(4); PG8_BAR;
        PG8_STAGE(PG8_SB(1, 0), cB + kstep, voffB); PG8_STAGE(PG8_SA(1, 0), cA + kstep, voffA); PG8_STAGE(PG8_SB(1, 1), cB + hstep + kstep, voffB);
        PG8_WAIT_V(6); PG8_BAR;
    }
    for (;;) {
        const bool has_next = S.next(ui + 1, nxt);
        const char* nA = has_next ? (const char*)g.A + (size_t)nxt.pm * tstep : cA; const char* nB = has_next ? (const char*)g.Bt + (size_t)nxt.pn * tstep : cB;
        for (int t = 0; t < nt; t += 2) {
            const bool last = (t == nt - 2);
            const char* a1 = cA + (size_t)(t + 1) * kstep;
            const char* a2 = last ? nA : cA + (size_t)(t + 2) * kstep; const char* b2 = last ? nB : cB + (size_t)(t + 2) * kstep;
            const char* a3 = a2 + kstep; const char* b3 = b2 + kstep;
            if (last && has_next) S.a_ready(nxt);
            if constexpr (SP2) {
            PG8_LDB(B0, 0, 0); PG8_LDB(B1, 0, 1); PG8_SCHED; PG8_LDA(At, 0, 0); PG8_STAGE(PG8_SA(1, 1), a1 + hstep, voffA);
            PG8_WAIT_V(8); PG8_WAIT_L(0); PG8_BAR; PG8_MMA(0, 0, At, B0); PG8_MMA(0, 1, At, B1); PG8_BAR; PG8_SCHED;
            PG8_LDA(At, 0, 1); PG8_STAGE(PG8_SB(0, 0), b2, voffB); PG8_STAGE(PG8_SB(0, 1), b2 + hstep, voffB); PG8_STAGE(PG8_SA(0, 0), a2, voffA);
            PG8_WAIT_V(8); PG8_WAIT_L(0); PG8_BAR; PG8_MMA(1, 0, At, B0); PG8_MMA(1, 1, At, B1); PG8_BAR; PG8_SCHED;
            PG8_LDB(B0, 1, 0); PG8_LDB(B1, 1, 1); PG8_SCHED; PG8_LDA(At, 1, 0); PG8_STAGE(PG8_SA(0, 1), a2 + hstep, voffA);
            PG8_WAIT_V(8); PG8_WAIT_L(0); PG8_BAR; PG8_MMA(0, 0, At, B0); PG8_MMA(0, 1, At, B1); PG8_BAR; PG8_SCHED;
            PG8_LDA(At, 1, 1); PG8_STAGE(PG8_SB(1, 0), b3, voffB); PG8_STAGE(PG8_SB(1, 1), b3 + hstep, voffB); PG8_STAGE(PG8_SA(1, 0), a3, voffA);
            PG8_WAIT_V(8); PG8_WAIT_L(0); PG8_BAR; PG8_MMA(1, 0, At, B0); PG8_MMA(1, 1, At, B1); PG8_BAR; PG8_SCHED;
            } else {
            PG8_LDB(B0, 0, 0); PG8_SCHED; PG8_LDA(At, 0, 0); PG8_STAGE(PG8_SA(1, 1), a1 + hstep, voffA);
            PG8_WAIT_L(8); PG8_BAR; PG8_WAIT_L(0); PG8_MMA(0, 0, At, B0); PG8_BAR; PG8_SCHED;
            PG8_LDB(B1, 0, 1); PG8_STAGE(PG8_SB(0, 0), b2, voffB);
            PG8_BAR; PG8_WAIT_L(0); PG8_MMA(0, 1, At, B1); PG8_BAR;
            PG8_LDA(At, 0, 1); PG8_STAGE(PG8_SA(0, 0), a2, voffA);
            PG8_BAR; PG8_WAIT_L(0); PG8_MMA(1, 0, At, B0); PG8_BAR; PG8_SCHED;
            PG8_STAGE(PG8_SB(0, 1), b2 + hstep, voffB);
            PG8_WAIT_V(6); PG8_BAR; PG8_MMA(1, 1, At, B1); PG8_BAR;
            PG8_LDB(B0, 1, 0); PG8_SCHED; PG8_LDA(At, 1, 0); PG8_STAGE(PG8_SA(0, 1), a2 + hstep, voffA);
            PG8_WAIT_L(8); PG8_BAR; PG8_WAIT_L(0); PG8_MMA(0, 0, At, B0); PG8_BAR; PG8_SCHED;
            PG8_LDB(B1, 1, 1); PG8_STAGE(PG8_SB(1, 0), b3, voffB);
            PG8_BAR; PG8_WAIT_L(0); PG8_MMA(0, 1, At, B1); PG8_BAR;
            PG8_LDA(At, 1, 1); PG8_STAGE(PG8_SA(1, 0), a3, voffA);
            PG8_BAR; PG8_WAIT_L(0); PG8_MMA(1, 0, At, B0); PG8_BAR; PG8_SCHED;
            PG8_STAGE(PG8_SB(1, 1), b3 + hstep, voffB);
            PG8_WAIT_V(6); PG8_BAR; PG8_MMA(1, 1, At, B1); PG8_BAR;
            }
        }
        if constexpr (ALIGN_EPI) { if (wr == 0) PG8_BAR; }
        if constexpr (!Epi::AFTER_DRAIN) { E(acc, cur, wr, wc, fr, fq); S.done(cur); }
        if (!has_next) break;
#pragma unroll
        for (int a = 0; a < 2; ++a)
#pragma unroll
            for (int b = 0; b < 2; ++b)
#pragma unroll
                for (int m = 0; m < 4; ++m)
#pragma unroll
                    for (int n = 0; n < 2; ++n) acc[a][b][m][n] = (f32x4){0.f, 0.f, 0.f, 0.f};
        cur = nxt; cA = nA; cB = nB; ++ui;
        if constexpr (ALIGN_EPI) { if (wr == 1) PG8_BAR; }
    }
    PG8_WAIT_V(0);
    if constexpr (!ALIGN_EPI) { if (wr == 0) PG8_BAR; }
    PG8_BAR;
    if constexpr (Epi::AFTER_DRAIN) { E.fused(acc, cur, wr, wc, fr, fq, lds, wid, lane); S.done(cur); }
#undef PG8_SA
#undef PG8_SB
#undef PG8_STAGE
#undef PG8_LDA
#undef PG8_LDB
#undef PG8_MMA
#undef PG8_WAIT_V
#undef PG8_WAIT_L
#undef PG8_BAR
#undef PG8_SCHED
}
}
#define XB_TMO      128
#define XB_XCNT(j)  (256  + 64 * (j))
#define XB_XSUB(j)  (1280 + 64 * (j))
#define XB_XGEN(j)  (2304 + 64 * (j))
#define XB_TOP      3328
#define XB_TOPGEN   3392
#define XCD_BAR_WORDS 3456
#define XB_SPIN_CAP (1u << 18)

__device__ __forceinline__ unsigned xb_ld(unsigned* p)              { return __hip_atomic_load(p, __ATOMIC_RELAXED, __HIP_MEMORY_SCOPE_AGENT); }
__device__ __forceinline__ unsigned xb_add(unsigned* p, unsigned v) { return __hip_atomic_fetch_add(p, v, __ATOMIC_RELAXED, __HIP_MEMORY_SCOPE_AGENT); }
__device__ __forceinline__ unsigned xb_xcc_id() { return (unsigned)__builtin_amdgcn_s_getreg((3 << 11) | 20) & 0xFu; }
#define XB_SPIN(cond, bar) do { unsigned _sp = 0; while (cond) { __builtin_amdgcn_s_sleep(1); \
    if ((++_sp & 255u) == 0u) { if (xb_ld(&(bar)[XB_TMO])) break; if (_sp > XB_SPIN_CAP) { atomicAdd(&(bar)[XB_TMO], 1u); break; } } } } while (0)

struct XcdBarrier {
    int wid0;
    unsigned* bar; unsigned x;
    volatile LAS unsigned* st;
};

__device__ __forceinline__ XcdBarrier xcd_barrier_post(unsigned* bar, volatile LAS unsigned* st) {
    XcdBarrier b; b.bar = bar; b.x = xb_xcc_id(); b.st = st;
    if (threadIdx.x == 0) (void)xb_add(&bar[XB_XCNT(b.x)], 1u);
    return b;
}
__device__ __forceinline__ void xcd_barrier_complete(unsigned* bar, unsigned x, unsigned& nloc, unsigned& nx) {
    const unsigned G = gridDim.x * gridDim.y * gridDim.z;
    unsigned sum, cnt, mine, sp = 0u;
    for (;;) {
        sum = 0u; cnt = 0u; mine = 0u;
#pragma unroll
        for (unsigned j = 0; j < 16; ++j) { const unsigned c = xb_ld(&bar[XB_XCNT(j)]); sum += c; cnt += (c > 0u) ? 1u : 0u; mine = (j == x) ? c : mine; }
        if (sum == G) break;
        __builtin_amdgcn_s_sleep(1);
        if ((++sp & 255u) == 0u) { if (xb_ld(&bar[XB_TMO])) break; if (sp > XB_SPIN_CAP) { atomicAdd(&bar[XB_TMO], 1u); break; } }
    }
    nloc = mine > 0u ? mine : 1u; nx = cnt > 0u ? cnt : 1u;
}

__device__ __forceinline__ void xcd_barrier(const XcdBarrier& b) {
    asm volatile("s_waitcnt vmcnt(0)" ::: "memory");
    __syncthreads();
    if (opaque_tid(b.wid0) == 0) {
        unsigned* bar = b.bar;
        __builtin_amdgcn_s_waitcnt(0);
        unsigned nloc = b.st[0], nx = b.st[1];
        if (nloc == 0u) { xcd_barrier_complete(bar, b.x, nloc, nx); b.st[0] = nloc; b.st[1] = nx; }
        const unsigned old = xb_add(&bar[XB_XSUB(b.x)], 1u);
        const unsigned gen = old / nloc;
        if (old + 1u == (gen + 1u) * nloc) {
            __builtin_amdgcn_fence(__ATOMIC_RELEASE, "agent");
            asm volatile("s_waitcnt vmcnt(0)" ::: "memory");
            const unsigned og = xb_add(&bar[XB_TOP], 1u);
            const unsigned tg = og / nx;
            if (og + 1u == (tg + 1u) * nx) xb_add(&bar[XB_TOPGEN], 1u);
            else XB_SPIN(xb_ld(&bar[XB_TOPGEN]) == tg, bar);
            __builtin_amdgcn_fence(__ATOMIC_ACQUIRE, "agent");
            xb_add(&bar[XB_XGEN(b.x)], 1u);
            asm volatile("s_waitcnt vmcnt(0)" ::: "memory");
        } else {
            XB_SPIN(xb_ld(&bar[XB_XGEN(b.x)]) == gen, bar);
            __builtin_amdgcn_fence(__ATOMIC_ACQUIRE, "agent");
            asm volatile("s_waitcnt vmcnt(0)" ::: "memory");
        }
    }
    __syncthreads();
}

__device__ const float kInvFreq[16] = {1.000000000e+00f, 4.403665960e-01f, 1.939227432e-01f, 8.539710194e-02f, 3.760603070e-02f, 1.656044088e-02f, 7.292664610e-03f, 3.211446106e-03f,
                                       1.414213562e-03f, 6.227724371e-04f, 2.742481884e-04f, 1.207697351e-04f, 5.318295734e-05f, 2.341999971e-05f, 1.031338525e-05f, 4.541670478e-06f};

__device__ __forceinline__ void sincos_f64(float angf, float& so, float& co) {
    const double a = (double)angf;
    const double k = __builtin_rint(a * 0.63661977236758134308);
    const double r = __builtin_fma(-k, 6.123233995736766e-17, __builtin_fma(-k, 1.5707963267948966, a));
    const double r2 = r * r;
    double s = -7.6471637318198164759e-13; s = s * r2 + 1.6059043836821614599e-10; s = s * r2 - 2.5052108385441718775e-8; s = s * r2 + 2.7557319223985890653e-6;
    s = s * r2 - 1.9841269841269841270e-4; s = s * r2 + 8.3333333333333333333e-3; s = s * r2 - 1.6666666666666666667e-1; s = s * r2 * r + r;
    double c = 4.7794773323873852974e-14; c = c * r2 - 1.1470745597729724714e-11; c = c * r2 + 2.0876756987868098979e-9; c = c * r2 - 2.7557319223985890653e-7;
    c = c * r2 + 2.4801587301587301587e-5; c = c * r2 - 1.3888888888888888889e-3; c = c * r2 + 4.1666666666666666667e-2; c = c * r2 - 0.5; c = c * r2 + 1.0;
    const int q = (int)((long long)k & 3);
    const double sv = (q == 0) ? s : (q == 1) ? c : (q == 2) ? -s : -c;
    const double cv = (q == 0) ? c : (q == 1) ? -s : (q == 2) ? -c : s;
    so = (float)sv; co = (float)cv;
}

struct TJob { const float* W; int K, N; bf16* WT; int mode; const float* g; const float* b; float* pcs; float* pbw; };
__device__ __forceinline__ void tr_item(const TJob& J, LAS float* scr, int item, int lane) {
    const int nblk = J.N / 32, kb = item / nblk, nb = item - kb * nblk, k0 = 64 * kb, n0 = 32 * nb;
#pragma unroll 8
    for (int i = 0; i < 32; ++i) { const int kk = 2 * i + (lane >> 5); scr[kk * 33 + (lane & 31)] = J.W[(size_t)(k0 + kk) * J.N + n0 + (lane & 31)]; }
    LDS_WAIT(); asm volatile("" ::: "memory");
    int drow0 = n0;
    if (J.mode == 2) { const int isup = n0 >= FF ? 1 : 0, hc = n0 - isup * FF; drow0 = 256 * (hc >> 7) + 128 * isup + (hc & 127); }
    const int c = lane & 7;
    float gk[8];
#pragma unroll
    for (int j = 0; j < 8; ++j) gk[j] = J.mode ? J.g[k0 + 8 * c + j] : 1.0f;
#pragma unroll
    for (int j = 0; j < 4; ++j) { const int n = (lane >> 3) + 8 * j; const LAS float* s = scr + (8 * c) * 33 + n;
        v4u o; o.x = pk2(s[0 * 33] * gk[0], s[1 * 33] * gk[1]); o.y = pk2(s[2 * 33] * gk[2], s[3 * 33] * gk[3]); o.z = pk2(s[4 * 33] * gk[4], s[5 * 33] * gk[5]); o.w = pk2(s[6 * 33] * gk[6], s[7 * 33] * gk[7]);
        *(GAS v4u*)(J.WT + (size_t)(drow0 + n) * J.K + k0 + 8 * c) = o; }
    if (J.mode) {
        float cs = 0.f, bw = 0.f; const int kh = (lane >> 5) * 32;
#pragma unroll 8
        for (int t = 0; t < 32; ++t) { const int kk = kh + t; const float w = scr[kk * 33 + (lane & 31)]; cs += bf_round(w * J.g[k0 + kk]); bw += w * J.b[k0 + kk]; }
        cs += shx(cs, 32, lane); bw += shx(bw, 32, lane);
        if (lane < 32) { J.pcs[(size_t)kb * J.N + drow0 + lane] = cs; J.pbw[(size_t)kb * J.N + drow0 + lane] = bw; }
    }
    LDS_WAIT(); asm volatile("" ::: "memory");
}

struct Args { const float* in[20]; float* out; unsigned char* ws; int ph_lo, ph_hi; };
#define CAS __attribute__((address_space(4)))
__device__ __forceinline__ const unsigned char CAS* kargs_() { const unsigned char CAS* p = (const unsigned char CAS*)__builtin_amdgcn_kernarg_segment_ptr(); asm volatile("" : "+s"(p)); return p; }
__device__ __forceinline__ const float* arg_in(int i) { return (const float*)(const GAS float*)*(const float* const CAS*)(kargs_() + 8 * i); }
__device__ __forceinline__ float* arg_out() { return (float*)(GAS float*)*(float* const CAS*)(kargs_() + 160); }
__device__ __forceinline__ unsigned char* arg_ws() { return (unsigned char*)(GAS unsigned char*)*(unsigned char* const CAS*)(kargs_() + 168); }
static_assert(sizeof(Args) == 184, "Args layout");

__device__ __forceinline__ TJob make_job(int id) {
    unsigned char* ws = arg_ws(); float* part = (float*)(ws + WS_PART);
    TJob J; J.mode = 0; J.g = nullptr; J.b = nullptr; J.pcs = nullptr; J.pbw = nullptr;
    switch (id) {
    case 0: J.W = arg_in(4); J.K = D; J.N = HW; J.WT = (bf16*)(ws + WS_W_IN); break;
    case 1: J.W = arg_in(9); J.K = D; J.N = D; J.WT = (bf16*)(ws + WS_W_OA); break;
    case 2: J.W = arg_in(10); J.K = D; J.N = NQKV; J.WT = (bf16*)(ws + WS_W_QKV); break;
    case 3: J.W = arg_in(11); J.K = AW; J.N = D; J.WT = (bf16*)(ws + WS_W_OB); break;
    case 4: case 5: { const int l = id - 4; J.W = arg_in(14) + (size_t)l * D * NGU; J.K = D; J.N = NGU; J.WT = (bf16*)(ws + WS_W_GU + l * W_GU_STRIDE); J.mode = 2;
        J.g = arg_in(12) + l * D; J.b = arg_in(13) + l * D; J.pcs = part + PART_GU + l * PART_GU_L; J.pbw = J.pcs + (size_t)KB32 * NGU; break; }
    case 6: case 7: { const int l = id - 6; J.W = arg_in(15) + (size_t)l * FF * D; J.K = FF; J.N = D; J.WT = (bf16*)(ws + WS_W_DN + l * W_DN_STRIDE); break; }
    case 8: case 9: { const int l = id - 8; J.W = arg_in(18) + (size_t)l * D * D; J.K = D; J.N = D; J.WT = (bf16*)(ws + WS_W_GT + l * W_GT_STRIDE); J.mode = 1;
        J.g = arg_in(16) + l * D; J.b = arg_in(17) + l * D; J.pcs = part + PART_GT + l * PART_GT_L; J.pbw = J.pcs + (size_t)KB32 * D; break; }
    default: { const int l = id - 10; J.W = arg_in(19) + (size_t)l * PLE * D; J.K = PLE; J.N = D; J.WT = (bf16*)(ws + WS_W_PJ + l * W_PJ_STRIDE); break; }
    }
    return J;
}
__device__ __forceinline__ int job_items(int id) {
    switch (id) { case 0: return (D / 64) * (HW / 32); case 1: return (D / 64) * (D / 32); case 2: return (D / 64) * (NQKV / 32); case 3: return (AW / 64) * (D / 32);
        case 4: case 5: return (D / 64) * (NGU / 32); case 6: case 7: return (FF / 64) * (D / 32); case 8: case 9: return (D / 64) * (D / 32); default: return (PLE / 64) * (D / 32); }
}

__device__ __forceinline__ void conv_bf16(const float* src, bf16* dst, size_t n8, size_t gt, size_t nthr) {
    for (size_t i = gt; i < n8; i += nthr) {
        const f32x4 a = *(const GAS f32x4*)(src + 8 * i), b = *(const GAS f32x4*)(src + 8 * i + 4);
        v4u o; o.x = pk2(a[0], a[1]); o.y = pk2(a[2], a[3]); o.z = pk2(b[0], b[1]); o.w = pk2(b[2], b[3]);
        *(GAS v4u*)(dst + 8 * i) = o;
    }
}

__device__ __forceinline__ void prologue_phase(LAS unsigned char* lds, int G, int wid0) {
    const int tid = opaque_tid(wid0), lane = tid & 63, wave = tid >> 6;
    LAS float* scr = (LAS float*)(lds + wave * 16384);
    const int gw = blockIdx.x * NWAVES + wave, NGW = G * NWAVES;
#pragma unroll 1
    for (int id = 0; id < 12; ++id) {
        const TJob J = make_job(id); const int ni = job_items(id);
#pragma unroll 1
        for (int it = gw; it < ni; it += NGW) tr_item(J, scr, it, lane);
    }
    const size_t gt = (size_t)blockIdx.x * 512 + tid, nthr = (size_t)G * 512;
    conv_bf16(arg_in(7), (bf16*)(arg_ws() + WS_W_S), (size_t)16 * 128 * 128 / 8, gt, nthr);
    float* rot = (float*)(arg_ws() + WS_ROT);
    for (size_t i = gt; i < (size_t)16384 * 16; i += nthr) { const int pos = (int)(i >> 4), f = (int)(i & 15); float s, c; sincos_f64((float)pos * kInvFreq[f], s, c); rot[pos * 32 + f] = c; rot[pos * 32 + 16 + f] = s; }
}
__device__ __forceinline__ void finalize_vecs(int G, int wid0) {
    const float* part = (const float*)(arg_ws() + WS_PART); float* vec = (float*)(arg_ws() + WS_VEC);
    const int gt = blockIdx.x * 512 + opaque_tid(wid0), nthr = G * 512;
    for (int i = gt; i < 2 * 2 * NGU; i += nthr) {
        const float* p = part + PART_GU + (size_t)(i / NGU) * KB32 * NGU + (i % NGU); float s = 0.f;
        for (int kb = 0; kb < KB32; ++kb) s += p[(size_t)kb * NGU];
        vec[VEC_GU + i] = s;
    }
    for (int i = gt; i < 2 * 2 * D; i += nthr) {
        const float* p = part + PART_GT + (size_t)(i / D) * KB32 * D + (i % D); float s = 0.f;
        for (int kb = 0; kb < KB32; ++kb) s += p[(size_t)kb * D];
        vec[VEC_GT + i] = s;
    }
}

__device__ __forceinline__ void sgu_phase(LAS unsigned char* lds, const bf16* H, bf16* GATED, const bf16* WS, const float* bs, const float* lng, const float* lnb, int G, int wid0) {
    const int tid = opaque_tid(wid0), lane = tid & 63, wave = tid >> 6, i16 = lane & 15, kq = lane >> 4;
    LAS f32x2v* SV = (LAS f32x2v*)(lds + STAB_OFF);
#pragma unroll 1
    for (int chunk = blockIdx.x; chunk < MG / 128; chunk += G) {
        const size_t row0 = (size_t)chunk * 128;
#pragma unroll 1
        for (int rr = 0; rr < 16; ++rr) {
            const int r = wave * 16 + rr; const bf16* vrow = H + (row0 + r) * HW + D;
            v4u d[4]; float x[32]; float s = 0.f;
#pragma unroll
            for (int j = 0; j < 4; ++j) d[j] = *(const GAS v4u*)(vrow + 8 * (lane + 64 * j));
#pragma unroll
            for (int j = 0; j < 4; ++j) { x[8 * j + 0] = bf_lo(d[j].x); x[8 * j + 1] = bf_hi(d[j].x); x[8 * j + 2] = bf_lo(d[j].y); x[8 * j + 3] = bf_hi(d[j].y);
                x[8 * j + 4] = bf_lo(d[j].z); x[8 * j + 5] = bf_hi(d[j].z); x[8 * j + 6] = bf_lo(d[j].w); x[8 * j + 7] = bf_hi(d[j].w); }
#pragma unroll
            for (int j = 0; j < 32; ++j) s += x[j];
            const float mean = wave_sum(s, lane) * (1.0f / D); float s2 = 0.f;
#pragma unroll
            for (int j = 0; j < 32; ++j) { const float t = x[j] - mean; s2 += t * t; }
            const float rstd = 1.0f / sqrtf(wave_sum(s2, lane) * (1.0f / D) + LN_EPS);
            if (lane == 0) SV[r] = (f32x2v){mean, rstd};
        }
        WG_BAR();
        const int p = 16 * wave + i16;
#pragma unroll 1
        for (int g = 0; g < 16; ++g) {
            LAS unsigned char* img = lds + (g & 1) * 32768;
#pragma unroll
            for (int n = 0; n < 4; ++n) {
                const int id = tid + 512 * n, q = id >> 4, ch = id & 15; const int c0 = g * 128 + ch * 8;
                const v4u d = *(const GAS v4u*)(H + (row0 + q) * HW + D + c0);
                const f32x2v sr = SV[q];
                const f32x4 g0 = *(const GAS f32x4*)(lng + c0), g1 = *(const GAS f32x4*)(lng + c0 + 4), b0 = *(const GAS f32x4*)(lnb + c0), b1 = *(const GAS f32x4*)(lnb + c0 + 4);
                f32x4 x0, x1; x0[0] = bf_lo(d.x); x0[1] = bf_hi(d.x); x0[2] = bf_lo(d.y); x0[3] = bf_hi(d.y); x1[0] = bf_lo(d.z); x1[1] = bf_hi(d.z); x1[2] = bf_lo(d.w); x1[3] = bf_hi(d.w);
                x0 = ((x0 - sr.x) * sr.y) * g0 + b0; x1 = ((x1 - sr.x) * sr.y) * g1 + b1;
                v4u o; o.x = pk2(x0[0], x0[1]); o.y = pk2(x0[2], x0[3]); o.z = pk2(x1[0], x1[1]); o.w = pk2(x1[2], x1[3]);
                *(LAS v4u*)(img + off_b(q, ch)) = o;
            }
            bf16x8 wf[4];
#pragma unroll
            for (int s = 0; s < 4; ++s) wf[s] = *(const GAS bf16x8*)(WS + ((size_t)(g * 128 + p)) * 128 + 32 * s + 8 * kq);
            const float bias = bs[g * 128 + p];
            WG_BAR();
            f32x4 acc[8];
#pragma unroll
            for (int ct = 0; ct < 8; ++ct) {
                f32x4 c4 = (f32x4){0.f, 0.f, 0.f, 0.f};
#pragma unroll
                for (int s = 0; s < 4; ++s) {
                    const unsigned qq = (unsigned)(i16 >> 2), pp = (unsigned)(lane & 3);
                    const s16x4 lo = tr_read(img + off_b(32 * s + 8 * kq + qq, 2 * ct + (pp >> 1)) + 8 * (pp & 1));
                    const s16x4 hi = tr_read(img + off_b(32 * s + 8 * kq + 4 + qq, 2 * ct + (pp >> 1)) + 8 * (pp & 1));
                    const bf16x8 af = __builtin_shufflevector(lo, hi, 0, 1, 2, 3, 4, 5, 6, 7);
                    c4 = PG8_MFMA16(af, wf[s], c4);
                }
                acc[ct] = c4;
            }
#pragma unroll
            for (int ct = 0; ct < 8; ++ct) {
                const int c = g * 128 + 16 * ct + 4 * kq;
                const v2u uw = *(const GAS v2u*)(H + (row0 + p) * HW + c);
                const float o0 = (acc[ct][0] + bias) * bf_lo(uw.x), o1 = (acc[ct][1] + bias) * bf_hi(uw.x), o2 = (acc[ct][2] + bias) * bf_lo(uw.y), o3 = (acc[ct][3] + bias) * bf_hi(uw.y);
                v2u ow; ow.x = pk2(o0, o1); ow.y = pk2(o2, o3);
                *(GAS v2u*)(GATED + (row0 + p) * D + c) = ow;
            }
        }
        WG_BAR();
    }
}

__device__ __forceinline__ void attn_phase(LAS unsigned char* lds, bf16* QKV, float* LSE, int S, int G, bool dry, int wid0) {
    const int tid = opaque_tid(wid0), lane = tid & 63, wave = tid >> 6, iq = lane & 15, kq = lane >> 4;
    LAS unsigned char* Kimg = lds; LAS unsigned char* Vimg = lds + 65536;
    const int tps = S >> 7;
#pragma unroll 1
    for (int u = blockIdx.x; u < 3 * 8 * (MG / 128); u += G) {
        const int g = u / (8 * (MG / 128)), rem = u - g * (8 * (MG / 128)), h = rem & 7, ts = rem >> 3;
        const int ldil = 2 * g, dil = 1 << ldil;
        const int b = ts / tps, wslot = ts - b * tps;
        const int L = S >> ldil, tpr = L >> 7;
        const int r = wslot / tpr, it = wslot - r * tpr, i0 = it * 128;
        const size_t tok0 = (size_t)b * S + r;
        bf16* Qb = QKV + g * 3072 + h * 128; const bf16* Kb = Qb + 1024; const bf16* Vb = Qb + 2048;
#pragma unroll
        for (int n = 0; n < 8; ++n) {
            const int id = tid + 512 * n, kl = id >> 4, ch = id & 15, j = i0 - 64 + kl;
            v4u kv = (v4u){0u, 0u, 0u, 0u}, vv = (v4u){0u, 0u, 0u, 0u};
            if (j >= 0 && j < L) { const size_t off = (tok0 + (size_t)j * dil) * NQKV + ch * 8; kv = *(const GAS v4u*)(Kb + off); vv = *(const GAS v4u*)(Vb + off); }
            *(LAS v4u*)(Kimg + off_b(kl, ch)) = kv; *(LAS v4u*)(Vimg + off_b(kl, ch)) = vv;
        }
        const int qi = i0 + 16 * wave + iq; const size_t qtok = tok0 + (size_t)qi * dil;
        bf16x8 qf[4];
#pragma unroll
        for (int s = 0; s < 4; ++s) qf[s] = *(const GAS bf16x8*)(Qb + qtok * NQKV + 32 * s + 8 * kq);
        WG_BAR();
        f32x4 st[9];
#pragma unroll
        for (int T = 0; T < 9; ++T) {
            f32x4 c4 = (f32x4){0.f, 0.f, 0.f, 0.f};
#pragma unroll
            for (int s = 0; s < 4; ++s) { const bf16x8 kf = *(const LAS bf16x8*)(Kimg + off_b(16 * wave + 16 * T + iq, 4 * s + kq)); c4 = PG8_MFMA16(kf, qf[s], c4); }
            st[T] = c4;
        }
        float mx = -3.0e38f;
#pragma unroll
        for (int T = 0; T < 9; ++T)
#pragma unroll
            for (int e = 0; e < 4; ++e) { const int kr = 16 * T + 4 * kq + e - iq, j = i0 + 16 * wave - 64 + 16 * T + 4 * kq + e;
                const bool ok = (kr >= 0) && (kr <= 128) && (j >= 0) && (j < L); st[T][e] = ok ? st[T][e] : -1.0e30f; mx = fmaxf(mx, st[T][e]); }
        mx = fmaxf(mx, shx(mx, 16, lane)); mx = fmaxf(mx, shx(mx, 32, lane));
        float den = 0.f;
#pragma unroll
        for (int T = 0; T < 9; ++T)
#pragma unroll
            for (int e = 0; e < 4; ++e) { const float pv = fast_exp2(st[T][e] - mx); st[T][e] = pv; den += pv; }
        den += shx(den, 16, lane); den += shx(den, 32, lane);
        bf16x8 pf[5];
#pragma unroll
        for (int s2 = 0; s2 < 5; ++s2) {
            v4u w; w.x = pk2(st[2 * s2][0], st[2 * s2][1]); w.y = pk2(st[2 * s2][2], st[2 * s2][3]);
            if (s2 < 4) { w.z = pk2(st[2 * s2 + 1][0], st[2 * s2 + 1][1]); w.w = pk2(st[2 * s2 + 1][2], st[2 * s2 + 1][3]); } else { w.z = 0u; w.w = 0u; }
            pf[s2] = __builtin_bit_cast(bf16x8, w);
        }
        const float inv = 1.0f / den;
        const unsigned qq = (unsigned)(iq >> 2), pp = (unsigned)(lane & 3);
#pragma unroll
        for (int c = 0; c < 8; ++c) {
            f32x4 o4 = (f32x4){0.f, 0.f, 0.f, 0.f};
#pragma unroll
            for (int s2 = 0; s2 < 5; ++s2) {
                unsigned r0 = 16 * wave + 32 * s2 + 4 * kq + qq, r1 = r0 + 16; r1 = r1 > 255u ? 255u : r1;
                const s16x4 lo = tr_read(Vimg + off_b(r0, 2 * c + (pp >> 1)) + 8 * (pp & 1));
                const s16x4 hi = tr_read(Vimg + off_b(r1, 2 * c + (pp >> 1)) + 8 * (pp & 1));
                const bf16x8 vf = __builtin_shufflevector(lo, hi, 0, 1, 2, 3, 4, 5, 6, 7);
                o4 = PG8_MFMA16(vf, pf[s2], o4);
            }
            v2u ow; ow.x = pk2(o4[0] * inv, o4[1] * inv); ow.y = pk2(o4[2] * inv, o4[3] * inv);
            if (!dry) *(GAS v2u*)(Qb + qtok * NQKV + 16 * c + 4 * kq) = ow;
        }
        if (kq == 0 && !dry) LSE[(qtok * 3 + g) * 8 + h] = (mx + __builtin_amdgcn_logf(den)) * LN2;
        WG_BAR();
    }
}
__device__ __forceinline__ void combine_phase(const bf16* QKV, const float* LSE, bf16* ATT, int G, int wid0) {
    const size_t gt = (size_t)blockIdx.x * 512 + opaque_tid(wid0), nthr = (size_t)G * 512;
    for (size_t i = gt; i < (size_t)MG * 128; i += nthr) {
        const size_t t = i >> 7; const int ch = (int)(i & 127), h = ch >> 4;
        const float l0 = LSE[(t * 3 + 0) * 8 + h], l1 = LSE[(t * 3 + 1) * 8 + h], l2 = LSE[(t * 3 + 2) * 8 + h];
        const float m = fmaxf(l0, fmaxf(l1, l2));
        float w0 = fast_exp2((l0 - m) * 1.4426950408889634f), w1 = fast_exp2((l1 - m) * 1.4426950408889634f), w2 = fast_exp2((l2 - m) * 1.4426950408889634f);
        const float inv = 1.0f / (w0 + w1 + w2); w0 *= inv; w1 *= inv; w2 *= inv;
        const v4u a = *(const GAS v4u*)(QKV + t * NQKV + ch * 8), b = *(const GAS v4u*)(QKV + t * NQKV + 3072 + ch * 8), c = *(const GAS v4u*)(QKV + t * NQKV + 6144 + ch * 8);
        v4u o;
        o.x = pk2(w0 * bf_lo(a.x) + w1 * bf_lo(b.x) + w2 * bf_lo(c.x), w0 * bf_hi(a.x) + w1 * bf_hi(b.x) + w2 * bf_hi(c.x));
        o.y = pk2(w0 * bf_lo(a.y) + w1 * bf_lo(b.y) + w2 * bf_lo(c.y), w0 * bf_hi(a.y) + w1 * bf_hi(b.y) + w2 * bf_hi(c.y));
        o.z = pk2(w0 * bf_lo(a.z) + w1 * bf_lo(b.z) + w2 * bf_lo(c.z), w0 * bf_hi(a.z) + w1 * bf_hi(b.z) + w2 * bf_hi(c.z));
        o.w = pk2(w0 * bf_lo(a.w) + w1 * bf_lo(b.w) + w2 * bf_lo(c.w), w0 * bf_hi(a.w) + w1 * bf_hi(b.w) + w2 * bf_hi(c.w));
        *(GAS v4u*)(ATT + t * AW + ch * 8) = o;
    }
}

#ifndef MK_PER_PHASE
#define MK_PER_PHASE 0
#endif
constexpr int N_PHASES = 1 + 2 * (1 + 2 + 4 + 3 + 4);
#ifndef PROBE_SITE
#define PROBE_SITE 0
#endif
#define REPS(site, cond) ((PROBE_SITE == (site) && (cond)) ? 2 : 1)

__global__ void __launch_bounds__(NWAVES * 64, 2) trunk_fwd(Args args) {
    extern __shared__ __attribute__((aligned(16))) unsigned char lds_raw[];
    LAS unsigned char* lds = (LAS unsigned char*)lds_raw;
    LAS unsigned char* xl = lds + RING_BYTES;
    const int G = gridDim.x;
    const int wid0 = __builtin_amdgcn_readfirstlane((int)threadIdx.x >> 6);
    for (int u = threadIdx.x; u < (LDS_BYTES - RING_BYTES) / 4; u += NWAVES * 64) ((LAS unsigned*)(lds + RING_BYTES))[u] = 0u;
    __syncthreads();
    const int lo = args.ph_lo, hi = args.ph_hi;
    XcdBarrier bar; bar.wid0 = wid0; bar.bar = (unsigned*)(arg_ws() + WS_CTL); bar.x = 0; bar.st = (volatile LAS unsigned*)(lds + MISC_OFF) + 8;
    if (hi - lo > 1) { bar = xcd_barrier_post((unsigned*)(arg_ws() + WS_CTL), (volatile LAS unsigned*)(lds + MISC_OFF) + 8); bar.wid0 = wid0; }
    int pc = 0;
#define RUN_PH (pc >= lo && pc < hi)
#define SEAM() do { if (pc >= lo && pc + 1 < hi) { XcdBarrier b2_ = bar; asm volatile("" : "+s"(b2_.bar), "+s"(b2_.x)); b2_.bar = (unsigned*)(GAS unsigned*)b2_.bar; xcd_barrier(b2_); } ++pc; } while (0)
#define WSP(T, off) ((T*)(arg_ws() + (off)))
#define BIGP(T, off) ((T*)(arg_ws() + WS_BIG + (off)))
#define XOUT(grp) (arg_out() + (size_t)(grp) * MG * D)
#define VECP() ((const float*)(arg_ws() + WS_VEC))
#define PH_LOCALS int grp_ = grp, layer_ = layer; asm volatile("" : "+s"(grp_), "+s"(layer_)); const int S_ = grp_ == 0 ? 2048 : 16384; (void)layer_; (void)S_

    if (RUN_PH) { _Pragma("unroll 1") for (int rep = 0; rep < REPS(1, true); ++rep) prologue_phase(lds, G, wid0); }
    SEAM();
#pragma unroll 1
    for (int grp = 0; grp < 2; ++grp) {
        if (RUN_PH) { int grp_ = grp; asm volatile("" : "+s"(grp_)); _Pragma("unroll 1") for (int rep = 0; rep < REPS(2, grp_ == 0); ++rep)
            conv_bf16(arg_in(grp_), WSP(bf16, WS_XB), (size_t)MG * D / 8, (size_t)blockIdx.x * 512 + opaque_tid(wid0), (size_t)G * 512);
            if (grp_ == 0) finalize_vecs(G, wid0);
        }
        SEAM();
#pragma unroll 1
        for (int layer = 0; layer < 2; ++layer) {
            if (layer == 0) {
                if (RUN_PH) { PH_LOCALS; _Pragma("unroll 1") for (int rep = 0; rep < REPS(3, grp_ == 0); ++rep) {
                    pg8::Gemm g{WSP(bf16, WS_XB), WSP(const bf16, WS_W_IN), MG, HW, D, wid0}; pg8::StaticOrder So; So.init(MG, HW, G, (int)blockIdx.x);
                    pg8::EpiPlain<1> E{BIGP(bf16, BIG_H), HW, wid0};
                    pg8::gemm_phase<pg8::EpiPlain<1>, pg8::StaticOrder, true, true>(lds, g, So, E);
                } }
                SEAM();
                if (RUN_PH) { PH_LOCALS; _Pragma("unroll 1") for (int rep = 0; rep < REPS(4, grp_ == 0); ++rep) sgu_phase(lds, BIGP(const bf16, BIG_H), BIGP(bf16, BIG_GATED), WSP(const bf16, WS_W_S), arg_in(8), arg_in(5), arg_in(6), G, wid0); }
                SEAM();
            } else {
                if (RUN_PH) { PH_LOCALS; _Pragma("unroll 1") for (int rep = 0; rep < REPS(5, grp_ == 0); ++rep) {
                    pg8::Gemm g{WSP(bf16, WS_XB), WSP(const bf16, WS_W_QKV), MG, NQKV, D, wid0}; pg8::StaticOrder So; So.init(MG, NQKV, G, (int)blockIdx.x);
                    pg8::EpiQKV E{BIGP(bf16, BIG_QKV), WSP(const float, WS_ROT), S_ - 1, QSCALE, wid0};
                    pg8::gemm_phase<pg8::EpiQKV, pg8::StaticOrder, true, true>(lds, g, So, E);
                } }
                SEAM();
                if (RUN_PH) { PH_LOCALS; _Pragma("unroll 1") for (int rep = REPS(6, grp_ == 0) - 1; rep >= 0; --rep) attn_phase(lds, BIGP(bf16, BIG_QKV), BIGP(float, BIG_LSE), S_, G, rep != 0, wid0); }
                SEAM();
                if (RUN_PH) { PH_LOCALS; _Pragma("unroll 1") for (int rep = 0; rep < REPS(7, grp_ == 0); ++rep) combine_phase(BIGP(const bf16, BIG_QKV), BIGP(const float, BIG_LSE), BIGP(bf16, BIG_ATT), G, wid0); }
                SEAM();
            }
            if (RUN_PH) { PH_LOCALS; _Pragma("unroll 1") for (int rep = 0; rep < REPS(8, grp_ == 0 && layer_ == 0); ++rep) {
                conv_bf16(arg_in(2 + grp_) + (size_t)layer_ * MG * PLE, BIGP(bf16, BIG_PB), (size_t)MG * PLE / 8, (size_t)blockIdx.x * 512 + opaque_tid(wid0), (size_t)G * 512);
                pg8::Gemm g{layer_ == 0 ? BIGP(const bf16, BIG_GATED) : BIGP(const bf16, BIG_ATT), layer_ == 0 ? WSP(const bf16, WS_W_OA) : WSP(const bf16, WS_W_OB), MG, D, layer_ == 0 ? D : AW, wid0};
                pg8::StaticOrder So; So.init(MG, D, G, (int)blockIdx.x);
                pg8::EpiY1 E{layer_ == 0 ? arg_in(grp_) : (const float*)nullptr, WSP(const bf16, WS_XB), WSP(bf16, WS_XB), WSP(float, WS_ST1), xl, ALPHA, wid0};
                pg8::gemm_phase<pg8::EpiY1, pg8::StaticOrder, true, true>(lds, g, So, E);
            } }
            SEAM();
            if (RUN_PH) { PH_LOCALS; _Pragma("unroll 1") for (int rep = 0; rep < REPS(9, grp_ == 0 && layer_ == 0); ++rep) {
                { pg8::Gemm g{BIGP(const bf16, BIG_PB), WSP(const bf16, WS_W_PJ + layer_ * W_PJ_STRIDE), MG, D, PLE, wid0}; pg8::StaticOrder So; So.init(MG, D, G, (int)blockIdx.x);
                  pg8::EpiPlain<0> E{BIGP(bf16, BIG_PP), D, wid0};
                  pg8::gemm_phase<pg8::EpiPlain<0>, pg8::StaticOrder, true, true>(lds, g, So, E); }
                { pg8::Gemm g{WSP(const bf16, WS_XB), WSP(const bf16, WS_W_GU + layer_ * W_GU_STRIDE), MG, NGU, D, wid0}; pg8::StaticOrder So; So.init(MG, NGU, G, (int)blockIdx.x);
                  pg8::EpiGU E{WSP(const float, WS_ST1), VECP() + VEC_GU + layer_ * VEC_GU_L, VECP() + VEC_GU + layer_ * VEC_GU_L + NGU, BIGP(bf16, BIG_HB), xl, LN_EPS, wid0};
                  pg8::gemm_phase<pg8::EpiGU, pg8::StaticOrder, true, true>(lds, g, So, E); }
            } }
            SEAM();
            if (RUN_PH) { PH_LOCALS; _Pragma("unroll 1") for (int rep = 0; rep < REPS(10, grp_ == 0 && layer_ == 0); ++rep) {
                pg8::Gemm g{BIGP(const bf16, BIG_HB), WSP(const bf16, WS_W_DN + layer_ * W_DN_STRIDE), MG, D, FF, wid0}; pg8::StaticOrder So; So.init(MG, D, G, (int)blockIdx.x);
                pg8::EpiY2 E{WSP(const bf16, WS_XB), BIGP(bf16, BIG_XB2), WSP(const float, WS_ST1), WSP(float, WS_ST2), arg_in(12) + layer_ * D, arg_in(13) + layer_ * D, xl, ALPHA, LN_EPS, wid0};
                pg8::gemm_phase<pg8::EpiY2, pg8::StaticOrder, true, true>(lds, g, So, E);
            } }
            SEAM();
            if (RUN_PH) { PH_LOCALS; _Pragma("unroll 1") for (int rep = 0; rep < REPS(11, grp_ == 0 && layer_ == 0); ++rep) {
                pg8::Gemm g{BIGP(const bf16, BIG_XB2), WSP(const bf16, WS_W_GT + layer_ * W_GT_STRIDE), MG, D, D, wid0}; pg8::StaticOrder So; So.init(MG, D, G, (int)blockIdx.x);
                pg8::EpiPLE E{BIGP(const bf16, BIG_XB2), layer_ == 0 ? (float*)nullptr : XOUT(grp_), WSP(bf16, WS_XB), BIGP(const bf16, BIG_PP), WSP(const float, WS_ST2), arg_in(16) + layer_ * D, arg_in(17) + layer_ * D,
                              VECP() + VEC_GT + layer_ * VEC_GT_L, VECP() + VEC_GT + layer_ * VEC_GT_L + D, xl, LN_EPS, wid0};
                pg8::gemm_phase<pg8::EpiPLE, pg8::StaticOrder, true, true>(lds, g, So, E);
            } }
            SEAM();
        }
    }
#undef RUN_PH
#undef SEAM
}

extern "C" void kernel_launch(void* const* d_in, const int* in_sizes, int n_in, void* d_out, int out_size, void* d_ws, size_t ws_size, hipStream_t stream) {
    static int grid = 0;
    if (grid == 0) {
        if (n_in != 20 || in_sizes[0] != MG * D || in_sizes[1] != MG * D || out_size != 2 * MG * D || ws_size < WS_END) {
            fprintf(stderr, "kernel_launch: unexpected shapes (n_in %d, in0 %d, out %d, ws %zu < %zu); nothing launched\n", n_in, n_in > 0 ? in_sizes[0] : -1, out_size, ws_size, (size_t)WS_END); grid = -1; return; }
        int dev = 0, cus = 0, per_cu = 0;
        if (hipGetDevice(&dev) != hipSuccess || hipDeviceGetAttribute(&cus, hipDeviceAttributeMultiprocessorCount, dev) != hipSuccess) { grid = -1; return; }
        if (hipFuncSetAttribute((const void*)trunk_fwd, hipFuncAttributeMaxDynamicSharedMemorySize, LDS_BYTES) != hipSuccess) { fprintf(stderr, "kernel_launch: hipFuncSetAttribute failed\n"); grid = -1; return; }
        if (hipOccupancyMaxActiveBlocksPerMultiprocessor(&per_cu, (const void*)trunk_fwd, NWAVES * 64, LDS_BYTES) != hipSuccess || per_cu < 1)
            fprintf(stderr, "kernel_launch: note: occupancy query reports %d workgroups per CU\n", per_cu);
        (void)hipGetLastError();
        grid = cus;
    }
    if (grid < 0) return;
    if (hipMemsetAsync((char*)d_ws + WS_CTL, 0, CTL_ZERO_BYTES, stream) != hipSuccess) return;
    Args a{};
    for (int i = 0; i < 20; ++i) a.in[i] = (const float*)d_in[i];
    a.out = (float*)d_out; a.ws = (unsigned char*)d_ws;
#if MK_PER_PHASE
    for (int p = 0; p < N_PHASES; ++p) { a.ph_lo = p; a.ph_hi = p + 1; hipLaunchKernelGGL(trunk_fwd, dim3(grid), dim3(NWAVES * 64), LDS_BYTES, stream, a); }
#else
    a.ph_lo = 0; a.ph_hi = N_PHASES;
    hipLaunchKernelGGL(trunk_fwd, dim3(grid), dim3(NWAVES * 64), LDS_BYTES, stream, a);
#endif
    const hipError_t le = hipPeekAtLastError();
    if (le != hipSuccess) fprintf(stderr, "kernel_launch: launch failed: %s\n", hipGetErrorName(le));
}
```

```cpp
#include <hip/hip_runtime.h>
#include <cstdio>
#include <cstdint>
namespace pg8 {
#define PG8_LAS __attribute__((address_space(3)))
typedef unsigned short bf16_t;
typedef short bf16x8 __attribute__((ext_vector_type(8)));
typedef float f32x4 __attribute__((ext_vector_type(4)));
typedef unsigned u32x4 __attribute__((ext_vector_type(4)));
constexpr int BM = 256, BK = 64, HALF = 128, HTB = HALF * BK * 2  , STAGE_BYTES = 8 * HTB, NXCD = 8, WGM = 8;

__host__ __device__ __forceinline__ int lds_byte(int r, int c) { const int st = (r >> 4) * 2 + (c >> 5), rr = r & 15, cc = c & 31, ob = rr * 64 + cc * 2; return st * 1024 + (ob ^ (((ob >> 9) & 1) << 5)); }
__host__ __device__ __forceinline__ void stage_rc(int b, int& R, int& C) { const int st = b / 1024, sb = b % 1024, swz = sb ^ (((sb >> 9) & 1) << 5); R = (st >> 1) * 16 + swz / 64; C = (st & 1) * 32 + (swz % 64) / 2; }
__host__ __device__ __forceinline__ int perm32(int rho) { const int n = rho >> 4, i = rho & 15; return 8 * (i >> 2) + 4 * n + (i & 3); }

struct Unit { int pm, pn; };
struct Gemm { const bf16_t* A; const bf16_t* Bt; int M, N, K, wid0; };

struct StaticOrder {
    int nM, nN, nwg, G, c;
    __host__ __device__ void init(int M, int N, int G_, int c_) { nM = M / BM; nN = N / BM; nwg = nM * nN; G = G_; c = c_; }
    __host__ __device__ bool next(int i, Unit& u) const {
        const long L = (long)i * G + c; if (L >= nwg) return false;
        int wgid = (int)L; { const int q = nwg / NXCD, r = nwg % NXCD, xcd = wgid % NXCD, off = wgid / NXCD; wgid = (xcd < r ? xcd * (q + 1) : r * (q + 1) + (xcd - r) * q) + off; }
        const int nig = WGM * nN, gid = wgid / nig, fm = gid * WGM, gsz = (nM - fm) < WGM ? (nM - fm) : WGM;
        u.pm = fm + ((wgid % nig) % gsz); u.pn = (wgid % nig) / gsz; return true;
    }
    __device__ __forceinline__ void a_ready(const Unit&) const {}
    __device__ __forceinline__ void done(const Unit&) const {}
};
typedef _Float16 h16x2 __attribute__((ext_vector_type(2)));
typedef _Float16 h16x8 __attribute__((ext_vector_type(8)));
typedef float f32x2p __attribute__((ext_vector_type(2)));
__device__ __forceinline__ unsigned cvt_pk16(float lo, float hi) { const f32x2p v = {lo, hi}; return __builtin_bit_cast(unsigned, __builtin_convertvector(v, h16x2)); }
#define PG8_MFMA16(a, b, c) __builtin_amdgcn_mfma_f32_16x16x32_f16(__builtin_bit_cast(pg8::h16x8, (a)), __builtin_bit_cast(pg8::h16x8, (b)), (c), 0, 0, 0)
typedef float f32x2 __attribute__((ext_vector_type(2)));
__device__ __forceinline__ f32x2 gelu_pk(f32x2 v) {
    const f32x2 av = __builtin_elementwise_abs(v), d = av * 0.2316418882f + 1.0f;
    f32x2 t; t.x = __builtin_amdgcn_rcpf(d.x); t.y = __builtin_amdgcn_rcpf(d.y);
    f32x2 q = t * 0.5307027145f + (-0.7265760135f); q = q * t + 0.7107068705f; q = q * t + (-0.142248368f); q = q * t + 0.127414796f; q = q * t;
    const f32x2 s = (v * v) * (-0.72134752044f);
    f32x2 e; e.x = __builtin_amdgcn_exp2f(s.x); e.y = __builtin_amdgcn_exp2f(s.y);
    const f32x2 m = v * (q * e), r = v - m;
    f32x2 o; o.x = v.x < 0.f ? m.x : r.x; o.y = v.y < 0.f ? m.y : r.y; return o;
}

template <int ACT  > struct EpiBf16 {
    static constexpr bool PERM = true, AFTER_DRAIN = false; static_assert(ACT == 0 || ACT == 1, "EpiBf16: ACT is 0 (none) or 1 (gelu_pk)");
    bf16_t* O; int ldc; const float* bias; int split_cols; size_t split_stride; float scale0;
    __device__ __forceinline__ void operator()(const f32x4 (&acc)[2][2][4][2], const Unit& u, int wr, int wc, int fr, int fq) const {
        const int row0 = u.pm * BM + wr * 64 + fr; int colt = u.pn * BM; bf16_t* base = O;
        float sc = 1.f; if (split_cols) { const int t = colt / split_cols; base += (size_t)t * split_stride; colt -= t * split_cols; if (t == 0) sc = scale0; }
        const int col0 = colt + wc * 32 + 8 * fq, bcol0 = u.pn * BM + wc * 32 + 8 * fq;
        f32x4 bv[2][2];
#pragma unroll
        for (int bj = 0; bj < 2; ++bj)
#pragma unroll
            for (int n = 0; n < 2; ++n) bv[bj][n] = bias ? *(const f32x4*)(bias + bcol0 + bj * HALF + 4 * n) : (f32x4){0.f, 0.f, 0.f, 0.f};
#pragma unroll
        for (int ai = 0; ai < 2; ++ai)
#pragma unroll
            for (int m = 0; m < 4; ++m) { bf16_t* rowp = base + (size_t)(row0 + ai * HALF + m * 16) * ldc + col0;
#pragma unroll
                for (int bj = 0; bj < 2; ++bj) { f32x4 v0 = acc[ai][bj][m][0] + bv[bj][0], v1 = acc[ai][bj][m][1] + bv[bj][1];
                    if (ACT == 1) { f32x2 a = gelu_pk((f32x2){v0[0], v0[1]}), b = gelu_pk((f32x2){v0[2], v0[3]}), c = gelu_pk((f32x2){v1[0], v1[1]}), d = gelu_pk((f32x2){v1[2], v1[3]});
                        v0 = (f32x4){a.x, a.y, b.x, b.y}; v1 = (f32x4){c.x, c.y, d.x, d.y}; }
                    v0 = v0 * sc; v1 = v1 * sc; u32x4 w; w.x = cvt_pk16(v0[0], v0[1]); w.y = cvt_pk16(v0[2], v0[3]); w.z = cvt_pk16(v1[0], v1[1]); w.w = cvt_pk16(v1[2], v1[3]);
                    *(u32x4*)(rowp + bj * HALF) = w; } }
    }
};
}

constexpr int D = 2048, FF = 5632, NGU = 2 * FF, NQKV = 9216, AW = 1024, PLE = 256, HW = 4096;
constexpr int MG = 32768;
constexpr float LN_EPS = 1e-5f;
constexpr float ALPHA = 1.4142135623730951f;
constexpr float QSCALE = 0.08838834764831845f * 1.4426950408889634f;
constexpr float LN2 = 0.6931471805599453f;
constexpr int NWAVES = 8;

constexpr size_t MiB = 1u << 20;
constexpr size_t WS_CTL = 0, CTL_ZERO_BYTES = 65536;
constexpr size_t WS_ROT = 2 * MiB;
constexpr size_t WS_ST1 = 4 * MiB, WS_ST2 = 6 * MiB;
constexpr size_t WS_PART = 8 * MiB;
constexpr size_t WS_VEC = 16 * MiB;
constexpr size_t WS_W_IN = 17 * MiB, WS_W_OA = 33 * MiB, WS_W_S = 41 * MiB, WS_W_QKV = 42 * MiB, WS_W_OB = 78 * MiB;
constexpr size_t WS_W_GU = 82 * MiB, W_GU_STRIDE = 44 * MiB, WS_W_DN = 170 * MiB, W_DN_STRIDE = 22 * MiB;
constexpr size_t WS_W_GT = 214 * MiB, W_GT_STRIDE = 8 * MiB, WS_W_PJ = 230 * MiB, W_PJ_STRIDE = 1 * MiB;
constexpr size_t WS_XB = 232 * MiB;
constexpr size_t WS_BIG = 360 * MiB;
constexpr size_t BIG_H = 0, BIG_GATED = 256 * MiB, BIG_PB = 384 * MiB, BIG_XB2 = 384 * MiB, BIG_HB = 0, BIG_PP = 512 * MiB;
constexpr size_t BIG_QKV = 0, BIG_ATT = 576 * MiB, BIG_LSE = 640 * MiB;
constexpr size_t WS_END = WS_BIG + 643 * MiB;
constexpr int KB32 = 32;
constexpr size_t PART_GU = 0, PART_GU_L = (size_t)2 * KB32 * NGU, PART_GT = 2 * PART_GU_L, PART_GT_L = (size_t)2 * KB32 * D;
constexpr size_t VEC_GU = 0, VEC_GU_L = 2 * NGU, VEC_GT = 2 * VEC_GU_L, VEC_GT_L = 2 * D;
static_assert((PART_GT + 2 * PART_GT_L) * 4 <= 8 * MiB && (VEC_GT + 2 * VEC_GT_L) * 4 <= 1 * MiB, "partials");

constexpr int RING_BYTES = 131072;
constexpr int MISC_OFF = RING_BYTES + 320;
constexpr int STAB_OFF = RING_BYTES + 512;
constexpr int PTAB_OFF = STAB_OFF + 2048;
constexpr int LDS_BYTES = 147456;
static_assert(PTAB_OFF + 8192 <= LDS_BYTES, "LDS map");

#define GAS __attribute__((address_space(1)))
#define LAS __attribute__((address_space(3)))
typedef unsigned short bf16;
typedef unsigned v4u __attribute__((ext_vector_type(4)));
typedef unsigned v2u __attribute__((ext_vector_type(2)));
typedef float f32x4 __attribute__((ext_vector_type(4)));
typedef float f32x2v __attribute__((ext_vector_type(2)));
typedef short bf16x8 __attribute__((ext_vector_type(8)));
typedef short s16x4 __attribute__((ext_vector_type(4)));
#define LDS_WAIT() asm volatile("s_waitcnt lgkmcnt(0)" ::: "memory")
#define VM_WAIT() asm volatile("s_waitcnt vmcnt(0)" ::: "memory")
#define WG_BAR() do { asm volatile("s_waitcnt lgkmcnt(0)" ::: "memory"); __builtin_amdgcn_s_barrier(); asm volatile("" ::: "memory"); } while (0)

__device__ __forceinline__ float bf_round(float f) { return (float)(_Float16)f; }
__device__ __forceinline__ unsigned pk2(float lo, float hi) { return pg8::cvt_pk16(lo, hi); }
__device__ __forceinline__ float bf_lo(unsigned w) { return (float)__builtin_bit_cast(pg8::h16x2, w).x; }
__device__ __forceinline__ float bf_hi(unsigned w) { return (float)__builtin_bit_cast(pg8::h16x2, w).y; }
__device__ __forceinline__ int opaque_tid(int wid0) { int t; asm volatile("v_mbcnt_lo_u32_b32 %0, -1, 0\n\tv_mbcnt_hi_u32_b32 %0, -1, %0" : "=v"(t)); return (wid0 << 6) | t; }
__device__ __forceinline__ float shx(float v, int mask, int lane) { return __builtin_bit_cast(float, __builtin_amdgcn_ds_bpermute((lane ^ mask) << 2, __builtin_bit_cast(int, v))); }
__device__ __forceinline__ float wave_sum(float v, int lane) {
#pragma unroll
    for (int o = 1; o < 64; o <<= 1) v += shx(v, o, lane);
    return v;
}
__device__ __forceinline__ float fast_exp2(float x) { return __builtin_amdgcn_exp2f(x); }
__device__ __forceinline__ float fast_rcp(float x) { return __builtin_amdgcn_rcpf(x); }
__device__ __forceinline__ float sigmoidf_(float x) { return fast_rcp(1.0f + fast_exp2(-1.4426950408889634f * x)); }
__device__ __forceinline__ unsigned off_b(unsigned row, unsigned ch) { return 256u * row + 16u * (ch ^ (((row & 3u) << 2) | ((row >> 2) & 3u))); }
typedef short v4i16_t __attribute__((ext_vector_type(4)));
__device__ __forceinline__ s16x4 tr_read(LAS const unsigned char* p) { return __builtin_bit_cast(s16x4, __builtin_amdgcn_ds_read_tr16_b64_v4i16((LAS v4i16_t*)p)); }

namespace pg8 {
__device__ __forceinline__ void stab_from_partials(const float* st, int pm, PG8_LAS unsigned char* xl, float eps, int wid0) {
    const int tid = opaque_tid(wid0);
    if (tid < 256) {
        const f32x4* p = (const f32x4*)(st + ((size_t)(pm * BM + tid)) * 16);
        const f32x4 a = p[0], b = p[1], c = p[2], d = p[3];
        const float S = ((a[0] + a[2]) + (b[0] + b[2])) + ((c[0] + c[2]) + (d[0] + d[2]));
        const float Q = ((a[1] + a[3]) + (b[1] + b[3])) + ((c[1] + c[3]) + (d[1] + d[3]));
        const float mean = S * (1.0f / 2048.0f); float var = Q * (1.0f / 2048.0f) - mean * mean; var = var < 0.f ? 0.f : var;
        ((PG8_LAS f32x2*)(xl + (STAB_OFF - RING_BYTES)))[tid] = (f32x2){mean, 1.0f / sqrtf(var + eps)};
    }
    asm volatile("s_waitcnt lgkmcnt(0)" ::: "memory"); __builtin_amdgcn_s_barrier(); asm volatile("" ::: "memory");
}
__device__ __forceinline__ void partials_to_st(float* st, const Unit& u, PG8_LAS unsigned char* xl, int wid0) {
    asm volatile("s_waitcnt lgkmcnt(0)" ::: "memory"); __builtin_amdgcn_s_barrier(); asm volatile("" ::: "memory");
    const int tid = opaque_tid(wid0);
    if (tid < 256) {
        const PG8_LAS f32x4* P = (const PG8_LAS f32x4*)(xl + (PTAB_OFF - RING_BYTES)) + tid * 2;
        const f32x4 a = P[0], b = P[1];
        f32x2 o; o.x = (a[0] + a[2]) + (b[0] + b[2]); o.y = (a[1] + a[3]) + (b[1] + b[3]);
        *(f32x2*)(st + ((size_t)(u.pm * BM + tid) * 8 + u.pn) * 2) = o;
    }
}
struct LaneId { int wr, wc, fr, fq; };
__device__ __forceinline__ LaneId lane_id(int wid0) { const int t = opaque_tid(wid0); const int wid = wid0, lane = t & 63; LaneId L; L.wr = wid >> 2; L.wc = wid & 3; L.fr = lane & 15; L.fq = lane >> 4; return L; }
#define PG8_ROWSUM(s, q, v) do { s += ((v)[0] + (v)[1]) + ((v)[2] + (v)[3]); q += ((v)[0] * (v)[0] + (v)[1] * (v)[1]) + ((v)[2] * (v)[2] + (v)[3] * (v)[3]); } while (0)

template <int ACT> struct EpiPlain {
    static constexpr bool PERM = true, AFTER_DRAIN = false;
    bf16_t* O; int ldc; int wid0;
    __device__ __forceinline__ void operator()(const f32x4 (&acc)[2][2][4][2], const Unit& u, int, int, int, int) const {
        const LaneId L_ = lane_id(wid0); const int wr = L_.wr, wc = L_.wc, fr = L_.fr, fq = L_.fq;
        const int row0 = u.pm * BM + wr * 64 + fr, col0 = u.pn * BM + wc * 32 + 8 * fq;
#pragma unroll
        for (int ai = 0; ai < 2; ++ai)
#pragma unroll
            for (int m = 0; m < 4; ++m) { bf16_t* rowp = O + (size_t)(row0 + ai * HALF + m * 16) * ldc + col0;
#pragma unroll
                for (int bj = 0; bj < 2; ++bj) { f32x4 v0 = acc[ai][bj][m][0], v1 = acc[ai][bj][m][1];
                    if (ACT == 1) { f32x2 a = gelu_pk((f32x2){v0[0], v0[1]}), b = gelu_pk((f32x2){v0[2], v0[3]}), c = gelu_pk((f32x2){v1[0], v1[1]}), d = gelu_pk((f32x2){v1[2], v1[3]});
                        v0 = (f32x4){a.x, a.y, b.x, b.y}; v1 = (f32x4){c.x, c.y, d.x, d.y}; }
                    u32x4 w; w.x = cvt_pk16(v0[0], v0[1]); w.y = cvt_pk16(v0[2], v0[3]); w.z = cvt_pk16(v1[0], v1[1]); w.w = cvt_pk16(v1[2], v1[3]);
                    *(u32x4*)(rowp + bj * HALF) = w; } }
    }
};
struct EpiQKV {
    static constexpr bool PERM = true, AFTER_DRAIN = false;
    bf16_t* O; const float* rot; int seq_mask; float qscale; int wid0;
    __device__ __forceinline__ void operator()(const f32x4 (&acc)[2][2][4][2], const Unit& u, int, int, int, int) const {
        const LaneId L_ = lane_id(wid0); const int wr = L_.wr, wc = L_.wc, fr = L_.fr, fq = L_.fq;
        const int colt = u.pn * BM, tsel = (colt % 3072) / 1024;
        const float sc = tsel == 0 ? qscale : 1.0f;
        const bool dorot = (tsel < 2) && (wc == 0);
        const int row0 = u.pm * BM + wr * 64 + fr, col0 = colt + wc * 32 + 8 * fq;
        const float sgn = fq < 2 ? -1.0f : 1.0f;
#pragma unroll
        for (int ai = 0; ai < 2; ++ai)
#pragma unroll
            for (int m = 0; m < 4; ++m) {
                const int row = row0 + ai * HALF + m * 16;
                f32x4 cs[2], sn[2];
                if (dorot) { const float* rp = rot + (size_t)(row & seq_mask) * 32 + 8 * (fq & 1);
                    cs[0] = *(const f32x4*)(rp); cs[1] = *(const f32x4*)(rp + 4); sn[0] = *(const f32x4*)(rp + 16); sn[1] = *(const f32x4*)(rp + 20); }
#pragma unroll
                for (int bj = 0; bj < 2; ++bj) {
                    f32x4 v[2] = {acc[ai][bj][m][0], acc[ai][bj][m][1]};
                    if (dorot) {
#pragma unroll
                        for (int n = 0; n < 2; ++n) { f32x4 pr;
#pragma unroll
                            for (int j = 0; j < 4; ++j) pr[j] = shx(v[n][j], 32, fr + 16 * fq);
                            v[n] = v[n] * cs[n] + (pr * sn[n]) * sgn; }
                    }
                    v[0] = v[0] * sc; v[1] = v[1] * sc;
                    u32x4 w; w.x = cvt_pk16(v[0][0], v[0][1]); w.y = cvt_pk16(v[0][2], v[0][3]); w.z = cvt_pk16(v[1][0], v[1][1]); w.w = cvt_pk16(v[1][2], v[1][3]);
                    *(u32x4*)(O + (size_t)row * NQKV + col0 + bj * HALF) = w;
                }
            }
    }
};
#define PG8_UNPACK8(W_, v0, v1) do { v0[0] = bf_lo((W_)[0]); v0[1] = bf_hi((W_)[0]); v0[2] = bf_lo((W_)[1]); v0[3] = bf_hi((W_)[1]); v1[0] = bf_lo((W_)[2]); v1[1] = bf_hi((W_)[2]); v1[2] = bf_lo((W_)[3]); v1[3] = bf_hi((W_)[3]); } while (0)
#define PG8_PACK8(W_, v0, v1) do { (W_)[0] = cvt_pk16(v0[0], v0[1]); (W_)[1] = cvt_pk16(v0[2], v0[3]); (W_)[2] = cvt_pk16(v1[0], v1[1]); (W_)[3] = cvt_pk16(v1[2], v1[3]); } while (0)
struct EpiY1 {
    static constexpr bool PERM = true, AFTER_DRAIN = false;
    const float* xin32; const bf16_t* xin16; bf16_t* yb; float* st; PG8_LAS unsigned char* xl; float alpha; int wid0;
    __device__ __forceinline__ void operator()(const f32x4 (&acc)[2][2][4][2], const Unit& u, int, int, int, int) const {
        const LaneId L_ = lane_id(wid0); const int wr = L_.wr, wc = L_.wc, fr = L_.fr, fq = L_.fq;
        const int row0 = u.pm * BM + wr * 64 + fr, col0 = u.pn * BM + wc * 32 + 8 * fq, ln_ = fr + 16 * fq;
        PG8_LAS f32x2* P = (PG8_LAS f32x2*)(xl + (PTAB_OFF - RING_BYTES));
#pragma unroll
        for (int ai = 0; ai < 2; ++ai) {
            float s[4] = {0.f, 0.f, 0.f, 0.f}, q[4] = {0.f, 0.f, 0.f, 0.f};
#pragma unroll
            for (int bj = 0; bj < 2; ++bj) {
                if (xin32) {
                    f32x4 x[4][2];
#pragma unroll
                    for (int m = 0; m < 4; ++m) { const size_t off = (size_t)(row0 + ai * HALF + m * 16) * D + col0 + bj * HALF; x[m][0] = *(const f32x4*)(xin32 + off); x[m][1] = *(const f32x4*)(xin32 + off + 4); }
#pragma unroll
                    for (int m = 0; m < 4; ++m) { const size_t off = (size_t)(row0 + ai * HALF + m * 16) * D + col0 + bj * HALF;
                        const f32x4 y0 = x[m][0] * alpha + acc[ai][bj][m][0], y1 = x[m][1] * alpha + acc[ai][bj][m][1];
                        u32x4 w; PG8_PACK8(w, y0, y1); *(u32x4*)(yb + off) = w;
                        PG8_ROWSUM(s[m], q[m], y0); PG8_ROWSUM(s[m], q[m], y1); }
                } else {
                    u32x4 xw[4];
#pragma unroll
                    for (int m = 0; m < 4; ++m) xw[m] = *(const u32x4*)(xin16 + (size_t)(row0 + ai * HALF + m * 16) * D + col0 + bj * HALF);
#pragma unroll
                    for (int m = 0; m < 4; ++m) { const size_t off = (size_t)(row0 + ai * HALF + m * 16) * D + col0 + bj * HALF;
                        f32x4 x0, x1; PG8_UNPACK8(xw[m], x0, x1);
                        const f32x4 y0 = x0 * alpha + acc[ai][bj][m][0], y1 = x1 * alpha + acc[ai][bj][m][1];
                        u32x4 w; PG8_PACK8(w, y0, y1); *(u32x4*)(yb + off) = w;
                        PG8_ROWSUM(s[m], q[m], y0); PG8_ROWSUM(s[m], q[m], y1); }
                }
                asm volatile("" ::: "memory");
            }
#pragma unroll
            for (int m = 0; m < 4; ++m) { float ss = s[m], qq = q[m]; ss += shx(ss, 16, ln_); qq += shx(qq, 16, ln_); ss += shx(ss, 32, ln_); qq += shx(qq, 32, ln_);
                if (fq == 0) P[(ai * HALF + wr * 64 + m * 16 + fr) * 4 + wc] = (f32x2){ss, qq}; }
        }
        partials_to_st(st, u, xl, wid0);
    }
};
struct EpiGU {
    static constexpr bool PERM = true, AFTER_DRAIN = false;
    const float* st; const float* cs; const float* bw; bf16_t* H; PG8_LAS unsigned char* xl; float eps; int wid0; mutable int last_pm = -1;
    __device__ __forceinline__ void operator()(const f32x4 (&acc)[2][2][4][2], const Unit& u, int, int, int, int) const {
        const LaneId L_ = lane_id(wid0); const int wr = L_.wr, wc = L_.wc, fr = L_.fr, fq = L_.fq;
        if (u.pm != last_pm) { stab_from_partials(st, u.pm, xl, eps, wid0); last_pm = u.pm; }
        const PG8_LAS f32x2* S = (const PG8_LAS f32x2*)(xl + (STAB_OFF - RING_BYTES));
        const int row0 = u.pm * BM + wr * 64 + fr, col0 = u.pn * BM + wc * 32 + 8 * fq, hcol0 = u.pn * HALF + wc * 32 + 8 * fq;
        f32x4 csv[2][2], bwv[2][2];
#pragma unroll
        for (int bj = 0; bj < 2; ++bj)
#pragma unroll
            for (int n = 0; n < 2; ++n) { csv[bj][n] = *(const f32x4*)(cs + col0 + bj * HALF + 4 * n); bwv[bj][n] = *(const f32x4*)(bw + col0 + bj * HALF + 4 * n); }
#pragma unroll
        for (int ai = 0; ai < 2; ++ai)
#pragma unroll
            for (int m = 0; m < 4; ++m) {
                const int rl = ai * HALF + wr * 64 + m * 16 + fr; const f32x2 sr = S[rl];
                f32x4 h[2];
#pragma unroll
                for (int n = 0; n < 2; ++n) {
                    const f32x4 g = (acc[ai][0][m][n] - csv[0][n] * sr.x) * sr.y + bwv[0][n];
                    const f32x4 uu = (acc[ai][1][m][n] - csv[1][n] * sr.x) * sr.y + bwv[1][n];
#pragma unroll
                    for (int j = 0; j < 4; ++j) h[n][j] = g[j] * __builtin_amdgcn_rcpf(1.0f + __builtin_amdgcn_exp2f(-1.4426950408889634f * g[j])) * uu[j];
                }
                u32x4 w; w.x = cvt_pk16(h[0][0], h[0][1]); w.y = cvt_pk16(h[0][2], h[0][3]); w.z = cvt_pk16(h[1][0], h[1][1]); w.w = cvt_pk16(h[1][2], h[1][3]);
                *(u32x4*)(H + (size_t)(row0 + ai * HALF + m * 16) * FF + hcol0) = w;
            }
    }
};
struct EpiY2 {
    static constexpr bool PERM = true, AFTER_DRAIN = false;
    const bf16_t* y1b; bf16_t* yb; const float* st1; float* st2; const float* lng; const float* lnb; PG8_LAS unsigned char* xl; float alpha, eps; int wid0; mutable int last_pm = -1;
    __device__ __forceinline__ void operator()(const f32x4 (&acc)[2][2][4][2], const Unit& u, int, int, int, int) const {
        const LaneId L_ = lane_id(wid0); const int wr = L_.wr, wc = L_.wc, fr = L_.fr, fq = L_.fq;
        const int row0 = u.pm * BM + wr * 64 + fr, col0 = u.pn * BM + wc * 32 + 8 * fq, ln_ = fr + 16 * fq;
        u32x4 aw[2][4];
#define PG8_Y2_LOAD(buf, k) do { _Pragma("unroll") for (int m = 0; m < 4; ++m) aw[buf][m] = *(const u32x4*)(y1b + (size_t)(row0 + ((k) >> 1) * HALF + m * 16) * D + col0 + ((k) & 1) * HALF); } while (0)
        PG8_Y2_LOAD(0, 0); PG8_Y2_LOAD(1, 1);
        if (u.pm != last_pm) { stab_from_partials(st1, u.pm, xl, eps, wid0); last_pm = u.pm; }
        const PG8_LAS f32x2* S = (const PG8_LAS f32x2*)(xl + (STAB_OFF - RING_BYTES));
        PG8_LAS f32x2* P = (PG8_LAS f32x2*)(xl + (PTAB_OFF - RING_BYTES));
        f32x4 gv[2][2], bv[2][2];
#pragma unroll
        for (int bj = 0; bj < 2; ++bj)
#pragma unroll
            for (int n = 0; n < 2; ++n) { gv[bj][n] = *(const f32x4*)(lng + col0 + bj * HALF + 4 * n); bv[bj][n] = *(const f32x4*)(lnb + col0 + bj * HALF + 4 * n); }
#pragma unroll
        for (int ai = 0; ai < 2; ++ai) {
            float s[4] = {0.f, 0.f, 0.f, 0.f}, q[4] = {0.f, 0.f, 0.f, 0.f}; f32x2 sr[4];
#pragma unroll
            for (int m = 0; m < 4; ++m) sr[m] = S[ai * HALF + wr * 64 + m * 16 + fr];
#pragma unroll
            for (int bj = 0; bj < 2; ++bj) {
                const int k = ai * 2 + bj, buf = k & 1;
#pragma unroll
                for (int m = 0; m < 4; ++m) { const size_t off = (size_t)(row0 + ai * HALF + m * 16) * D + col0 + bj * HALF;
                    f32x4 a0, a1; PG8_UNPACK8(aw[buf][m], a0, a1);
                    const f32x4 x0 = ((a0 - sr[m].x) * sr[m].y) * gv[bj][0] + bv[bj][0], x1 = ((a1 - sr[m].x) * sr[m].y) * gv[bj][1] + bv[bj][1];
                    const f32x4 y0 = x0 * alpha + acc[ai][bj][m][0], y1 = x1 * alpha + acc[ai][bj][m][1];
                    u32x4 w; PG8_PACK8(w, y0, y1); *(u32x4*)(yb + off) = w;
                    PG8_ROWSUM(s[m], q[m], y0); PG8_ROWSUM(s[m], q[m], y1); }
                if (k < 2) PG8_Y2_LOAD(buf, k + 2);
            }
#pragma unroll
            for (int m = 0; m < 4; ++m) { float ss = s[m], qq = q[m]; ss += shx(ss, 16, ln_); qq += shx(qq, 16, ln_); ss += shx(ss, 32, ln_); qq += shx(qq, 32, ln_);
                if (fq == 0) P[(ai * HALF + wr * 64 + m * 16 + fr) * 4 + wc] = (f32x2){ss, qq}; }
        }
#undef PG8_Y2_LOAD
        partials_to_st(st2, u, xl, wid0);
    }
};
struct EpiPLE {
    static constexpr bool PERM = true, AFTER_DRAIN = false;
    const bf16_t* y2b; float* out32; bf16_t* xb; const bf16_t* pp; const float* st2; const float* lng; const float* lnb; const float* cs; const float* bw; PG8_LAS unsigned char* xl; float eps; int wid0; mutable int last_pm = -1;
    __device__ __forceinline__ void operator()(const f32x4 (&acc)[2][2][4][2], const Unit& u, int, int, int, int) const {
        const LaneId L_ = lane_id(wid0); const int wr = L_.wr, wc = L_.wc, fr = L_.fr, fq = L_.fq;
        const int row0 = u.pm * BM + wr * 64 + fr, col0 = u.pn * BM + wc * 32 + 8 * fq;
        u32x4 aw[4], pw[4];
#pragma unroll
        for (int m = 0; m < 4; ++m) { const size_t off = (size_t)(row0 + m * 16) * D + col0; aw[m] = *(const u32x4*)(y2b + off); pw[m] = *(const u32x4*)(pp + off); }
        if (u.pm != last_pm) { stab_from_partials(st2, u.pm, xl, eps, wid0); last_pm = u.pm; }
        const PG8_LAS f32x2* S = (const PG8_LAS f32x2*)(xl + (STAB_OFF - RING_BYTES));
#pragma unroll
        for (int bj = 0; bj < 2; ++bj) {
            f32x4 gv[2], bv[2], csv[2], bwv[2];
#pragma unroll
            for (int n = 0; n < 2; ++n) { const int c = col0 + bj * HALF + 4 * n; gv[n] = *(const f32x4*)(lng + c); bv[n] = *(const f32x4*)(lnb + c); csv[n] = *(const f32x4*)(cs + c); bwv[n] = *(const f32x4*)(bw + c); }
#pragma unroll
            for (int ai = 0; ai < 2; ++ai) {
                if (bj + ai > 0) {
#pragma unroll
                    for (int m = 0; m < 4; ++m) { const size_t off = (size_t)(row0 + ai * HALF + m * 16) * D + col0 + bj * HALF; aw[m] = *(const u32x4*)(y2b + off); pw[m] = *(const u32x4*)(pp + off); }
                }
#pragma unroll
                for (int m = 0; m < 4; ++m) {
                    const int rl = ai * HALF + wr * 64 + m * 16 + fr; const size_t off = (size_t)(row0 + ai * HALF + m * 16) * D + col0 + bj * HALF; const f32x2 sr = S[rl];
                    f32x4 a0, a1, p0, p1; PG8_UNPACK8(aw[m], a0, a1); PG8_UNPACK8(pw[m], p0, p1);
                    const f32x4 x0 = ((a0 - sr.x) * sr.y) * gv[0] + bv[0], x1 = ((a1 - sr.x) * sr.y) * gv[1] + bv[1];
                    const f32x4 t0 = (acc[ai][bj][m][0] - csv[0] * sr.x) * sr.y + bwv[0], t1 = (acc[ai][bj][m][1] - csv[1] * sr.x) * sr.y + bwv[1];
                    f32x4 o0, o1;
#pragma unroll
                    for (int j = 0; j < 4; ++j) { o0[j] = x0[j] + sigmoidf_(t0[j]) * p0[j]; o1[j] = x1[j] + sigmoidf_(t1[j]) * p1[j]; }
                    if (out32) { *(f32x4*)(out32 + off) = o0; *(f32x4*)(out32 + off + 4) = o1; }
                    else { u32x4 w; PG8_PACK8(w, o0, o1); *(u32x4*)(xb + off) = w; }
                }
                asm volatile("" ::: "memory");
            }
        }
    }
};
}
namespace pg8 {
template <class Epi, class Sched, bool ALIGN_EPI = false, bool SP2 = false>
__device__ __forceinline__ void gemm_phase(PG8_LAS unsigned char* lds, const Gemm g, const Sched& S, const Epi& E) {
    const int tid = opaque_tid(g.wid0), wid = g.wid0, lane = tid & 63, wr = wid >> 2, wc = wid & 3, fr = lane & 15, fq = lane >> 4;
    const int K = g.K, nt = K / BK;
    unsigned voffA[2], voffB[2];
#pragma unroll
    for (int i = 0; i < 2; ++i) { int R, C; stage_rc(tid * 16 + i * 8192, R, C); const int Rb = Epi::PERM ? ((R & ~31) + perm32(R & 31)) : R;
        voffA[i] = (unsigned)(R * K + C) * 2u; voffB[i] = (unsigned)(Rb * K + C) * 2u; }
    const size_t kstep = (size_t)(BK * 2);
    const size_t hstep = (size_t)HALF * K * 2;
    const size_t tstep = 2 * hstep;
    const unsigned ldsw = (unsigned)wid * 1024u;
    const int aoff = lds_byte(wr * 64 + fr, fq * 8), boff = lds_byte(wc * 32 + fr, fq * 8);
#define PG8_SA(b, h) (((b) * 2 + (h)) * HTB)
#define PG8_SB(b, h) ((4 + (b) * 2 + (h)) * HTB)
#define PG8_STAGE(bufoff, gbase, voff) do { _Pragma("unroll") for (int _i = 0; _i < 2; ++_i) \
        __builtin_amdgcn_global_load_lds((const unsigned*)((const char*)(gbase) + (voff)[_i]), (PG8_LAS unsigned*)(lds + (bufoff) + ldsw + _i * 8192), 16, 0, 0); } while (0)
#define PG8_LDA(dst, b, h) do { _Pragma("unroll") for (int m = 0; m < 4; ++m) _Pragma("unroll") for (int k = 0; k < 2; ++k) dst[m][k] = *(const PG8_LAS bf16x8*)(lds + PG8_SA(b, h) + aoff + m * 2048 + k * 1024); } while (0)
#define PG8_LDB(dst, b, h) do { _Pragma("unroll") for (int n = 0; n < 2; ++n) _Pragma("unroll") for (int k = 0; k < 2; ++k) dst[n][k] = *(const PG8_LAS bf16x8*)(lds + PG8_SB(b, h) + boff + n * 2048 + k * 1024); } while (0)
#define PG8_MMA(ai, bj, At, Bt) do { __builtin_amdgcn_s_setprio(1); _Pragma("unroll") for (int m = 0; m < 4; ++m) _Pragma("unroll") for (int n = 0; n < 2; ++n) _Pragma("unroll") for (int k = 0; k < 2; ++k) \
        acc[ai][bj][m][n] = PG8_MFMA16(Bt[n][k], At[m][k], acc[ai][bj][m][n]); __builtin_amdgcn_s_setprio(0); } while (0)
#define PG8_WAIT_V(n) asm volatile("s_waitcnt vmcnt(" #n ")" ::: "memory")
#define PG8_WAIT_L(n) asm volatile("s_waitcnt lgkmcnt(" #n ")" ::: "memory")
#define PG8_BAR __builtin_amdgcn_s_barrier()
#define PG8_SCHED __builtin_amdgcn_sched_barrier(0)
    Unit cur, nxt; int ui = 0;
    float z0_ = 0.f; asm volatile("" : "+v"(z0_));
    if (!S.next(0, cur)) return;
    f32x4 acc[2][2][4][2];
#pragma unroll
    for (int a = 0; a < 2; ++a)
#pragma unroll
        for (int b = 0; b < 2; ++b)
#pragma unroll
            for (int m = 0; m < 4; ++m)
#pragma unroll
                for (int n = 0; n < 2; ++n) acc[a][b][m][n] = (f32x4){z0_, z0_, z0_, z0_};
    bf16x8 At[4][2], B0[2][2], B1[2][2];
    const char* cA = (const char*)g.A + (size_t)cur.pm * tstep; const char* cB = (const char*)g.Bt + (size_t)cur.pn * tstep;
    S.a_ready(cur);
    if constexpr (SP2) {
        PG8_STAGE(PG8_SB(0, 0), cB, voffB); PG8_STAGE(PG8_SB(0, 1), cB + hstep, voffB); PG8_STAGE(PG8_SA(0, 0), cA, voffA); PG8_STAGE(PG8_SA(0, 1), cA + hstep, voffA);
        if (wr == 1) PG8_BAR;
        PG8_WAIT_V(2); PG8_BAR;
        PG8_STAGE(PG8_SB(1, 0), cB + kstep, voffB); PG8_STAGE(PG8_SA(1, 0), cA + kstep, voffA); PG8_STAGE(PG8_SB(1, 1), cB + hstep + kstep, voffB);
        PG8_WAIT_V(6); PG8_BAR;
    } else {
        PG8_STAGE(PG8_SB(0, 0), cB, voffB); PG8_STAGE(PG8_SA(0, 0), cA, voffA); PG8_STAGE(PG8_SB(0, 1), cB + hstep, voffB); PG8_STAGE(PG8_SA(0, 1), cA + hstep, voffA);
        if (wr == 1) PG8_BAR;
        PG8_WAIT_V(4); PG8_BAR;
        PG8_STAGE(PG8_SB(1, 0), cB + kstep, voffB); PG8_STAGE(PG8_SA(1, 0), cA + kstep, voffA); PG8_STAGE(PG8_SB(1, 1), cB + hstep + kstep, voffB);
        PG8_WAIT_V(6); PG8_BAR;
    }
    for (;;) {
        const bool has_next = S.next(ui + 1, nxt);
        const char* nA = has_next ? (const char*)g.A + (size_t)nxt.pm * tstep : cA; const char* nB = has_next ? (const char*)g.Bt + (size_t)nxt.pn * tstep : cB;
        for (int t = 0; t < nt; t += 2) {
            const bool last = (t == nt - 2);
            const char* a1 = cA + (size_t)(t + 1) * kstep;
            const char* a2 = last ? nA : cA + (size_t)(t + 2) * kstep; const char* b2 = last ? nB : cB + (size_t)(t + 2) * kstep;
            const char* a3 = a2 + kstep; const char* b3 = b2 + kstep;
            if (last && has_next) S.a_ready(nxt);
            if constexpr (SP2) {
            PG8_LDB(B0, 0, 0); PG8_LDB(B1, 0, 1); PG8_SCHED; PG8_LDA(At, 0, 0); PG8_STAGE(PG8_SA(1, 1), a1 + hstep, voffA);
            PG8_WAIT_V(8); PG8_WAIT_L(0); PG8_BAR; PG8_MMA(0, 0, At, B0); PG8_MMA(0, 1, At, B1); PG8_BAR; PG8_SCHED;
            PG8_LDA(At, 0, 1); PG8_STAGE(PG8_SB(0, 0), b2, voffB); PG8_STAGE(PG8_SB(0, 1), b2 + hstep, voffB); PG8_STAGE(PG8_SA(0, 0), a2, voffA);
            PG8_WAIT_V(8); PG8_WAIT_L(0); PG8_BAR; PG8_MMA(1, 0, At, B0); PG8_MMA(1, 1, At, B1); PG8_BAR; PG8_SCHED;
            PG8_LDB(B0, 1, 0); PG8_LDB(B1, 1, 1); PG8_SCHED; PG8_LDA(At, 1, 0); PG8_STAGE(PG8_SA(0, 1), a2 + hstep, voffA);
            PG8_WAIT_V(8); PG8_WAIT_L(0); PG8_BAR; PG8_MMA(0, 0, At, B0); PG8_MMA(0, 1, At, B1); PG8_BAR; PG8_SCHED;
            PG8_LDA(At, 1, 1); PG8_STAGE(PG8_SB(1, 0), b3, voffB); PG8_STAGE(PG8_SB(1, 1), b3 + hstep, voffB); PG8_STAGE(PG8_SA(1, 0), a3, voffA);
            PG8_WAIT_V(8); PG8_WAIT_L(0); PG8_BAR; PG8_MMA(1, 0, At, B0); PG8_MMA(1, 1, At, B1); PG8_BAR; PG8_SCHED;
            } else {
            PG8_LDB(B0, 0, 0); PG8_SCHED; PG8_LDA(At, 0, 0); PG8_STAGE(PG8_SA(1, 1), a1 + hstep, voffA);
            PG8_WAIT_L(8); PG8_BAR; PG8_WAIT_L(0); PG8_MMA(0, 0, At, B0); PG8_BAR; PG8_SCHED;
            PG8_LDB(B1, 0, 1); PG8_STAGE(PG8_SB(0, 0), b2, voffB);
            PG8_BAR; PG8_WAIT_L(0); PG8_MMA(0, 1, At, B1); PG8_BAR;
            PG8_LDA(At, 0, 1); PG8_STAGE(PG8_SA(0, 0), a2, voffA);
            PG8_BAR; PG8_WAIT_L(0); PG8_MMA(1, 0, At, B0); PG8_BAR; PG8_SCHED;
            PG8_STAGE(PG8_SB(0, 1), b2 + hstep, voffB);
            PG8_WAIT_V(6); PG8_BAR; PG8_MMA(1, 1, At, B1); PG8_BAR;
            PG8_LDB(B0, 1, 0); PG8_SCHED; PG8_LDA(At, 1, 0); PG8_STAGE(PG8_SA(0, 1), a2 + hstep, voffA);
            PG8_WAIT_L(8); PG8_BAR; PG8_WAIT_L(0); PG8_MMA(0, 0, At, B0); PG8_BAR; PG8_SCHED;
            PG8_LDB(B1, 1, 1); PG8_STAGE(PG8_SB(1, 0), b3, voffB);
            PG8_BAR; PG8_WAIT_L(0); PG8_MMA(0, 1, At, B1); PG8_BAR;
            PG8_LDA(At, 1, 1); PG8_STAGE(PG8_SA(1, 0), a3, voffA);
            PG8_BAR; PG8_WAIT_L(0); PG8_MMA(1, 0, At, B0); PG8_BAR; PG8_SCHED;
            PG8_STAGE(PG8_SB(1, 1), b3 + hstep, voffB);
            PG8_WAIT_V(6); PG8_BAR; PG8_MMA(1, 1, At, B1); PG8_BAR;
            }
        }
        if constexpr (ALIGN_EPI) { if (wr == 0) PG8_BAR; }
        if constexpr (!Epi::AFTER_DRAIN) { E(acc, cur, wr, wc, fr, fq); S.done(cur); }
        if (!has_next) break;
#pragma unroll
        for (int a = 0; a < 2; ++a)
#pragma unroll
            for (int b = 0; b < 2; ++b)
#pragma unroll
                for (int m = 0; m < 4; ++m)
#pragma unroll
                    for (int n = 0; n < 2; ++n) acc[a][b][m][n] = (f32x4){z0_, z0_, z0_, z0_};
        cur = nxt; cA = nA; cB = nB; ++ui;
        if constexpr (ALIGN_EPI) { if (wr == 1) PG8_BAR; }
    }
    PG8_WAIT_V(0);
    if constexpr (!ALIGN_EPI) { if (wr == 0) PG8_BAR; }
    PG8_BAR;
    if constexpr (Epi::AFTER_DRAIN) { E.fused(acc, cur, wr, wc, fr, fq, lds, wid, lane); S.done(cur); }
#undef PG8_SA
#undef PG8_SB
#undef PG8_STAGE
#undef PG8_LDA
#undef PG8_LDB
#undef PG8_MMA
#undef PG8_WAIT_V
#undef PG8_WAIT_L
#undef PG8_BAR
#undef PG8_SCHED
}
}
#define XB_TMO      128
#define XB_XCNT(j)  (256  + 64 * (j))
#define XB_XSUB(j)  (1280 + 64 * (j))
#define XB_XGEN(j)  (2304 + 64 * (j))
#define XB_TOP      3328
#define XB_TOPGEN   3392
#define XCD_BAR_WORDS 3456
#define XB_SPIN_CAP (1u << 18)

__device__ __forceinline__ unsigned xb_ld(unsigned* p)              { return __hip_atomic_load(p, __ATOMIC_RELAXED, __HIP_MEMORY_SCOPE_AGENT); }
__device__ __forceinline__ unsigned xb_add(unsigned* p, unsigned v) { return __hip_atomic_fetch_add(p, v, __ATOMIC_RELAXED, __HIP_MEMORY_SCOPE_AGENT); }
__device__ __forceinline__ unsigned xb_xcc_id() { return (unsigned)__builtin_amdgcn_s_getreg((3 << 11) | 20) & 0xFu; }
#define XB_SPIN(cond, bar) do { unsigned _sp = 0; while (cond) { __builtin_amdgcn_s_sleep(1); \
    if ((++_sp & 255u) == 0u) { if (xb_ld(&(bar)[XB_TMO])) break; if (_sp > XB_SPIN_CAP) { atomicAdd(&(bar)[XB_TMO], 1u); break; } } } } while (0)

struct XcdBarrier {
    int wid0;
    unsigned* bar; unsigned x;
    volatile LAS unsigned* st;
};

__device__ __forceinline__ XcdBarrier xcd_barrier_post(unsigned* bar, volatile LAS unsigned* st) {
    XcdBarrier b; b.bar = bar; b.x = xb_xcc_id(); b.st = st;
    if (threadIdx.x == 0) (void)xb_add(&bar[XB_XCNT(b.x)], 1u);
    return b;
}
__device__ __forceinline__ void xcd_barrier_complete(unsigned* bar, unsigned x, unsigned& nloc, unsigned& nx) {
    const unsigned G = gridDim.x * gridDim.y * gridDim.z;
    unsigned sum, cnt, mine, sp = 0u;
    for (;;) {
        sum = 0u; cnt = 0u; mine = 0u;
#pragma unroll
        for (unsigned j = 0; j < 16; ++j) { const unsigned c = xb_ld(&bar[XB_XCNT(j)]); sum += c; cnt += (c > 0u) ? 1u : 0u; mine = (j == x) ? c : mine; }
        if (sum == G) break;
        __builtin_amdgcn_s_sleep(1);
        if ((++sp & 255u) == 0u) { if (xb_ld(&bar[XB_TMO])) break; if (sp > XB_SPIN_CAP) { atomicAdd(&bar[XB_TMO], 1u); break; } }
    }
    nloc = mine > 0u ? mine : 1u; nx = cnt > 0u ? cnt : 1u;
}

__device__ __forceinline__ void xcd_barrier(const XcdBarrier& b) {
    asm volatile("s_waitcnt vmcnt(0)" ::: "memory");
    __syncthreads();
    if (opaque_tid(b.wid0) == 0) {
        unsigned* bar = b.bar;
        __builtin_amdgcn_s_waitcnt(0);
        unsigned nloc = b.st[0], nx = b.st[1];
        if (nloc == 0u) { xcd_barrier_complete(bar, b.x, nloc, nx); b.st[0] = nloc; b.st[1] = nx; }
        const unsigned old = xb_add(&bar[XB_XSUB(b.x)], 1u);
        const unsigned gen = old / nloc;
        if (old + 1u == (gen + 1u) * nloc) {
            __builtin_amdgcn_fence(__ATOMIC_RELEASE, "agent");
            asm volatile("s_waitcnt vmcnt(0)" ::: "memory");
            const unsigned og = xb_add(&bar[XB_TOP], 1u);
            const unsigned tg = og / nx;
            if (og + 1u == (tg + 1u) * nx) xb_add(&bar[XB_TOPGEN], 1u);
            else XB_SPIN(xb_ld(&bar[XB_TOPGEN]) == tg, bar);
            __builtin_amdgcn_fence(__ATOMIC_ACQUIRE, "agent");
            xb_add(&bar[XB_XGEN(b.x)], 1u);
            asm volatile("s_waitcnt vmcnt(0)" ::: "memory");
        } else {
            XB_SPIN(xb_ld(&bar[XB_XGEN(b.x)]) == gen, bar);
            __builtin_amdgcn_fence(__ATOMIC_ACQUIRE, "agent");
            asm volatile("s_waitcnt vmcnt(0)" ::: "memory");
        }
    }
    __syncthreads();
}

__device__ const float kInvFreq[16] = {1.000000000e+00f, 4.403665960e-01f, 1.939227432e-01f, 8.539710194e-02f, 3.760603070e-02f, 1.656044088e-02f, 7.292664610e-03f, 3.211446106e-03f,
                                       1.414213562e-03f, 6.227724371e-04f, 2.742481884e-04f, 1.207697351e-04f, 5.318295734e-05f, 2.341999971e-05f, 1.031338525e-05f, 4.541670478e-06f};

__device__ __forceinline__ void sincos_f64(float angf, float& so, float& co) {
    const double a = (double)angf;
    const double k = __builtin_rint(a * 0.63661977236758134308);
    const double r = __builtin_fma(-k, 6.123233995736766e-17, __builtin_fma(-k, 1.5707963267948966, a));
    const double r2 = r * r;
    double s = -7.6471637318198164759e-13; s = s * r2 + 1.6059043836821614599e-10; s = s * r2 - 2.5052108385441718775e-8; s = s * r2 + 2.7557319223985890653e-6;
    s = s * r2 - 1.9841269841269841270e-4; s = s * r2 + 8.3333333333333333333e-3; s = s * r2 - 1.6666666666666666667e-1; s = s * r2 * r + r;
    double c = 4.7794773323873852974e-14; c = c * r2 - 1.1470745597729724714e-11; c = c * r2 + 2.0876756987868098979e-9; c = c * r2 - 2.7557319223985890653e-7;
    c = c * r2 + 2.4801587301587301587e-5; c = c * r2 - 1.3888888888888888889e-3; c = c * r2 + 4.1666666666666666667e-2; c = c * r2 - 0.5; c = c * r2 + 1.0;
    const int q = (int)((long long)k & 3);
    const double sv = (q == 0) ? s : (q == 1) ? c : (q == 2) ? -s : -c;
    const double cv = (q == 0) ? c : (q == 1) ? -s : (q == 2) ? -c : s;
    so = (float)sv; co = (float)cv;
}

struct TJob { const float* W; int K, N; bf16* WT; int mode; const float* g; const float* b; float* pcs; float* pbw; };
__device__ __forceinline__ void tr_item(const TJob& J, LAS float* scr, int item, int lane) {
    const int nblk = J.N / 32, kb = item / nblk, nb = item - kb * nblk, k0 = 64 * kb, n0 = 32 * nb;
#pragma unroll 8
    for (int i = 0; i < 32; ++i) { const int kk = 2 * i + (lane >> 5); scr[kk * 33 + (lane & 31)] = J.W[(size_t)(k0 + kk) * J.N + n0 + (lane & 31)]; }
    LDS_WAIT(); asm volatile("" ::: "memory");
    int drow0 = n0;
    if (J.mode == 2) { const int isup = n0 >= FF ? 1 : 0, hc = n0 - isup * FF; drow0 = 256 * (hc >> 7) + 128 * isup + (hc & 127); }
    const int c = lane & 7;
    float gk[8];
#pragma unroll
    for (int j = 0; j < 8; ++j) gk[j] = J.mode ? J.g[k0 + 8 * c + j] : 1.0f;
#pragma unroll
    for (int j = 0; j < 4; ++j) { const int n = (lane >> 3) + 8 * j; const LAS float* s = scr + (8 * c) * 33 + n;
        v4u o; o.x = pk2(s[0 * 33] * gk[0], s[1 * 33] * gk[1]); o.y = pk2(s[2 * 33] * gk[2], s[3 * 33] * gk[3]); o.z = pk2(s[4 * 33] * gk[4], s[5 * 33] * gk[5]); o.w = pk2(s[6 * 33] * gk[6], s[7 * 33] * gk[7]);
        *(GAS v4u*)(J.WT + (size_t)(drow0 + n) * J.K + k0 + 8 * c) = o; }
    if (J.mode) {
        float cs = 0.f, bw = 0.f; const int kh = (lane >> 5) * 32;
#pragma unroll 8
        for (int t = 0; t < 32; ++t) { const int kk = kh + t; const float w = scr[kk * 33 + (lane & 31)]; cs += bf_round(w * J.g[k0 + kk]); bw += w * J.b[k0 + kk]; }
        cs += shx(cs, 32, lane); bw += shx(bw, 32, lane);
        if (lane < 32) { J.pcs[(size_t)kb * J.N + drow0 + lane] = cs; J.pbw[(size_t)kb * J.N + drow0 + lane] = bw; }
    }
    LDS_WAIT(); asm volatile("" ::: "memory");
}

struct Args { const float* in[20]; float* out; unsigned char* ws; int ph_lo, ph_hi; };
#define CAS __attribute__((address_space(4)))
__device__ __forceinline__ const unsigned char CAS* kargs_() { const unsigned char CAS* p = (const unsigned char CAS*)__builtin_amdgcn_kernarg_segment_ptr(); asm volatile("" : "+s"(p)); return p; }
__device__ __forceinline__ const float* arg_in(int i) { return (const float*)(const GAS float*)*(const float* const CAS*)(kargs_() + 8 * i); }
__device__ __forceinline__ float* arg_out() { return (float*)(GAS float*)*(float* const CAS*)(kargs_() + 160); }
__device__ __forceinline__ unsigned char* arg_ws() { return (unsigned char*)(GAS unsigned char*)*(unsigned char* const CAS*)(kargs_() + 168); }
static_assert(sizeof(Args) == 184, "Args layout");

__device__ __forceinline__ TJob make_job(int id) {
    unsigned char* ws = arg_ws(); float* part = (float*)(ws + WS_PART);
    TJob J; J.mode = 0; J.g = nullptr; J.b = nullptr; J.pcs = nullptr; J.pbw = nullptr;
    switch (id) {
    case 0: J.W = arg_in(4); J.K = D; J.N = HW; J.WT = (bf16*)(ws + WS_W_IN); break;
    case 1: J.W = arg_in(9); J.K = D; J.N = D; J.WT = (bf16*)(ws + WS_W_OA); break;
    case 2: J.W = arg_in(10); J.K = D; J.N = NQKV; J.WT = (bf16*)(ws + WS_W_QKV); break;
    case 3: J.W = arg_in(11); J.K = AW; J.N = D; J.WT = (bf16*)(ws + WS_W_OB); break;
    case 4: case 5: { const int l = id - 4; J.W = arg_in(14) + (size_t)l * D * NGU; J.K = D; J.N = NGU; J.WT = (bf16*)(ws + WS_W_GU + l * W_GU_STRIDE); J.mode = 2;
        J.g = arg_in(12) + l * D; J.b = arg_in(13) + l * D; J.pcs = part + PART_GU + l * PART_GU_L; J.pbw = J.pcs + (size_t)KB32 * NGU; break; }
    case 6: case 7: { const int l = id - 6; J.W = arg_in(15) + (size_t)l * FF * D; J.K = FF; J.N = D; J.WT = (bf16*)(ws + WS_W_DN + l * W_DN_STRIDE); break; }
    case 8: case 9: { const int l = id - 8; J.W = arg_in(18) + (size_t)l * D * D; J.K = D; J.N = D; J.WT = (bf16*)(ws + WS_W_GT + l * W_GT_STRIDE); J.mode = 1;
        J.g = arg_in(16) + l * D; J.b = arg_in(17) + l * D; J.pcs = part + PART_GT + l * PART_GT_L; J.pbw = J.pcs + (size_t)KB32 * D; break; }
    default: { const int l = id - 10; J.W = arg_in(19) + (size_t)l * PLE * D; J.K = PLE; J.N = D; J.WT = (bf16*)(ws + WS_W_PJ + l * W_PJ_STRIDE); break; }
    }
    return J;
}
__device__ __forceinline__ int job_items(int id) {
    switch (id) { case 0: return (D / 64) * (HW / 32); case 1: return (D / 64) * (D / 32); case 2: return (D / 64) * (NQKV / 32); case 3: return (AW / 64) * (D / 32);
        case 4: case 5: return (D / 64) * (NGU / 32); case 6: case 7: return (FF / 64) * (D / 32); case 8: case 9: return (D / 64) * (D / 32); default: return (PLE / 64) * (D / 32); }
}

__device__ __forceinline__ void conv_bf16(const float* src, bf16* dst, size_t n8, size_t gt, size_t nthr) {
    for (size_t i = gt; i < n8; i += nthr) {
        const f32x4 a = *(const GAS f32x4*)(src + 8 * i), b = *(const GAS f32x4*)(src + 8 * i + 4);
        v4u o; o.x = pk2(a[0], a[1]); o.y = pk2(a[2], a[3]); o.z = pk2(b[0], b[1]); o.w = pk2(b[2], b[3]);
        *(GAS v4u*)(dst + 8 * i) = o;
    }
}

__device__ __forceinline__ void prologue_phase(LAS unsigned char* lds, int G, int wid0) {
    const int tid = opaque_tid(wid0), lane = tid & 63, wave = tid >> 6;
    LAS float* scr = (LAS float*)(lds + wave * 16384);
    const int gw = blockIdx.x * NWAVES + wave, NGW = G * NWAVES;
#pragma unroll 1
    for (int id = 0; id < 12; ++id) {
        const TJob J = make_job(id); const int ni = job_items(id);
#pragma unroll 1
        for (int it = gw; it < ni; it += NGW) tr_item(J, scr, it, lane);
    }
    const size_t gt = (size_t)blockIdx.x * 512 + tid, nthr = (size_t)G * 512;
    conv_bf16(arg_in(7), (bf16*)(arg_ws() + WS_W_S), (size_t)16 * 128 * 128 / 8, gt, nthr);
    float* rot = (float*)(arg_ws() + WS_ROT);
    for (size_t i = gt; i < (size_t)16384 * 16; i += nthr) { const int pos = (int)(i >> 4), f = (int)(i & 15); float s, c; sincos_f64((float)pos * kInvFreq[f], s, c); rot[pos * 32 + f] = c; rot[pos * 32 + 16 + f] = s; }
}
__device__ __forceinline__ void finalize_vecs(int G, int wid0) {
    const float* part = (const float*)(arg_ws() + WS_PART); float* vec = (float*)(arg_ws() + WS_VEC);
    const int gt = blockIdx.x * 512 + opaque_tid(wid0), nthr = G * 512;
    for (int i = gt; i < 2 * 2 * NGU; i += nthr) {
        const float* p = part + PART_GU + (size_t)(i / NGU) * KB32 * NGU + (i % NGU); float s = 0.f;
        for (int kb = 0; kb < KB32; ++kb) s += p[(size_t)kb * NGU];
        vec[VEC_GU + i] = s;
    }
    for (int i = gt; i < 2 * 2 * D; i += nthr) {
        const float* p = part + PART_GT + (size_t)(i / D) * KB32 * D + (i % D); float s = 0.f;
        for (int kb = 0; kb < KB32; ++kb) s += p[(size_t)kb * D];
        vec[VEC_GT + i] = s;
    }
}

__device__ __forceinline__ void sgu_phase(LAS unsigned char* lds, const bf16* H, bf16* GATED, const bf16* WS, const float* bs, const float* lng, const float* lnb, int G, int wid0) {
    const int tid = opaque_tid(wid0), lane = tid & 63, wave = tid >> 6, i16 = lane & 15, kq = lane >> 4;
    LAS f32x2v* SV = (LAS f32x2v*)(lds + STAB_OFF);
#pragma unroll 1
    for (int chunk = blockIdx.x; chunk < MG / 128; chunk += G) {
        const size_t row0 = (size_t)chunk * 128;
#pragma unroll 1
        for (int rr = 0; rr < 16; ++rr) {
            const int r = wave * 16 + rr; const bf16* vrow = H + (row0 + r) * HW + D;
            v4u d[4]; float x[32]; float s = 0.f;
#pragma unroll
            for (int j = 0; j < 4; ++j) d[j] = *(const GAS v4u*)(vrow + 8 * (lane + 64 * j));
#pragma unroll
            for (int j = 0; j < 4; ++j) { x[8 * j + 0] = bf_lo(d[j].x); x[8 * j + 1] = bf_hi(d[j].x); x[8 * j + 2] = bf_lo(d[j].y); x[8 * j + 3] = bf_hi(d[j].y);
                x[8 * j + 4] = bf_lo(d[j].z); x[8 * j + 5] = bf_hi(d[j].z); x[8 * j + 6] = bf_lo(d[j].w); x[8 * j + 7] = bf_hi(d[j].w); }
#pragma unroll
            for (int j = 0; j < 32; ++j) s += x[j];
            const float mean = wave_sum(s, lane) * (1.0f / D); float s2 = 0.f;
#pragma unroll
            for (int j = 0; j < 32; ++j) { const float t = x[j] - mean; s2 += t * t; }
            const float rstd = 1.0f / sqrtf(wave_sum(s2, lane) * (1.0f / D) + LN_EPS);
            if (lane == 0) SV[r] = (f32x2v){mean, rstd};
        }
        WG_BAR();
        const int p = 16 * wave + i16;
#pragma unroll 1
        for (int g = 0; g < 16; ++g) {
            LAS unsigned char* img = lds + (g & 1) * 32768;
#pragma unroll
            for (int n = 0; n < 4; ++n) {
                const int id = tid + 512 * n, q = id >> 4, ch = id & 15; const int c0 = g * 128 + ch * 8;
                const v4u d = *(const GAS v4u*)(H + (row0 + q) * HW + D + c0);
                const f32x2v sr = SV[q];
                const f32x4 g0 = *(const GAS f32x4*)(lng + c0), g1 = *(const GAS f32x4*)(lng + c0 + 4), b0 = *(const GAS f32x4*)(lnb + c0), b1 = *(const GAS f32x4*)(lnb + c0 + 4);
                f32x4 x0, x1; x0[0] = bf_lo(d.x); x0[1] = bf_hi(d.x); x0[2] = bf_lo(d.y); x0[3] = bf_hi(d.y); x1[0] = bf_lo(d.z); x1[1] = bf_hi(d.z); x1[2] = bf_lo(d.w); x1[3] = bf_hi(d.w);
                x0 = ((x0 - sr.x) * sr.y) * g0 + b0; x1 = ((x1 - sr.x) * sr.y) * g1 + b1;
                v4u o; o.x = pk2(x0[0], x0[1]); o.y = pk2(x0[2], x0[3]); o.z = pk2(x1[0], x1[1]); o.w = pk2(x1[2], x1[3]);
                *(LAS v4u*)(img + off_b(q, ch)) = o;
            }
            bf16x8 wf[4];
#pragma unroll
            for (int s = 0; s < 4; ++s) wf[s] = *(const GAS bf16x8*)(WS + ((size_t)(g * 128 + p)) * 128 + 32 * s + 8 * kq);
            const float bias = bs[g * 128 + p];
            WG_BAR();
            f32x4 acc[8];
#pragma unroll
            for (int ct = 0; ct < 8; ++ct) {
                f32x4 c4 = (f32x4){0.f, 0.f, 0.f, 0.f};
#pragma unroll
                for (int s = 0; s < 4; ++s) {
                    const unsigned qq = (unsigned)(i16 >> 2), pp = (unsigned)(lane & 3);
                    const s16x4 lo = tr_read(img + off_b(32 * s + 8 * kq + qq, 2 * ct + (pp >> 1)) + 8 * (pp & 1));
                    const s16x4 hi = tr_read(img + off_b(32 * s + 8 * kq + 4 + qq, 2 * ct + (pp >> 1)) + 8 * (pp & 1));
                    const bf16x8 af = __builtin_shufflevector(lo, hi, 0, 1, 2, 3, 4, 5, 6, 7);
                    c4 = PG8_MFMA16(af, wf[s], c4);
                }
                acc[ct] = c4;
            }
#pragma unroll
            for (int ct = 0; ct < 8; ++ct) {
                const int c = g * 128 + 16 * ct + 4 * kq;
                const v2u uw = *(const GAS v2u*)(H + (row0 + p) * HW + c);
                const float o0 = (acc[ct][0] + bias) * bf_lo(uw.x), o1 = (acc[ct][1] + bias) * bf_hi(uw.x), o2 = (acc[ct][2] + bias) * bf_lo(uw.y), o3 = (acc[ct][3] + bias) * bf_hi(uw.y);
                v2u ow; ow.x = pk2(o0, o1); ow.y = pk2(o2, o3);
                *(GAS v2u*)(GATED + (row0 + p) * D + c) = ow;
            }
        }
        WG_BAR();
    }
}

struct AttnUnit { int g, h, dil, L, i0; size_t tok0; };
__device__ __forceinline__ AttnUnit attn_decode(int u, int S) {
    AttnUnit A; const int tps = S >> 7;
    A.g = u / (8 * (MG / 128)); const int rem = u - A.g * (8 * (MG / 128)); A.h = rem & 7; const int ts = rem >> 3;
    const int ldil = 2 * A.g; A.dil = 1 << ldil;
    const int b = ts / tps, wslot = ts - b * tps;
    A.L = S >> ldil; const int tpr = A.L >> 7;
    const int r = wslot / tpr, it = wslot - r * tpr; A.i0 = it * 128;
    A.tok0 = (size_t)b * S + r;
    return A;
}
#define ATTN_KV_LOAD(A_) do { const bf16* Kb_ = QKV + (A_).g * 3072 + (A_).h * 128 + 1024; const bf16* Vb_ = Kb_ + 1024; \
    _Pragma("unroll") for (int n = 0; n < 8; ++n) { const int id = tid + 512 * n, kl = id >> 4, ch = id & 15, j = (A_).i0 - 64 + kl; \
        kreg[n] = (v4u){zz_, zz_, zz_, zz_}; vreg[n] = (v4u){zz_, zz_, zz_, zz_}; \
        if (j >= 0 && j < (A_).L) { const size_t off = ((A_).tok0 + (size_t)j * (A_).dil) * NQKV + ch * 8; kreg[n] = *(const GAS v4u*)(Kb_ + off); vreg[n] = *(const GAS v4u*)(Vb_ + off); } } } while (0)
__device__ __forceinline__ void attn_phase(LAS unsigned char* lds, bf16* QKV, float* LSE, int S, int G, bool dry, int wid0) {
    const int tid = opaque_tid(wid0), lane = tid & 63, wave = tid >> 6, iq = lane & 15, kq = lane >> 4;
    LAS unsigned char* Kimg = lds; LAS unsigned char* Vimg = lds + 65536;
    constexpr int NU = 3 * 8 * (MG / 128);
    v4u kreg[8], vreg[8];
    unsigned zz_ = 0u; asm volatile("" : "+v"(zz_));
    int u = blockIdx.x;
    if (u < NU) { const AttnUnit A0 = attn_decode(u, S); ATTN_KV_LOAD(A0); }
#pragma unroll 1
    while (u < NU) {
        const AttnUnit A = attn_decode(u, S);
        const int g = A.g, h = A.h, dil = A.dil, L = A.L, i0 = A.i0; const size_t tok0 = A.tok0;
        bf16* Qb = QKV + g * 3072 + h * 128;
#pragma unroll
        for (int n = 0; n < 8; ++n) { const int id = tid + 512 * n, kl = id >> 4, ch = id & 15; *(LAS v4u*)(Kimg + off_b(kl, ch)) = kreg[n]; *(LAS v4u*)(Vimg + off_b(kl, ch)) = vreg[n]; }
        const int qi = i0 + 16 * wave + iq; const size_t qtok = tok0 + (size_t)qi * dil;
        bf16x8 qf[4];
#pragma unroll
        for (int s = 0; s < 4; ++s) qf[s] = *(const GAS bf16x8*)(Qb + qtok * NQKV + 32 * s + 8 * kq);
        WG_BAR();
        const int un = u + G;
        if (un < NU) { const AttnUnit An = attn_decode(un, S); ATTN_KV_LOAD(An); }
        f32x4 st[9];
#pragma unroll
        for (int T = 0; T < 9; ++T) {
            f32x4 c4 = (f32x4){0.f, 0.f, 0.f, 0.f};
#pragma unroll
            for (int s = 0; s < 4; ++s) { const bf16x8 kf = *(const LAS bf16x8*)(Kimg + off_b(16 * wave + 16 * T + iq, 4 * s + kq)); c4 = PG8_MFMA16(kf, qf[s], c4); }
            st[T] = c4;
        }
        float mx = -3.0e38f;
#pragma unroll
        for (int T = 0; T < 9; ++T)
#pragma unroll
            for (int e = 0; e < 4; ++e) { const int kr = 16 * T + 4 * kq + e - iq, j = i0 + 16 * wave - 64 + 16 * T + 4 * kq + e;
                const bool ok = (kr >= 0) && (kr <= 128) && (j >= 0) && (j < L); st[T][e] = ok ? st[T][e] : -1.0e30f; mx = fmaxf(mx, st[T][e]); }
        mx = fmaxf(mx, shx(mx, 16, lane)); mx = fmaxf(mx, shx(mx, 32, lane));
        float den = 0.f;
#pragma unroll
        for (int T = 0; T < 9; ++T)
#pragma unroll
            for (int e = 0; e < 4; ++e) { const float pv = fast_exp2(st[T][e] - mx); st[T][e] = pv; den += pv; }
        den += shx(den, 16, lane); den += shx(den, 32, lane);
        bf16x8 pf[5];
#pragma unroll
        for (int s2 = 0; s2 < 5; ++s2) {
            v4u w; w.x = pk2(st[2 * s2][0], st[2 * s2][1]); w.y = pk2(st[2 * s2][2], st[2 * s2][3]);
            if (s2 < 4) { w.z = pk2(st[2 * s2 + 1][0], st[2 * s2 + 1][1]); w.w = pk2(st[2 * s2 + 1][2], st[2 * s2 + 1][3]); } else { w.z = 0u; w.w = 0u; }
            pf[s2] = __builtin_bit_cast(bf16x8, w);
        }
        const float inv = 1.0f / den;
        const unsigned qq = (unsigned)(iq >> 2), pp = (unsigned)(lane & 3);
#pragma unroll
        for (int c = 0; c < 8; ++c) {
            f32x4 o4 = (f32x4){0.f, 0.f, 0.f, 0.f};
#pragma unroll
            for (int s2 = 0; s2 < 5; ++s2) {
                unsigned r0 = 16 * wave + 32 * s2 + 4 * kq + qq, r1 = r0 + 16; r1 = r1 > 255u ? 255u : r1;
                const s16x4 lo = tr_read(Vimg + off_b(r0, 2 * c + (pp >> 1)) + 8 * (pp & 1));
                const s16x4 hi = tr_read(Vimg + off_b(r1, 2 * c + (pp >> 1)) + 8 * (pp & 1));
                const bf16x8 vf = __builtin_shufflevector(lo, hi, 0, 1, 2, 3, 4, 5, 6, 7);
                o4 = PG8_MFMA16(vf, pf[s2], o4);
            }
            v2u ow; ow.x = pk2(o4[0] * inv, o4[1] * inv); ow.y = pk2(o4[2] * inv, o4[3] * inv);
            if (!dry) *(GAS v2u*)(Qb + qtok * NQKV + 16 * c + 4 * kq) = ow;
        }
        if (kq == 0 && !dry) LSE[(qtok * 3 + g) * 8 + h] = (mx + __builtin_amdgcn_logf(den)) * LN2;
        WG_BAR();
        u = un;
    }
}
#undef ATTN_KV_LOAD
__device__ __forceinline__ void combine_phase(const bf16* QKV, const float* LSE, bf16* ATT, int G, int wid0) {
    const size_t gt = (size_t)blockIdx.x * 512 + opaque_tid(wid0), nthr = (size_t)G * 512;
    for (size_t i = gt; i < (size_t)MG * 128; i += nthr) {
        const size_t t = i >> 7; const int ch = (int)(i & 127), h = ch >> 4;
        const float l0 = LSE[(t * 3 + 0) * 8 + h], l1 = LSE[(t * 3 + 1) * 8 + h], l2 = LSE[(t * 3 + 2) * 8 + h];
        const float m = fmaxf(l0, fmaxf(l1, l2));
        float w0 = fast_exp2((l0 - m) * 1.4426950408889634f), w1 = fast_exp2((l1 - m) * 1.4426950408889634f), w2 = fast_exp2((l2 - m) * 1.4426950408889634f);
        const float inv = 1.0f / (w0 + w1 + w2); w0 *= inv; w1 *= inv; w2 *= inv;
        const v4u a = *(const GAS v4u*)(QKV + t * NQKV + ch * 8), b = *(const GAS v4u*)(QKV + t * NQKV + 3072 + ch * 8), c = *(const GAS v4u*)(QKV + t * NQKV + 6144 + ch * 8);
        v4u o;
        o.x = pk2(w0 * bf_lo(a.x) + w1 * bf_lo(b.x) + w2 * bf_lo(c.x), w0 * bf_hi(a.x) + w1 * bf_hi(b.x) + w2 * bf_hi(c.x));
        o.y = pk2(w0 * bf_lo(a.y) + w1 * bf_lo(b.y) + w2 * bf_lo(c.y), w0 * bf_hi(a.y) + w1 * bf_hi(b.y) + w2 * bf_hi(c.y));
        o.z = pk2(w0 * bf_lo(a.z) + w1 * bf_lo(b.z) + w2 * bf_lo(c.z), w0 * bf_hi(a.z) + w1 * bf_hi(b.z) + w2 * bf_hi(c.z));
        o.w = pk2(w0 * bf_lo(a.w) + w1 * bf_lo(b.w) + w2 * bf_lo(c.w), w0 * bf_hi(a.w) + w1 * bf_hi(b.w) + w2 * bf_hi(c.w));
        *(GAS v4u*)(ATT + t * AW + ch * 8) = o;
    }
}

#ifndef MK_PER_PHASE
#define MK_PER_PHASE 0
#endif
constexpr int N_PHASES = 1 + (2 + 4 + 3 + 4) + 1 + (2 + 4 + 3 + 4);
#ifndef PROBE_SITE
#define PROBE_SITE 0
#endif
#define REPS(site, cond) ((PROBE_SITE == (site) && (cond)) ? 2 : 1)

__global__ void __launch_bounds__(NWAVES * 64, 2) trunk_fwd(Args args) {
    extern __shared__ __attribute__((aligned(16))) unsigned char lds_raw[];
    LAS unsigned char* lds = (LAS unsigned char*)lds_raw;
    LAS unsigned char* xl = lds + RING_BYTES;
    const int G = gridDim.x;
    const int wid0 = __builtin_amdgcn_readfirstlane((int)threadIdx.x >> 6);
    for (int u = threadIdx.x; u < (LDS_BYTES - RING_BYTES) / 4; u += NWAVES * 64) ((LAS unsigned*)(lds + RING_BYTES))[u] = 0u;
    __syncthreads();
    const int lo = args.ph_lo, hi = args.ph_hi;
    XcdBarrier bar; bar.wid0 = wid0; bar.bar = (unsigned*)(arg_ws() + WS_CTL); bar.x = 0; bar.st = (volatile LAS unsigned*)(lds + MISC_OFF) + 8;
    if (hi - lo > 1) { bar = xcd_barrier_post((unsigned*)(arg_ws() + WS_CTL), (volatile LAS unsigned*)(lds + MISC_OFF) + 8); bar.wid0 = wid0; }
    int pc = 0;
#define RUN_PH (pc >= lo && pc < hi)
#define SEAM() do { if (pc >= lo && pc + 1 < hi) { XcdBarrier b2_ = bar; asm volatile("" : "+s"(b2_.bar), "+s"(b2_.x)); b2_.bar = (unsigned*)(GAS unsigned*)b2_.bar; xcd_barrier(b2_); } ++pc; } while (0)
#define WSP(T, off) ((T*)(arg_ws() + (off)))
#define BIGP(T, off) ((T*)(arg_ws() + WS_BIG + (off)))
#define XOUT(grp) (arg_out() + (size_t)(grp) * MG * D)
#define VECP() ((const float*)(arg_ws() + WS_VEC))
#define PH_LOCALS int grp_ = grp, layer_ = layer; asm volatile("" : "+s"(grp_), "+s"(layer_)); const int S_ = grp_ == 0 ? 2048 : 16384; (void)layer_; (void)S_

    if (RUN_PH) { _Pragma("unroll 1") for (int rep = 0; rep < REPS(1, true); ++rep) prologue_phase(lds, G, wid0);
        conv_bf16(arg_in(0), WSP(bf16, WS_XB), (size_t)MG * D / 8, (size_t)blockIdx.x * 512 + opaque_tid(wid0), (size_t)G * 512); }
    SEAM();
#pragma unroll 1
    for (int grp = 0; grp < 2; ++grp) {
        if (grp == 1) {
            if (RUN_PH) { _Pragma("unroll 1") for (int rep = 0; rep < REPS(2, true); ++rep)
                conv_bf16(arg_in(1), WSP(bf16, WS_XB), (size_t)MG * D / 8, (size_t)blockIdx.x * 512 + opaque_tid(wid0), (size_t)G * 512); }
            SEAM();
        }
#pragma unroll 1
        for (int layer = 0; layer < 2; ++layer) {
            if (layer == 0) {
                if (RUN_PH) { PH_LOCALS; if (grp_ == 0) finalize_vecs(G, wid0);
                    _Pragma("unroll 1") for (int rep = 0; rep < REPS(3, grp_ == 0); ++rep) {
                    pg8::Gemm g{WSP(bf16, WS_XB), WSP(const bf16, WS_W_IN), MG, HW, D, wid0}; pg8::StaticOrder So; So.init(MG, HW, G, (int)blockIdx.x);
                    pg8::EpiPlain<1> E{BIGP(bf16, BIG_H), HW, wid0};
                    pg8::gemm_phase<pg8::EpiPlain<1>, pg8::StaticOrder, true, true>(lds, g, So, E);
                } }
                SEAM();
                if (RUN_PH) { PH_LOCALS; _Pragma("unroll 1") for (int rep = 0; rep < REPS(4, grp_ == 0); ++rep) sgu_phase(lds, BIGP(const bf16, BIG_H), BIGP(bf16, BIG_GATED), WSP(const bf16, WS_W_S), arg_in(8), arg_in(5), arg_in(6), G, wid0); }
                SEAM();
            } else {
                if (RUN_PH) { PH_LOCALS; _Pragma("unroll 1") for (int rep = 0; rep < REPS(5, grp_ == 0); ++rep) {
                    pg8::Gemm g{WSP(bf16, WS_XB), WSP(const bf16, WS_W_QKV), MG, NQKV, D, wid0}; pg8::StaticOrder So; So.init(MG, NQKV, G, (int)blockIdx.x);
                    pg8::EpiQKV E{BIGP(bf16, BIG_QKV), WSP(const float, WS_ROT), S_ - 1, QSCALE, wid0};
                    pg8::gemm_phase<pg8::EpiQKV, pg8::StaticOrder, true, true>(lds, g, So, E);
                } }
                SEAM();
                if (RUN_PH) { PH_LOCALS; _Pragma("unroll 1") for (int rep = REPS(6, grp_ == 0) - 1; rep >= 0; --rep) attn_phase(lds, BIGP(bf16, BIG_QKV), BIGP(float, BIG_LSE), S_, G, rep != 0, wid0); }
                SEAM();
                if (RUN_PH) { PH_LOCALS; _Pragma("unroll 1") for (int rep = 0; rep < REPS(7, grp_ == 0); ++rep) combine_phase(BIGP(const bf16, BIG_QKV), BIGP(const float, BIG_LSE), BIGP(bf16, BIG_ATT), G, wid0); }
                SEAM();
            }
            if (RUN_PH) { PH_LOCALS; _Pragma("unroll 1") for (int rep = 0; rep < REPS(8, grp_ == 0 && layer_ == 0); ++rep) {
                conv_bf16(arg_in(2 + grp_) + (size_t)layer_ * MG * PLE, BIGP(bf16, BIG_PB), (size_t)MG * PLE / 8, (size_t)blockIdx.x * 512 + opaque_tid(wid0), (size_t)G * 512);
                pg8::Gemm g{layer_ == 0 ? BIGP(const bf16, BIG_GATED) : BIGP(const bf16, BIG_ATT), layer_ == 0 ? WSP(const bf16, WS_W_OA) : WSP(const bf16, WS_W_OB), MG, D, layer_ == 0 ? D : AW, wid0};
                pg8::StaticOrder So; So.init(MG, D, G, (int)blockIdx.x);
                pg8::EpiY1 E{layer_ == 0 ? arg_in(grp_) : (const float*)nullptr, WSP(const bf16, WS_XB), WSP(bf16, WS_XB), WSP(float, WS_ST1), xl, ALPHA, wid0};
                pg8::gemm_phase<pg8::EpiY1, pg8::StaticOrder, true, true>(lds, g, So, E);
            } }
            SEAM();
            if (RUN_PH) { PH_LOCALS; _Pragma("unroll 1") for (int rep = 0; rep < REPS(9, grp_ == 0 && layer_ == 0); ++rep) {
                { int kple = PLE; asm volatile("" : "+s"(kple));
                  pg8::Gemm g{BIGP(const bf16, BIG_PB), WSP(const bf16, WS_W_PJ + layer_ * W_PJ_STRIDE), MG, D, kple, wid0}; pg8::StaticOrder So; So.init(MG, D, G, (int)blockIdx.x);
                  pg8::EpiPlain<0> E{BIGP(bf16, BIG_PP), D, wid0};
                  pg8::gemm_phase<pg8::EpiPlain<0>, pg8::StaticOrder, true, true>(lds, g, So, E); }
                { pg8::Gemm g{WSP(const bf16, WS_XB), WSP(const bf16, WS_W_GU + layer_ * W_GU_STRIDE), MG, NGU, D, wid0}; pg8::StaticOrder So; So.init(MG, NGU, G, (int)blockIdx.x);
                  pg8::EpiGU E{WSP(const float, WS_ST1), VECP() + VEC_GU + layer_ * VEC_GU_L, VECP() + VEC_GU + layer_ * VEC_GU_L + NGU, BIGP(bf16, BIG_HB), xl, LN_EPS, wid0};
                  pg8::gemm_phase<pg8::EpiGU, pg8::StaticOrder, true, true>(lds, g, So, E); }
            } }
            SEAM();
            if (PROBE_SITE == 10 && RUN_PH) { PH_LOCALS; if (grp_ == 0 && layer_ == 0) {
                pg8::Gemm g{BIGP(const bf16, BIG_HB), WSP(const bf16, WS_W_DN + layer_ * W_DN_STRIDE), MG, D, FF, wid0}; pg8::StaticOrder So; So.init(MG, D, G, (int)blockIdx.x);
                pg8::EpiY2 E{WSP(const bf16, WS_XB), BIGP(bf16, BIG_XB2), WSP(const float, WS_ST1), WSP(float, WS_ST2), arg_in(12) + layer_ * D, arg_in(13) + layer_ * D, xl, ALPHA, LN_EPS, wid0};
                pg8::gemm_phase<pg8::EpiY2, pg8::StaticOrder, true, true>(lds, g, So, E);
            } }
            if (RUN_PH) { PH_LOCALS; {
                pg8::Gemm g{BIGP(const bf16, BIG_HB), WSP(const bf16, WS_W_DN + layer_ * W_DN_STRIDE), MG, D, FF, wid0}; pg8::StaticOrder So; So.init(MG, D, G, (int)blockIdx.x);
                pg8::EpiY2 E{WSP(const bf16, WS_XB), BIGP(bf16, BIG_XB2), WSP(const float, WS_ST1), WSP(float, WS_ST2), arg_in(12) + layer_ * D, arg_in(13) + layer_ * D, xl, ALPHA, LN_EPS, wid0};
                pg8::gemm_phase<pg8::EpiY2, pg8::StaticOrder, true, true>(lds, g, So, E);
            } }
            SEAM();
            if (RUN_PH) { PH_LOCALS; _Pragma("unroll 1") for (int rep = 0; rep < REPS(11, grp_ == 0 && layer_ == 0); ++rep) {
                pg8::Gemm g{BIGP(const bf16, BIG_XB2), WSP(const bf16, WS_W_GT + layer_ * W_GT_STRIDE), MG, D, D, wid0}; pg8::StaticOrder So; So.init(MG, D, G, (int)blockIdx.x);
                pg8::EpiPLE E{BIGP(const bf16, BIG_XB2), layer_ == 0 ? (float*)nullptr : XOUT(grp_), WSP(bf16, WS_XB), BIGP(const bf16, BIG_PP), WSP(const float, WS_ST2), arg_in(16) + layer_ * D, arg_in(17) + layer_ * D,
                              VECP() + VEC_GT + layer_ * VEC_GT_L, VECP() + VEC_GT + layer_ * VEC_GT_L + D, xl, LN_EPS, wid0};
                pg8::gemm_phase<pg8::EpiPLE, pg8::StaticOrder, true, true>(lds, g, So, E);
            } }
            SEAM();
        }
    }
#undef RUN_PH
#undef SEAM
}

extern "C" void kernel_launch(void* const* d_in, const int* in_sizes, int n_in, void* d_out, int out_size, void* d_ws, size_t ws_size, hipStream_t stream) {
    static int grid = 0;
    if (grid == 0) {
        if (n_in != 20 || in_sizes[0] != MG * D || in_sizes[1] != MG * D || out_size != 2 * MG * D || ws_size < WS_END) {
            fprintf(stderr, "kernel_launch: unexpected shapes (n_in %d, in0 %d, out %d, ws %zu < %zu); nothing launched\n", n_in, n_in > 0 ? in_sizes[0] : -1, out_size, ws_size, (size_t)WS_END); grid = -1; return; }
        int dev = 0, cus = 0, per_cu = 0;
        if (hipGetDevice(&dev) != hipSuccess || hipDeviceGetAttribute(&cus, hipDeviceAttributeMultiprocessorCount, dev) != hipSuccess) { grid = -1; return; }
        if (hipFuncSetAttribute((const void*)trunk_fwd, hipFuncAttributeMaxDynamicSharedMemorySize, LDS_BYTES) != hipSuccess) { fprintf(stderr, "kernel_launch: hipFuncSetAttribute failed\n"); grid = -1; return; }
        if (hipOccupancyMaxActiveBlocksPerMultiprocessor(&per_cu, (const void*)trunk_fwd, NWAVES * 64, LDS_BYTES) != hipSuccess || per_cu < 1)
            fprintf(stderr, "kernel_launch: note: occupancy query reports %d workgroups per CU\n", per_cu);
        (void)hipGetLastError();
        grid = cus;
    }
    if (grid < 0) return;
    if (hipMemsetAsync((char*)d_ws + WS_CTL, 0, CTL_ZERO_BYTES, stream) != hipSuccess) return;
    Args a{};
    for (int i = 0; i < 20; ++i) a.in[i] = (const float*)d_in[i];
    a.out = (float*)d_out; a.ws = (unsigned char*)d_ws;
#if MK_PER_PHASE
    for (int p = 0; p < N_PHASES; ++p) { a.ph_lo = p; a.ph_hi = p + 1; hipLaunchKernelGGL(trunk_fwd, dim3(grid), dim3(NWAVES * 64), LDS_BYTES, stream, a); }
#else
    a.ph_lo = 0; a.ph_hi = N_PHASES;
    hipLaunchKernelGGL(trunk_fwd, dim3(grid), dim3(NWAVES * 64), LDS_BYTES, stream, a);
#endif
    const hipError_t le = hipPeekAtLastError();
    if (le != hipSuccess) fprintf(stderr, "kernel_launch: launch failed: %s\n", hipGetErrorName(le));
}
```

```cpp
#include <hip/hip_runtime.h>
#include <cstdio>
#include <cstdint>
namespace pg8 {
#define PG8_LAS __attribute__((address_space(3)))
typedef unsigned short bf16_t;
typedef short bf16x8 __attribute__((ext_vector_type(8)));
typedef float f32x4 __attribute__((ext_vector_type(4)));
typedef unsigned u32x4 __attribute__((ext_vector_type(4)));
constexpr int BM = 256, BK = 64, HALF = 128, HTB = HALF * BK * 2  , STAGE_BYTES = 8 * HTB, NXCD = 8, WGM = 4;

__host__ __device__ __forceinline__ int lds_byte(int r, int c) { const int st = (r >> 4) * 2 + (c >> 5), rr = r & 15, cc = c & 31, ob = rr * 64 + cc * 2; return st * 1024 + (ob ^ (((ob >> 9) & 1) << 5)); }
__host__ __device__ __forceinline__ void stage_rc(int b, int& R, int& C) { const int st = b / 1024, sb = b % 1024, swz = sb ^ (((sb >> 9) & 1) << 5); R = (st >> 1) * 16 + swz / 64; C = (st & 1) * 32 + (swz % 64) / 2; }
__host__ __device__ __forceinline__ int perm32(int rho) { const int n = rho >> 4, i = rho & 15; return 8 * (i >> 2) + 4 * n + (i & 3); }

struct Unit { int pm, pn; };
struct Gemm { const bf16_t* A; const bf16_t* Bt; int M, N, K, wid0; };

struct StaticOrder {
    int nM, nN, nwg, G, c;
    __host__ __device__ void init(int M, int N, int G_, int c_) { nM = M / BM; nN = N / BM; nwg = nM * nN; G = G_; c = c_; }
    __host__ __device__ bool next(int i, Unit& u) const {
        const long L = (long)i * G + c; if (L >= nwg) return false;
        int wgid = (int)L; { const int q = nwg / NXCD, r = nwg % NXCD, xcd = wgid % NXCD, off = wgid / NXCD; wgid = (xcd < r ? xcd * (q + 1) : r * (q + 1) + (xcd - r) * q) + off; }
        const int nig = WGM * nN, gid = wgid / nig, fm = gid * WGM, gsz = (nM - fm) < WGM ? (nM - fm) : WGM;
        u.pm = fm + ((wgid % nig) % gsz); u.pn = (wgid % nig) / gsz; return true;
    }
    __device__ __forceinline__ void a_ready(const Unit&) const {}
    __device__ __forceinline__ void done(const Unit&) const {}
    unsigned* gate_p = nullptr; unsigned gate_t = 0u; mutable unsigned gwait = 0u;
    __device__ __forceinline__ void epi_gate(int ui) const {
#if PROBE_STAMP == 9
        if (ui == 0 && gate_t != 0u) { const unsigned tg0_ = (unsigned)__builtin_amdgcn_s_memrealtime(); while (__hip_atomic_load(gate_p, __ATOMIC_RELAXED, __HIP_MEMORY_SCOPE_AGENT) < gate_t) __builtin_amdgcn_s_sleep(1);
            gwait = (unsigned)__builtin_amdgcn_s_memrealtime() - tg0_; return; }
#endif
        if (ui == 0 && gate_t != 0u) { unsigned sp = 0u; while (__hip_atomic_load(gate_p, __ATOMIC_RELAXED, __HIP_MEMORY_SCOPE_AGENT) < gate_t) { __builtin_amdgcn_s_sleep(1); if (++sp > (1u << 18)) break; } asm volatile("" ::: "memory"); }
    }
};
typedef _Float16 h16x2 __attribute__((ext_vector_type(2)));
typedef _Float16 h16x8 __attribute__((ext_vector_type(8)));
typedef float f32x2p __attribute__((ext_vector_type(2)));
#ifndef USE_BF16
#define USE_BF16 1
#endif
#if USE_BF16
__device__ __forceinline__ unsigned cvt_pk16(float lo, float hi) { unsigned r; asm volatile("v_cvt_pk_bf16_f32 %0, %1, %2" : "=v"(r) : "v"(lo), "v"(hi)); return r; }
#define PG8_MFMA16(a, b, c) __builtin_amdgcn_mfma_f32_16x16x32_bf16((a), (b), (c), 0, 0, 0)
#else
__device__ __forceinline__ unsigned cvt_pk16(float lo, float hi) { const f32x2p v = {lo, hi}; return __builtin_bit_cast(unsigned, __builtin_convertvector(v, h16x2)); }
#define PG8_MFMA16(a, b, c) __builtin_amdgcn_mfma_f32_16x16x32_f16(__builtin_bit_cast(pg8::h16x8, (a)), __builtin_bit_cast(pg8::h16x8, (b)), (c), 0, 0, 0)
#endif
typedef float f32x2 __attribute__((ext_vector_type(2)));
__device__ __forceinline__ f32x2 gelu_pk(f32x2 v) {
    const f32x2 av = __builtin_elementwise_abs(v), d = av * 0.2316418882f + 1.0f;
    f32x2 t; t.x = __builtin_amdgcn_rcpf(d.x); t.y = __builtin_amdgcn_rcpf(d.y);
    f32x2 q = t * 0.5307027145f + (-0.7265760135f); q = q * t + 0.7107068705f; q = q * t + (-0.142248368f); q = q * t + 0.127414796f; q = q * t;
    const f32x2 s = (v * v) * (-0.72134752044f);
    f32x2 e; e.x = __builtin_amdgcn_exp2f(s.x); e.y = __builtin_amdgcn_exp2f(s.y);
    const f32x2 m = v * (q * e), r = v - m;
    f32x2 o; o.x = v.x < 0.f ? m.x : r.x; o.y = v.y < 0.f ? m.y : r.y; return o;
}

template <int ACT  > struct EpiBf16 {
    static constexpr bool PERM = true, AFTER_DRAIN = false; static_assert(ACT == 0 || ACT == 1, "EpiBf16: ACT is 0 (none) or 1 (gelu_pk)");
    bf16_t* O; int ldc; const float* bias; int split_cols; size_t split_stride; float scale0;
    __device__ __forceinline__ void operator()(const f32x4 (&acc)[2][2][4][2], const Unit& u, int wr, int wc, int fr, int fq) const {
        const int row0 = u.pm * BM + wr * 64 + fr; int colt = u.pn * BM; bf16_t* base = O;
        float sc = 1.f; if (split_cols) { const int t = colt / split_cols; base += (size_t)t * split_stride; colt -= t * split_cols; if (t == 0) sc = scale0; }
        const int col0 = colt + wc * 32 + 8 * fq, bcol0 = u.pn * BM + wc * 32 + 8 * fq;
        f32x4 bv[2][2];
#pragma unroll
        for (int bj = 0; bj < 2; ++bj)
#pragma unroll
            for (int n = 0; n < 2; ++n) bv[bj][n] = bias ? *(const f32x4*)(bias + bcol0 + bj * HALF + 4 * n) : (f32x4){0.f, 0.f, 0.f, 0.f};
#pragma unroll
        for (int ai = 0; ai < 2; ++ai)
#pragma unroll
            for (int m = 0; m < 4; ++m) { bf16_t* rowp = base + (size_t)(row0 + ai * HALF + m * 16) * ldc + col0;
#pragma unroll
                for (int bj = 0; bj < 2; ++bj) { f32x4 v0 = acc[ai][bj][m][0] + bv[bj][0], v1 = acc[ai][bj][m][1] + bv[bj][1];
                    if (ACT == 1) { f32x2 a = gelu_pk((f32x2){v0[0], v0[1]}), b = gelu_pk((f32x2){v0[2], v0[3]}), c = gelu_pk((f32x2){v1[0], v1[1]}), d = gelu_pk((f32x2){v1[2], v1[3]});
                        v0 = (f32x4){a.x, a.y, b.x, b.y}; v1 = (f32x4){c.x, c.y, d.x, d.y}; }
                    v0 = v0 * sc; v1 = v1 * sc; u32x4 w; w.x = cvt_pk16(v0[0], v0[1]); w.y = cvt_pk16(v0[2], v0[3]); w.z = cvt_pk16(v1[0], v1[1]); w.w = cvt_pk16(v1[2], v1[3]);
                    *(u32x4*)(rowp + bj * HALF) = w; } }
    }
};
}

constexpr int D = 2048, FF = 5632, NGU = 2 * FF, NQKV = 9216, AW = 1024, PLE = 256, HW = 4096;
constexpr int MG = 32768;
constexpr float LN_EPS = 1e-5f;
constexpr float ALPHA = 1.4142135623730951f;
constexpr float QSCALE = 0.08838834764831845f * 1.4426950408889634f;
constexpr float LN2 = 0.6931471805599453f;
constexpr int NWAVES = 8;

constexpr size_t MiB = 1u << 20;
constexpr size_t WS_CTL = 0, CTL_ZERO_BYTES = 65536;
constexpr size_t WS_ROT = 2 * MiB;
constexpr size_t WS_ST1 = 4 * MiB, WS_ST2 = 6 * MiB;
constexpr size_t WS_PART = 8 * MiB;
constexpr size_t WS_VEC = 16 * MiB;
constexpr size_t WS_W_IN = 17 * MiB, WS_W_OA = 33 * MiB, WS_W_S = 41 * MiB, WS_W_QKV = 42 * MiB, WS_W_OB = 78 * MiB;
constexpr size_t WS_W_GU = 82 * MiB, W_GU_STRIDE = 44 * MiB, WS_W_DN = 170 * MiB, W_DN_STRIDE = 22 * MiB;
constexpr size_t WS_W_GT = 214 * MiB, W_GT_STRIDE = 8 * MiB, WS_W_PJ = 230 * MiB, W_PJ_STRIDE = 1 * MiB;
constexpr size_t WS_XB = 232 * MiB;
constexpr size_t WS_BIG = 360 * MiB;
constexpr size_t BIG_H = 0, BIG_GATED = 384 * MiB, BIG_PB = 644 * MiB, BIG_XB2 = 384 * MiB, BIG_HB = 0, BIG_PP = 512 * MiB;
constexpr size_t BIG_QKV = 0, BIG_ATT = 576 * MiB, BIG_LSE = 640 * MiB;
constexpr size_t WS_END = WS_BIG + 660 * MiB;
constexpr int KB32 = 32;
constexpr size_t PART_GU = 0, PART_GU_L = (size_t)2 * KB32 * NGU, PART_GT = 2 * PART_GU_L, PART_GT_L = (size_t)2 * KB32 * D;
constexpr size_t VEC_GU = 0, VEC_GU_L = 2 * NGU, VEC_GT = 2 * VEC_GU_L, VEC_GT_L = 2 * D;
static_assert((PART_GT + 2 * PART_GT_L) * 4 <= 8 * MiB && (VEC_GT + 2 * VEC_GT_L) * 4 <= 1 * MiB, "partials");

constexpr int RING_BYTES = 131072;
constexpr int MISC_OFF = RING_BYTES + 320;
constexpr int STAB_OFF = RING_BYTES + 512;
constexpr int PTAB_OFF = STAB_OFF + 2048;
constexpr int LDS_BYTES = 147456;
static_assert(PTAB_OFF + 8192 <= LDS_BYTES, "LDS map");

#define GAS __attribute__((address_space(1)))
#define LAS __attribute__((address_space(3)))
typedef unsigned short bf16;
typedef unsigned v4u __attribute__((ext_vector_type(4)));
typedef unsigned v2u __attribute__((ext_vector_type(2)));
typedef float f32x4 __attribute__((ext_vector_type(4)));
typedef float f32x2v __attribute__((ext_vector_type(2)));
typedef short bf16x8 __attribute__((ext_vector_type(8)));
typedef short s16x4 __attribute__((ext_vector_type(4)));
#define LDS_WAIT() asm volatile("s_waitcnt lgkmcnt(0)" ::: "memory")
#define VM_WAIT() asm volatile("s_waitcnt vmcnt(0)" ::: "memory")
#define WG_BAR() do { asm volatile("s_waitcnt lgkmcnt(0)" ::: "memory"); __builtin_amdgcn_s_barrier(); asm volatile("" ::: "memory"); } while (0)

#if USE_BF16
__device__ __forceinline__ float bf_round(float f) { unsigned u = __builtin_bit_cast(unsigned, f); u = (u + 0x7fffu + ((u >> 16) & 1u)) & 0xffff0000u; return __builtin_bit_cast(float, u); }
#else
__device__ __forceinline__ float bf_round(float f) { return (float)(_Float16)f; }
#endif
__device__ __forceinline__ unsigned pk2(float lo, float hi) { return pg8::cvt_pk16(lo, hi); }
#if USE_BF16
__device__ __forceinline__ float bf_lo(unsigned w) { return __builtin_bit_cast(float, w << 16); }
__device__ __forceinline__ float bf_hi(unsigned w) { return __builtin_bit_cast(float, w & 0xffff0000u); }
#else
__device__ __forceinline__ float bf_lo(unsigned w) { return (float)__builtin_bit_cast(pg8::h16x2, w).x; }
__device__ __forceinline__ float bf_hi(unsigned w) { return (float)__builtin_bit_cast(pg8::h16x2, w).y; }
#endif
__device__ __forceinline__ int opaque_tid(int wid0) { int t; asm volatile("v_mbcnt_lo_u32_b32 %0, -1, 0\n\tv_mbcnt_hi_u32_b32 %0, -1, %0" : "=v"(t)); return (wid0 << 6) | t; }
__device__ __forceinline__ float shx(float v, int mask, int lane) { return __builtin_bit_cast(float, __builtin_amdgcn_ds_bpermute((lane ^ mask) << 2, __builtin_bit_cast(int, v))); }
__device__ __forceinline__ float wave_sum(float v, int lane) {
#pragma unroll
    for (int o = 1; o < 64; o <<= 1) v += shx(v, o, lane);
    return v;
}
__device__ __forceinline__ float fast_exp2(float x) { return __builtin_amdgcn_exp2f(x); }
__device__ __forceinline__ float fast_rcp(float x) { return __builtin_amdgcn_rcpf(x); }
__device__ __forceinline__ float sigmoidf_(float x) { return fast_rcp(1.0f + fast_exp2(-1.4426950408889634f * x)); }
__device__ __forceinline__ unsigned off_b(unsigned row, unsigned ch) { return 256u * row + 16u * (ch ^ (((row & 3u) << 2) | ((row >> 2) & 3u))); }
typedef short v4i16_t __attribute__((ext_vector_type(4)));
__device__ __forceinline__ s16x4 tr_read(LAS const unsigned char* p) { return __builtin_bit_cast(s16x4, __builtin_amdgcn_ds_read_tr16_b64_v4i16((LAS v4i16_t*)p)); }

namespace pg8 {
__device__ __forceinline__ void stab_from_partials(const float* st, int pm, PG8_LAS unsigned char* xl, float eps, int wid0) {
    const int tid = opaque_tid(wid0);
    if (tid < 256) {
        const f32x4* p = (const f32x4*)(st + ((size_t)(pm * BM + tid)) * 16);
        const f32x4 a = p[0], b = p[1], c = p[2], d = p[3];
        const float S = ((a[0] + a[2]) + (b[0] + b[2])) + ((c[0] + c[2]) + (d[0] + d[2]));
        const float Q = ((a[1] + a[3]) + (b[1] + b[3])) + ((c[1] + c[3]) + (d[1] + d[3]));
        const float mean = S * (1.0f / 2048.0f); float var = Q * (1.0f / 2048.0f) - mean * mean; var = var < 0.f ? 0.f : var;
        ((PG8_LAS f32x2*)(xl + (STAB_OFF - RING_BYTES)))[tid] = (f32x2){mean, 1.0f / sqrtf(var + eps)};
    }
    asm volatile("s_waitcnt lgkmcnt(0)" ::: "memory"); __builtin_amdgcn_s_barrier(); asm volatile("" ::: "memory");
}
__device__ __forceinline__ void partials_to_st(float* st, const Unit& u, PG8_LAS unsigned char* xl, int wid0) {
    asm volatile("s_waitcnt lgkmcnt(0)" ::: "memory"); __builtin_amdgcn_s_barrier(); asm volatile("" ::: "memory");
    const int tid = opaque_tid(wid0);
    if (tid < 256) {
        const PG8_LAS f32x4* P = (const PG8_LAS f32x4*)(xl + (PTAB_OFF - RING_BYTES)) + tid * 2;
        const f32x4 a = P[0], b = P[1];
        f32x2 o; o.x = (a[0] + a[2]) + (b[0] + b[2]); o.y = (a[1] + a[3]) + (b[1] + b[3]);
        *(f32x2*)(st + ((size_t)(u.pm * BM + tid) * 8 + u.pn) * 2) = o;
    }
}
#ifndef NT_STREAM
#define NT_STREAM 1
#endif
#if NT_STREAM
#define NT_STORE16(p, v) __builtin_nontemporal_store((v), (u32x4*)(p))
#else
#define NT_STORE16(p, v) (*(u32x4*)(p) = (v))
#endif
struct LaneId { int wr, wc, fr, fq; };
__device__ __forceinline__ LaneId lane_id(int wid0) { const int t = opaque_tid(wid0); const int wid = wid0, lane = t & 63; LaneId L; L.wr = wid >> 2; L.wc = wid & 3; L.fr = lane & 15; L.fq = lane >> 4; return L; }
__device__ __forceinline__ f32x4 fma4(f32x4 a, float k, float c) { return a * k + c; }
__device__ __forceinline__ f32x4 sigmoid4(f32x4 t) {
    const f32x4 m = t * (-1.4426950408889634f); f32x4 e;
    e[0] = __builtin_amdgcn_exp2f(m[0]); e[1] = __builtin_amdgcn_exp2f(m[1]); e[2] = __builtin_amdgcn_exp2f(m[2]); e[3] = __builtin_amdgcn_exp2f(m[3]);
    const f32x4 d = e + 1.0f; f32x4 r;
    r[0] = __builtin_amdgcn_rcpf(d[0]); r[1] = __builtin_amdgcn_rcpf(d[1]); r[2] = __builtin_amdgcn_rcpf(d[2]); r[3] = __builtin_amdgcn_rcpf(d[3]);
    return r;
}
#define PG8_ROWSUM(s, q, v) do { s += ((v)[0] + (v)[1]) + ((v)[2] + (v)[3]); q += ((v)[0] * (v)[0] + (v)[1] * (v)[1]) + ((v)[2] * (v)[2] + (v)[3] * (v)[3]); } while (0)

template <int ACT> struct EpiPlain {
    static constexpr bool PERM = true, AFTER_DRAIN = false;
    bf16_t* O; int ldc; int wid0; float* st = nullptr; PG8_LAS unsigned char* xl = nullptr; int st_pn0 = 0;
    __device__ __forceinline__ void operator()(const f32x4 (&acc)[2][2][4][2], const Unit& u, int, int, int, int) const {
        const LaneId L_ = lane_id(wid0); const int wr = L_.wr, wc = L_.wc, fr = L_.fr, fq = L_.fq;
        const int row0 = u.pm * BM + wr * 64 + fr, col0 = u.pn * BM + wc * 32 + 8 * fq, ln_ = fr + 16 * fq;
        const bool stats = st != nullptr && u.pn >= st_pn0;
        PG8_LAS f32x2* P = (PG8_LAS f32x2*)(xl + (PTAB_OFF - RING_BYTES));
#pragma unroll
        for (int ai = 0; ai < 2; ++ai)
#pragma unroll
            for (int m = 0; m < 4; ++m) { bf16_t* rowp = O + (size_t)(row0 + ai * HALF + m * 16) * ldc + col0; float ss = 0.f, qq = 0.f;
#pragma unroll
                for (int bj = 0; bj < 2; ++bj) { f32x4 v0 = acc[ai][bj][m][0], v1 = acc[ai][bj][m][1];
                    if (ACT == 1) { f32x2 a = gelu_pk((f32x2){v0[0], v0[1]}), b = gelu_pk((f32x2){v0[2], v0[3]}), c = gelu_pk((f32x2){v1[0], v1[1]}), d = gelu_pk((f32x2){v1[2], v1[3]});
                        v0 = (f32x4){a.x, a.y, b.x, b.y}; v1 = (f32x4){c.x, c.y, d.x, d.y}; }
                    if (stats) { PG8_ROWSUM(ss, qq, v0); PG8_ROWSUM(ss, qq, v1); }
                    u32x4 w; w.x = cvt_pk16(v0[0], v0[1]); w.y = cvt_pk16(v0[2], v0[3]); w.z = cvt_pk16(v1[0], v1[1]); w.w = cvt_pk16(v1[2], v1[3]);
                    NT_STORE16(rowp + bj * HALF, w); }
                if (stats) { ss += shx(ss, 16, ln_); qq += shx(qq, 16, ln_); ss += shx(ss, 32, ln_); qq += shx(qq, 32, ln_);
                    if (fq == 0) P[(ai * HALF + wr * 64 + m * 16 + fr) * 4 + wc] = (f32x2){ss, qq}; } }
        if (stats) { Unit u2 = u; u2.pn = u.pn - st_pn0; partials_to_st(st, u2, xl, wid0); }
    }
};
struct EpiQKV {
    static constexpr bool PERM = true, AFTER_DRAIN = false;
    bf16_t* O; const float* rot; int seq_mask; float qscale; int wid0;
    __device__ __forceinline__ void operator()(const f32x4 (&acc)[2][2][4][2], const Unit& u, int, int, int, int) const {
        const LaneId L_ = lane_id(wid0); const int wr = L_.wr, wc = L_.wc, fr = L_.fr, fq = L_.fq;
        const int colt = u.pn * BM, tsel = (colt % 3072) / 1024;
        const float sc = tsel == 0 ? qscale : 1.0f;
        const bool dorot = (tsel < 2) && (wc == 0);
        const int row0 = u.pm * BM + wr * 64 + fr, col0 = colt + wc * 32 + 8 * fq;
        const float sgn = fq < 2 ? -1.0f : 1.0f;
#pragma unroll
        for (int ai = 0; ai < 2; ++ai)
#pragma unroll
            for (int m = 0; m < 4; ++m) {
                const int row = row0 + ai * HALF + m * 16;
                f32x4 cs[2], sn[2];
                if (dorot) { const float* rp = rot + (size_t)(row & seq_mask) * 32 + 8 * (fq & 1);
                    cs[0] = *(const f32x4*)(rp); cs[1] = *(const f32x4*)(rp + 4); sn[0] = *(const f32x4*)(rp + 16); sn[1] = *(const f32x4*)(rp + 20); }
#pragma unroll
                for (int bj = 0; bj < 2; ++bj) {
                    f32x4 v[2] = {acc[ai][bj][m][0], acc[ai][bj][m][1]};
                    if (dorot) {
#pragma unroll
                        for (int n = 0; n < 2; ++n) { f32x4 pr;
#pragma unroll
                            for (int j = 0; j < 4; ++j) pr[j] = shx(v[n][j], 32, fr + 16 * fq);
                            v[n] = v[n] * cs[n] + (pr * sn[n]) * sgn; }
                    }
                    v[0] = v[0] * sc; v[1] = v[1] * sc;
                    u32x4 w; w.x = cvt_pk16(v[0][0], v[0][1]); w.y = cvt_pk16(v[0][2], v[0][3]); w.z = cvt_pk16(v[1][0], v[1][1]); w.w = cvt_pk16(v[1][2], v[1][3]);
                    NT_STORE16(O + (size_t)row * NQKV + col0 + bj * HALF, w);
                }
            }
    }
};
#define PG8_UNPACK8(W_, v0, v1) do { v0[0] = bf_lo((W_)[0]); v0[1] = bf_hi((W_)[0]); v0[2] = bf_lo((W_)[1]); v0[3] = bf_hi((W_)[1]); v1[0] = bf_lo((W_)[2]); v1[1] = bf_hi((W_)[2]); v1[2] = bf_lo((W_)[3]); v1[3] = bf_hi((W_)[3]); } while (0)
#define PG8_PACK8(W_, v0, v1) do { (W_)[0] = cvt_pk16(v0[0], v0[1]); (W_)[1] = cvt_pk16(v0[2], v0[3]); (W_)[2] = cvt_pk16(v1[0], v1[1]); (W_)[3] = cvt_pk16(v1[2], v1[3]); } while (0)
struct EpiY1 {
    static constexpr bool PERM = true, AFTER_DRAIN = false;
    const float* xin32; const bf16_t* xin16; bf16_t* yb; float* st; PG8_LAS unsigned char* xl; float alpha; int wid0;
    __device__ __forceinline__ void operator()(const f32x4 (&acc)[2][2][4][2], const Unit& u, int, int, int, int) const {
        const LaneId L_ = lane_id(wid0); const int wr = L_.wr, wc = L_.wc, fr = L_.fr, fq = L_.fq;
        const int row0 = u.pm * BM + wr * 64 + fr, col0 = u.pn * BM + wc * 32 + 8 * fq, ln_ = fr + 16 * fq;
        PG8_LAS f32x2* P = (PG8_LAS f32x2*)(xl + (PTAB_OFF - RING_BYTES));
        const unsigned eb0 = (unsigned)(row0 * D + col0) * 2u;
        u32x4 xw[2][4];
#pragma unroll
        for (int m = 0; m < 4; ++m) xw[0][m] = *(const u32x4*)(((const char*)xin16 + (size_t)(m * 16 * D) * 2) + (size_t)eb0);
#pragma unroll
        for (int ai = 0; ai < 2; ++ai) {
            float s[4] = {0.f, 0.f, 0.f, 0.f}, q[4] = {0.f, 0.f, 0.f, 0.f};
#pragma unroll
            for (int bj = 0; bj < 2; ++bj) {
                const int b = ai * 2 + bj;
                if (b < 3) { const int ai2 = (b + 1) >> 1, bj2 = (b + 1) & 1;
#pragma unroll
                    for (int m = 0; m < 4; ++m) xw[(b + 1) & 1][m] = *(const u32x4*)(((const char*)xin16 + (size_t)((ai2 * HALF + m * 16) * D + bj2 * HALF) * 2) + (size_t)eb0); }
#pragma unroll
                for (int m = 0; m < 4; ++m) {
                    f32x4 x0, x1; PG8_UNPACK8(xw[b & 1][m], x0, x1);
                    const f32x4 y0 = x0 * alpha + acc[ai][bj][m][0], y1 = x1 * alpha + acc[ai][bj][m][1];
                    u32x4 w; PG8_PACK8(w, y0, y1); *(u32x4*)(((char*)yb + (size_t)((ai * HALF + m * 16) * D + bj * HALF) * 2) + (size_t)eb0) = w;
                    PG8_ROWSUM(s[m], q[m], y0); PG8_ROWSUM(s[m], q[m], y1); }
                asm volatile("" ::: "memory");
            }
#pragma unroll
            for (int m = 0; m < 4; ++m) { float ss = s[m], qq = q[m]; ss += shx(ss, 16, ln_); qq += shx(qq, 16, ln_); ss += shx(ss, 32, ln_); qq += shx(qq, 32, ln_);
                if (fq == 0) P[(ai * HALF + wr * 64 + m * 16 + fr) * 4 + wc] = (f32x2){ss, qq}; }
        }
        partials_to_st(st, u, xl, wid0);
    }
};
struct EpiGU {
    static constexpr bool PERM = true, AFTER_DRAIN = false;
    const float* st; const float* cs; const float* bw; bf16_t* H; PG8_LAS unsigned char* xl; float eps; int wid0; mutable int last_pm = -1;
    __device__ __forceinline__ void operator()(const f32x4 (&acc)[2][2][4][2], const Unit& u, int, int, int, int) const {
        const LaneId L_ = lane_id(wid0); const int wr = L_.wr, wc = L_.wc, fr = L_.fr, fq = L_.fq;
        if (u.pm != last_pm) { stab_from_partials(st, u.pm, xl, eps, wid0); last_pm = u.pm; }
        const PG8_LAS f32x2* S = (const PG8_LAS f32x2*)(xl + (STAB_OFF - RING_BYTES));
        const int row0 = u.pm * BM + wr * 64 + fr, col0 = u.pn * BM + wc * 32 + 8 * fq, hcol0 = u.pn * HALF + wc * 32 + 8 * fq;
        f32x4 csv[2][2], bwv[2][2];
#pragma unroll
        for (int bj = 0; bj < 2; ++bj)
#pragma unroll
            for (int n = 0; n < 2; ++n) { csv[bj][n] = *(const f32x4*)(cs + col0 + bj * HALF + 4 * n); bwv[bj][n] = *(const f32x4*)(bw + col0 + bj * HALF + 4 * n); }
#pragma unroll
        for (int ai = 0; ai < 2; ++ai)
#pragma unroll
            for (int m = 0; m < 4; ++m) {
                const int rl = ai * HALF + wr * 64 + m * 16 + fr; const f32x2 sr = S[rl]; const float nmr = -sr.x * sr.y;
                f32x4 h[2];
#pragma unroll
                for (int n = 0; n < 2; ++n) {
                    const f32x4 g = acc[ai][0][m][n] * sr.y + (csv[0][n] * nmr + bwv[0][n]);
                    const f32x4 uu = acc[ai][1][m][n] * sr.y + (csv[1][n] * nmr + bwv[1][n]);
                    h[n] = (g * sigmoid4(g)) * uu;
                }
                u32x4 w; w.x = cvt_pk16(h[0][0], h[0][1]); w.y = cvt_pk16(h[0][2], h[0][3]); w.z = cvt_pk16(h[1][0], h[1][1]); w.w = cvt_pk16(h[1][2], h[1][3]);
                NT_STORE16(H + (size_t)(row0 + ai * HALF + m * 16) * FF + hcol0, w);
            }
    }
};
struct EpiY2 {
    static constexpr bool PERM = true, AFTER_DRAIN = false;
    const bf16_t* y1b; bf16_t* yb; const float* st1; float* st2; const float* lng; const float* lnb; PG8_LAS unsigned char* xl; float alpha, eps; int wid0; mutable int last_pm = -1;
    __device__ __forceinline__ void operator()(const f32x4 (&acc)[2][2][4][2], const Unit& u, int, int, int, int) const {
        const LaneId L_ = lane_id(wid0); const int wr = L_.wr, wc = L_.wc, fr = L_.fr, fq = L_.fq;
        const int row0 = u.pm * BM + wr * 64 + fr, col0 = u.pn * BM + wc * 32 + 8 * fq, ln_ = fr + 16 * fq;
        const unsigned eb0 = (unsigned)(row0 * D + col0) * 2u;
        u32x4 aw[2][4];
#define PG8_Y2_LOAD(buf, k) do { _Pragma("unroll") for (int m = 0; m < 4; ++m) aw[buf][m] = *(const u32x4*)(((const char*)y1b + (size_t)(((((k) >> 1) * HALF + m * 16) * D + ((k) & 1) * HALF) * 2)) + (size_t)eb0); } while (0)
        PG8_Y2_LOAD(0, 0); PG8_Y2_LOAD(1, 1);
        if (u.pm != last_pm) { stab_from_partials(st1, u.pm, xl, eps, wid0); last_pm = u.pm; }
        const PG8_LAS f32x2* S = (const PG8_LAS f32x2*)(xl + (STAB_OFF - RING_BYTES));
        PG8_LAS f32x2* P = (PG8_LAS f32x2*)(xl + (PTAB_OFF - RING_BYTES));
        f32x4 gv[2][2], bv[2][2];
#pragma unroll
        for (int bj = 0; bj < 2; ++bj)
#pragma unroll
            for (int n = 0; n < 2; ++n) { gv[bj][n] = *(const f32x4*)(lng + col0 + bj * HALF + 4 * n); bv[bj][n] = *(const f32x4*)(lnb + col0 + bj * HALF + 4 * n); }
#pragma unroll
        for (int ai = 0; ai < 2; ++ai) {
            float s[4] = {0.f, 0.f, 0.f, 0.f}, q[4] = {0.f, 0.f, 0.f, 0.f}; f32x2 sr[4];
#pragma unroll
            for (int m = 0; m < 4; ++m) sr[m] = S[ai * HALF + wr * 64 + m * 16 + fr];
#pragma unroll
            for (int bj = 0; bj < 2; ++bj) {
                const int k = ai * 2 + bj, buf = k & 1;
#pragma unroll
                for (int m = 0; m < 4; ++m) { const size_t cofs = (size_t)(((ai * HALF + m * 16) * D + bj * HALF) * 2);
                    f32x4 a0, a1; PG8_UNPACK8(aw[buf][m], a0, a1);
                    const float nmr = -sr[m].x * sr[m].y; const f32x4 x0 = fma4(a0, sr[m].y, nmr) * gv[bj][0] + bv[bj][0], x1 = fma4(a1, sr[m].y, nmr) * gv[bj][1] + bv[bj][1];
                    const f32x4 y0 = x0 * alpha + acc[ai][bj][m][0], y1 = x1 * alpha + acc[ai][bj][m][1];
                    u32x4 w; PG8_PACK8(w, y0, y1); *(u32x4*)(((char*)yb + cofs) + (size_t)eb0) = w;
                    PG8_ROWSUM(s[m], q[m], y0); PG8_ROWSUM(s[m], q[m], y1); }
                if (k < 2) PG8_Y2_LOAD(buf, k + 2);
            }
#pragma unroll
            for (int m = 0; m < 4; ++m) { float ss = s[m], qq = q[m]; ss += shx(ss, 16, ln_); qq += shx(qq, 16, ln_); ss += shx(ss, 32, ln_); qq += shx(qq, 32, ln_);
                if (fq == 0) P[(ai * HALF + wr * 64 + m * 16 + fr) * 4 + wc] = (f32x2){ss, qq}; }
        }
#undef PG8_Y2_LOAD
        partials_to_st(st2, u, xl, wid0);
    }
};
struct EpiPLE {
    static constexpr bool PERM = true, AFTER_DRAIN = false;
    const bf16_t* y2b; float* out32; bf16_t* xb; const bf16_t* pp; const float* st2; const float* lng; const float* lnb; const float* cs; const float* bw; PG8_LAS unsigned char* xl; float eps; int wid0; mutable int last_pm = -1;
    __device__ __forceinline__ void operator()(const f32x4 (&acc)[2][2][4][2], const Unit& u, int, int, int, int) const {
        const LaneId L_ = lane_id(wid0); const int wr = L_.wr, wc = L_.wc, fr = L_.fr, fq = L_.fq;
        const int row0 = u.pm * BM + wr * 64 + fr, col0 = u.pn * BM + wc * 32 + 8 * fq;
        const unsigned eb0 = (unsigned)(row0 * D + col0) * 2u;
        u32x4 aw[2][2], pw[2][2];
#define PLE_LOAD(hb_) do { const int bj_ = (hb_) >> 2, ai_ = ((hb_) >> 1) & 1, mh_ = (hb_) & 1; _Pragma("unroll") for (int r_ = 0; r_ < 2; ++r_) { const size_t co_ = (size_t)((ai_ * HALF + (2 * mh_ + r_) * 16) * D + bj_ * HALF) * 2; \
            aw[(hb_) & 1][r_] = *(const u32x4*)(((const char*)y2b + co_) + (size_t)eb0); pw[(hb_) & 1][r_] = *(const u32x4*)(((const char*)pp + co_) + (size_t)eb0); } } while (0)
        PLE_LOAD(0);
        if (u.pm != last_pm) { stab_from_partials(st2, u.pm, xl, eps, wid0); last_pm = u.pm; }
        const PG8_LAS f32x2* S = (const PG8_LAS f32x2*)(xl + (STAB_OFF - RING_BYTES));
#pragma unroll
        for (int bj = 0; bj < 2; ++bj) {
            f32x4 gv[2], bv[2], csv[2], bwv[2];
#pragma unroll
            for (int n = 0; n < 2; ++n) { const int c = col0 + bj * HALF + 4 * n; gv[n] = *(const f32x4*)(lng + c); bv[n] = *(const f32x4*)(lnb + c); csv[n] = *(const f32x4*)(cs + c); bwv[n] = *(const f32x4*)(bw + c); }
#pragma unroll
            for (int ai = 0; ai < 2; ++ai) {
#pragma unroll
                for (int mh = 0; mh < 2; ++mh) {
                    const int hb = bj * 4 + ai * 2 + mh;
                    if (hb < 7) PLE_LOAD(hb + 1);
#pragma unroll
                    for (int r = 0; r < 2; ++r) {
                        const int m = 2 * mh + r, rl = ai * HALF + wr * 64 + m * 16 + fr; const size_t co = (size_t)((ai * HALF + m * 16) * D + bj * HALF); const f32x2 sr = S[rl];
                        f32x4 a0, a1, p0, p1; PG8_UNPACK8(aw[hb & 1][r], a0, a1); PG8_UNPACK8(pw[hb & 1][r], p0, p1);
                        const float nmr = -sr.x * sr.y; const f32x4 x0 = fma4(a0, sr.y, nmr) * gv[0] + bv[0], x1 = fma4(a1, sr.y, nmr) * gv[1] + bv[1];
                        const f32x4 t0 = acc[ai][bj][m][0] * sr.y + (csv[0] * nmr + bwv[0]), t1 = acc[ai][bj][m][1] * sr.y + (csv[1] * nmr + bwv[1]);
                        const f32x4 o0 = x0 + sigmoid4(t0) * p0, o1 = x1 + sigmoid4(t1) * p1;
                        if (out32) { float* op = (float*)(((char*)out32 + co * 4) + (size_t)eb0 * 2); *(f32x4*)op = o0; *(f32x4*)(op + 4) = o1; }
                        else { u32x4 w; PG8_PACK8(w, o0, o1); *(u32x4*)(((char*)xb + co * 2) + (size_t)eb0) = w; }
                    }
                    asm volatile("" ::: "memory");
                }
            }
        }
#undef PLE_LOAD
    }
};
}
namespace pg8 {
template <class Epi, class Sched, bool ALIGN_EPI = false, bool SP2 = false>
__device__ __forceinline__ void gemm_phase(PG8_LAS unsigned char* lds, const Gemm g, const Sched& S, const Epi& E) {
    int wid_ = g.wid0; asm volatile("" : "+s"(wid_));     const int tid = opaque_tid(wid_), wid = wid_, lane = tid & 63, wr = wid >> 2, wc = wid & 3, fr = lane & 15, fq = lane >> 4;
    const int K = g.K, nt = K / BK;
    unsigned voffA[2], voffB[2];
#pragma unroll
    for (int i = 0; i < 2; ++i) { int R, C; stage_rc(tid * 16 + i * 8192, R, C); const int Rb = Epi::PERM ? ((R & ~31) + perm32(R & 31)) : R;
        voffA[i] = (unsigned)(R * K + C) * 2u; voffB[i] = (unsigned)(Rb * K + C) * 2u; }
    const size_t kstep = (size_t)(BK * 2);
    const size_t hstep = (size_t)HALF * K * 2;
    const size_t tstep = 2 * hstep;
    const unsigned ldsw = (unsigned)wid * 1024u;
    const int aoff = lds_byte(wr * 64 + fr, fq * 8), boff = lds_byte(wc * 32 + fr, fq * 8);
#define PG8_SA(b, h) (((b) * 2 + (h)) * HTB)
#define PG8_SB(b, h) ((4 + (b) * 2 + (h)) * HTB)
#define PG8_STAGE(bufoff, gbase, voff) do { _Pragma("unroll") for (int _i = 0; _i < 2; ++_i) \
        __builtin_amdgcn_global_load_lds((const unsigned*)((const char*)(gbase) + (voff)[_i]), (PG8_LAS unsigned*)(lds + (bufoff) + ldsw + _i * 8192), 16, 0, 0); } while (0)
#define PG8_LDA(dst, b, h) do { _Pragma("unroll") for (int m = 0; m < 4; ++m) _Pragma("unroll") for (int k = 0; k < 2; ++k) dst[m][k] = *(const PG8_LAS bf16x8*)(lds + PG8_SA(b, h) + aoff + m * 2048 + k * 1024); } while (0)
#define PG8_LDB(dst, b, h) do { _Pragma("unroll") for (int n = 0; n < 2; ++n) _Pragma("unroll") for (int k = 0; k < 2; ++k) dst[n][k] = *(const PG8_LAS bf16x8*)(lds + PG8_SB(b, h) + boff + n * 2048 + k * 1024); } while (0)
#define PG8_MMA(ai, bj, At, Bt) do { __builtin_amdgcn_s_setprio(1); _Pragma("unroll") for (int m = 0; m < 4; ++m) _Pragma("unroll") for (int n = 0; n < 2; ++n) _Pragma("unroll") for (int k = 0; k < 2; ++k) \
        acc[ai][bj][m][n] = PG8_MFMA16(Bt[n][k], At[m][k], acc[ai][bj][m][n]); __builtin_amdgcn_s_setprio(0); } while (0)
#define PG8_WAIT_V(n) asm volatile("s_waitcnt vmcnt(" #n ")" ::: "memory")
#define PG8_WAIT_L(n) asm volatile("s_waitcnt lgkmcnt(" #n ")" ::: "memory")
#define PG8_BAR __builtin_amdgcn_s_barrier()
#define PG8_SCHED __builtin_amdgcn_sched_barrier(0)
    Unit cur, nxt; int ui = 0;
    float z0_ = 0.f; asm volatile("" : "+v"(z0_));
    if (!S.next(0, cur)) return;
    f32x4 acc[2][2][4][2];
#pragma unroll
    for (int a = 0; a < 2; ++a)
#pragma unroll
        for (int b = 0; b < 2; ++b)
#pragma unroll
            for (int m = 0; m < 4; ++m)
#pragma unroll
                for (int n = 0; n < 2; ++n) acc[a][b][m][n] = (f32x4){z0_, z0_, z0_, z0_};
    bf16x8 At[4][2], B0[2][2], B1[2][2];
    const char* cA = (const char*)g.A + (size_t)cur.pm * tstep; const char* cB = (const char*)g.Bt + (size_t)cur.pn * tstep;
    S.a_ready(cur);
    if constexpr (SP2) {
        PG8_STAGE(PG8_SB(0, 0), cB, voffB); PG8_STAGE(PG8_SB(0, 1), cB + hstep, voffB); PG8_STAGE(PG8_SA(0, 0), cA, voffA); PG8_STAGE(PG8_SA(0, 1), cA + hstep, voffA);
        if (wr == 1) PG8_BAR;
        PG8_WAIT_V(2); PG8_BAR;
        PG8_STAGE(PG8_SB(1, 0), cB + kstep, voffB); PG8_STAGE(PG8_SA(1, 0), cA + kstep, voffA); PG8_STAGE(PG8_SB(1, 1), cB + hstep + kstep, voffB);
        PG8_WAIT_V(6); PG8_BAR;
    } else {
        PG8_STAGE(PG8_SB(0, 0), cB, voffB); PG8_STAGE(PG8_SA(0, 0), cA, voffA); PG8_STAGE(PG8_SB(0, 1), cB + hstep, voffB); PG8_STAGE(PG8_SA(0, 1), cA + hstep, voffA);
        if (wr == 1) PG8_BAR;
        PG8_WAIT_V(4); PG8_BAR;
        PG8_STAGE(PG8_SB(1, 0), cB + kstep, voffB); PG8_STAGE(PG8_SA(1, 0), cA + kstep, voffA); PG8_STAGE(PG8_SB(1, 1), cB + hstep + kstep, voffB);
        PG8_WAIT_V(6); PG8_BAR;
    }
    for (;;) {
        const bool has_next = S.next(ui + 1, nxt);
        const char* nA = has_next ? (const char*)g.A + (size_t)nxt.pm * tstep : cA; const char* nB = has_next ? (const char*)g.Bt + (size_t)nxt.pn * tstep : cB;
        for (int t = 0; t < nt; t += 2) {
            const bool last = (t == nt - 2);
            const char* a1 = cA + (size_t)(t + 1) * kstep;
            const char* a2 = last ? nA : cA + (size_t)(t + 2) * kstep; const char* b2 = last ? nB : cB + (size_t)(t + 2) * kstep;
            const char* a3 = a2 + kstep; const char* b3 = b2 + kstep;
            if (last && has_next) S.a_ready(nxt);
            if constexpr (SP2) {
            PG8_LDB(B0, 0, 0); PG8_LDB(B1, 0, 1); PG8_SCHED; PG8_LDA(At, 0, 0); PG8_STAGE(PG8_SA(1, 1), a1 + hstep, voffA);
            PG8_WAIT_V(8); PG8_WAIT_L(0); PG8_BAR; PG8_MMA(0, 0, At, B0); PG8_MMA(0, 1, At, B1); PG8_BAR; PG8_SCHED;
            PG8_LDA(At, 0, 1); PG8_STAGE(PG8_SB(0, 0), b2, voffB); PG8_STAGE(PG8_SB(0, 1), b2 + hstep, voffB); PG8_STAGE(PG8_SA(0, 0), a2, voffA);
            PG8_WAIT_V(8); PG8_WAIT_L(0); PG8_BAR; PG8_MMA(1, 0, At, B0); PG8_MMA(1, 1, At, B1); PG8_BAR; PG8_SCHED;
            PG8_LDB(B0, 1, 0); PG8_LDB(B1, 1, 1); PG8_SCHED; PG8_LDA(At, 1, 0); PG8_STAGE(PG8_SA(0, 1), a2 + hstep, voffA);
            PG8_WAIT_V(8); PG8_WAIT_L(0); PG8_BAR; PG8_MMA(0, 0, At, B0); PG8_MMA(0, 1, At, B1); PG8_BAR; PG8_SCHED;
            PG8_LDA(At, 1, 1); PG8_STAGE(PG8_SB(1, 0), b3, voffB); PG8_STAGE(PG8_SB(1, 1), b3 + hstep, voffB); PG8_STAGE(PG8_SA(1, 0), a3, voffA);
            PG8_WAIT_V(8); PG8_WAIT_L(0); PG8_BAR; PG8_MMA(1, 0, At, B0); PG8_MMA(1, 1, At, B1); PG8_BAR; PG8_SCHED;
            } else {
            PG8_LDB(B0, 0, 0); PG8_SCHED; PG8_LDA(At, 0, 0); PG8_STAGE(PG8_SA(1, 1), a1 + hstep, voffA);
            PG8_WAIT_L(8); PG8_BAR; PG8_WAIT_L(0); PG8_MMA(0, 0, At, B0); PG8_BAR; PG8_SCHED;
            PG8_LDB(B1, 0, 1); PG8_STAGE(PG8_SB(0, 0), b2, voffB);
            PG8_BAR; PG8_WAIT_L(0); PG8_MMA(0, 1, At, B1); PG8_BAR;
            PG8_LDA(At, 0, 1); PG8_STAGE(PG8_SA(0, 0), a2, voffA);
            PG8_BAR; PG8_WAIT_L(0); PG8_MMA(1, 0, At, B0); PG8_BAR; PG8_SCHED;
            PG8_STAGE(PG8_SB(0, 1), b2 + hstep, voffB);
            PG8_WAIT_V(6); PG8_BAR; PG8_MMA(1, 1, At, B1); PG8_BAR;
            PG8_LDB(B0, 1, 0); PG8_SCHED; PG8_LDA(At, 1, 0); PG8_STAGE(PG8_SA(0, 1), a2 + hstep, voffA);
            PG8_WAIT_L(8); PG8_BAR; PG8_WAIT_L(0); PG8_MMA(0, 0, At, B0); PG8_BAR; PG8_SCHED;
            PG8_LDB(B1, 1, 1); PG8_STAGE(PG8_SB(1, 0), b3, voffB);
            PG8_BAR; PG8_WAIT_L(0); PG8_MMA(0, 1, At, B1); PG8_BAR;
            PG8_LDA(At, 1, 1); PG8_STAGE(PG8_SA(1, 0), a3, voffA);
            PG8_BAR; PG8_WAIT_L(0); PG8_MMA(1, 0, At, B0); PG8_BAR; PG8_SCHED;
            PG8_STAGE(PG8_SB(1, 1), b3 + hstep, voffB);
            PG8_WAIT_V(6); PG8_BAR; PG8_MMA(1, 1, At, B1); PG8_BAR;
            }
        }
        if constexpr (ALIGN_EPI) { if (wr == 0) PG8_BAR; }
        if constexpr (!Epi::AFTER_DRAIN) { S.epi_gate(ui); E(acc, cur, wr, wc, fr, fq); S.done(cur); }
        if (!has_next) break;
#pragma unroll
        for (int a = 0; a < 2; ++a)
#pragma unroll
            for (int b = 0; b < 2; ++b)
#pragma unroll
                for (int m = 0; m < 4; ++m)
#pragma unroll
                    for (int n = 0; n < 2; ++n) acc[a][b][m][n] = (f32x4){z0_, z0_, z0_, z0_};
        cur = nxt; cA = nA; cB = nB; ++ui;
        if constexpr (ALIGN_EPI) { if (wr == 1) PG8_BAR; }
    }
    PG8_WAIT_V(0);
    if constexpr (!ALIGN_EPI) { if (wr == 0) PG8_BAR; }
    PG8_BAR;
    if constexpr (Epi::AFTER_DRAIN) { E.fused(acc, cur, wr, wc, fr, fq, lds, wid, lane); S.done(cur); }
#undef PG8_SA
#undef PG8_SB
#undef PG8_STAGE
#undef PG8_LDA
#undef PG8_LDB
#undef PG8_MMA
#undef PG8_WAIT_V
#undef PG8_WAIT_L
#undef PG8_BAR
#undef PG8_SCHED
}
}
#define XB_TMO      128
#define XB_XCNT(j)  (256  + 64 * (j))
#define XB_XSUB(j)  (1280 + 64 * (j))
#define XB_XGEN(j)  (2304 + 64 * (j))
#define XB_TOP      3328
#define XB_TOPGEN   3392
#define XB_TOPS     3456
#define XCD_BAR_WORDS 3520
#define XB_SPIN_CAP (1u << 18)
#ifndef PROBE_FORCE_FULL
#define PROBE_FORCE_FULL 0
#endif

__device__ __forceinline__ unsigned xb_ld(unsigned* p)              { return __hip_atomic_load(p, __ATOMIC_RELAXED, __HIP_MEMORY_SCOPE_AGENT); }
__device__ __forceinline__ unsigned xb_add(unsigned* p, unsigned v) { return __hip_atomic_fetch_add(p, v, __ATOMIC_RELAXED, __HIP_MEMORY_SCOPE_AGENT); }
__device__ __forceinline__ unsigned xb_xcc_id() { return (unsigned)__builtin_amdgcn_s_getreg((3 << 11) | 20) & 0xFu; }
#define XB_SPIN(cond, bar) do { unsigned _sp = 0; while (cond) { __builtin_amdgcn_s_sleep(1); \
    if ((++_sp & 255u) == 0u) { if (xb_ld(&(bar)[XB_TMO])) break; if (_sp > XB_SPIN_CAP) { atomicAdd(&(bar)[XB_TMO], 1u); break; } } } } while (0)

struct XcdBarrier {
    int wid0;
    unsigned* bar; unsigned x;
    volatile LAS unsigned* st;
};

__device__ __forceinline__ XcdBarrier xcd_barrier_post(unsigned* bar, volatile LAS unsigned* st) {
    XcdBarrier b; b.bar = bar; b.x = xb_xcc_id(); b.st = st;
    if (threadIdx.x == 0) st[4] = xb_add(&bar[XB_XCNT(b.x)], 1u);
    return b;
}
__device__ __forceinline__ void xcd_barrier_complete(unsigned* bar, unsigned x, unsigned& nloc, unsigned& nx, unsigned& uni, unsigned& xv) {
    const unsigned G = gridDim.x * gridDim.y * gridDim.z;
    unsigned sum, cnt, mine, below, odd, sp = 0u;
    for (;;) {
        sum = 0u; cnt = 0u; mine = 0u; below = 0u; odd = 0u;
#pragma unroll
        for (unsigned j = 0; j < 16; ++j) { const unsigned c = xb_ld(&bar[XB_XCNT(j)]); sum += c; cnt += (c > 0u) ? 1u : 0u; mine = (j == x) ? c : mine; below += (c > 0u && j < x) ? 1u : 0u; odd += (c > 0u && c * 8u != G) ? 1u : 0u; }
        if (sum == G) break;
        __builtin_amdgcn_s_sleep(1);
        if ((++sp & 255u) == 0u) { if (xb_ld(&bar[XB_TMO])) break; if (sp > XB_SPIN_CAP) { atomicAdd(&bar[XB_TMO], 1u); break; } }
    }
    nloc = mine > 0u ? mine : 1u; nx = cnt > 0u ? cnt : 1u;
    uni = (sum == G && cnt == 8u && odd == 0u && !PROBE_FORCE_FULL) ? 1u : 0u; xv = below;
}

__device__ __forceinline__ void xcd_barrier(const XcdBarrier& b) {
    asm volatile("s_waitcnt vmcnt(0)" ::: "memory");
    __syncthreads();
    if (opaque_tid(b.wid0) == 0) {
        unsigned* bar = b.bar;
        __builtin_amdgcn_s_waitcnt(0);
        unsigned nloc = b.st[0], nx = b.st[1];
        if (nloc == 0u) { unsigned uni, xv; xcd_barrier_complete(bar, b.x, nloc, nx, uni, xv); b.st[0] = nloc; b.st[1] = nx; b.st[2] = uni; b.st[3] = xv; }
        const unsigned old = xb_add(&bar[XB_XSUB(b.x)], 1u);
        const unsigned gen = old / nloc;
        if (old + 1u == (gen + 1u) * nloc) {
            __builtin_amdgcn_fence(__ATOMIC_RELEASE, "agent");
            asm volatile("s_waitcnt vmcnt(0)" ::: "memory");
            const unsigned og = xb_add(&bar[XB_TOP], 1u);
            const unsigned tg = og / nx;
            if (og + 1u == (tg + 1u) * nx) xb_add(&bar[XB_TOPGEN], 1u);
#if PROBE_STAMP == 7 || PROBE_STAMP == 8
            else { const unsigned long long tq0_ = __builtin_amdgcn_s_memrealtime(); XB_SPIN(xb_ld(&bar[XB_TOPGEN]) == tg, bar); atomicAdd((unsigned long long*)bar + 4096 + 1 + b.x, __builtin_amdgcn_s_memrealtime() - tq0_); }
#else
            else XB_SPIN(xb_ld(&bar[XB_TOPGEN]) == tg, bar);
#endif
            __builtin_amdgcn_fence(__ATOMIC_ACQUIRE, "agent");
            xb_add(&bar[XB_XGEN(b.x)], 1u);
            asm volatile("s_waitcnt vmcnt(0)" ::: "memory");
        } else {
            XB_SPIN(xb_ld(&bar[XB_XGEN(b.x)]) == gen, bar);
            __builtin_amdgcn_fence(__ATOMIC_ACQUIRE, "agent");
            asm volatile("s_waitcnt vmcnt(0)" ::: "memory");
        }
    }
    __syncthreads();
}

__device__ __forceinline__ void xcd_seam_local(const XcdBarrier& b, const bool wb) {
    asm volatile("s_waitcnt vmcnt(0)" ::: "memory");
    __syncthreads();
    if (opaque_tid(b.wid0) == 0) {
        unsigned* bar = b.bar;
        __builtin_amdgcn_s_waitcnt(0);
        const unsigned nloc = b.st[0];
        const unsigned old = xb_add(&bar[XB_XSUB(b.x)], 1u);
        const unsigned gen = old / nloc;
        if (old + 1u == (gen + 1u) * nloc) {
            xb_add(&bar[XB_XGEN(b.x)], 1u);
            if (wb) {
            __builtin_amdgcn_fence(__ATOMIC_RELEASE, "agent");
            asm volatile("s_waitcnt vmcnt(0)" ::: "memory");
            }
            xb_add(&bar[XB_TOPS], 1u);
        }
        else XB_SPIN(xb_ld(&bar[XB_XGEN(b.x)]) == gen, bar);
        __builtin_amdgcn_fence(__ATOMIC_ACQUIRE, "agent");
        asm volatile("s_waitcnt vmcnt(0)" ::: "memory");
    }
    __syncthreads();
}
__device__ __forceinline__ void xcd_gate(unsigned* tops, unsigned target) {
    unsigned sp = 0u;
    while (xb_ld(tops) < target) { __builtin_amdgcn_s_sleep(1); if (++sp > XB_SPIN_CAP) break; }
    asm volatile("" ::: "memory");
}

__device__ const float kInvFreq[16] = {1.000000000e+00f, 4.403665960e-01f, 1.939227432e-01f, 8.539710194e-02f, 3.760603070e-02f, 1.656044088e-02f, 7.292664610e-03f, 3.211446106e-03f,
                                       1.414213562e-03f, 6.227724371e-04f, 2.742481884e-04f, 1.207697351e-04f, 5.318295734e-05f, 2.341999971e-05f, 1.031338525e-05f, 4.541670478e-06f};

__device__ __forceinline__ void sincos_f64(float angf, float& so, float& co) {
    const double a = (double)angf;
    const double k = __builtin_rint(a * 0.63661977236758134308);
    const double r = __builtin_fma(-k, 6.123233995736766e-17, __builtin_fma(-k, 1.5707963267948966, a));
    const double r2 = r * r;
    double s = -7.6471637318198164759e-13; s = s * r2 + 1.6059043836821614599e-10; s = s * r2 - 2.5052108385441718775e-8; s = s * r2 + 2.7557319223985890653e-6;
    s = s * r2 - 1.9841269841269841270e-4; s = s * r2 + 8.3333333333333333333e-3; s = s * r2 - 1.6666666666666666667e-1; s = s * r2 * r + r;
    double c = 4.7794773323873852974e-14; c = c * r2 - 1.1470745597729724714e-11; c = c * r2 + 2.0876756987868098979e-9; c = c * r2 - 2.7557319223985890653e-7;
    c = c * r2 + 2.4801587301587301587e-5; c = c * r2 - 1.3888888888888888889e-3; c = c * r2 + 4.1666666666666666667e-2; c = c * r2 - 0.5; c = c * r2 + 1.0;
    const int q = (int)((long long)k & 3);
    const double sv = (q == 0) ? s : (q == 1) ? c : (q == 2) ? -s : -c;
    const double cv = (q == 0) ? c : (q == 1) ? -s : (q == 2) ? -c : s;
    so = (float)sv; co = (float)cv;
}

#ifndef W8BIT
#define W8BIT 0
#endif
#if W8BIT
__device__ __forceinline__ float WQ(float f) { unsigned u = __builtin_bit_cast(unsigned, f); u = (u + 0x7fffu + ((u >> 16) & 1u)) & 0xffff0000u; return __builtin_bit_cast(float, u); }
#else
#define WQ(x) (x)
#endif
struct TJob { const float* W; int K, N; bf16* WT; int mode; const float* g; const float* b; float* pcs; float* pbw; };
__device__ __forceinline__ void tr_item(const TJob& J, LAS float* scr, int item, int lane) {
    const int nblk = J.N / 32, kb = item / nblk, nb = item - kb * nblk, k0 = 64 * kb, n0 = 32 * nb;
#pragma unroll 8
    for (int i = 0; i < 32; ++i) { const int kk = 2 * i + (lane >> 5); scr[kk * 33 + (lane & 31)] = J.W[(size_t)(k0 + kk) * J.N + n0 + (lane & 31)]; }
    LDS_WAIT(); asm volatile("" ::: "memory");
    int drow0 = n0;
    if (J.mode == 2) { const int isup = n0 >= FF ? 1 : 0, hc = n0 - isup * FF; drow0 = 256 * (hc >> 7) + 128 * isup + (hc & 127); }
    const int c = lane & 7;
    float gk[8];
#pragma unroll
    for (int j = 0; j < 8; ++j) gk[j] = J.mode ? J.g[k0 + 8 * c + j] : 1.0f;
#pragma unroll
    for (int j = 0; j < 4; ++j) { const int n = (lane >> 3) + 8 * j; const LAS float* s = scr + (8 * c) * 33 + n;
        v4u o; o.x = pk2(WQ(s[0 * 33] * gk[0]), WQ(s[1 * 33] * gk[1])); o.y = pk2(WQ(s[2 * 33] * gk[2]), WQ(s[3 * 33] * gk[3])); o.z = pk2(WQ(s[4 * 33] * gk[4]), WQ(s[5 * 33] * gk[5])); o.w = pk2(WQ(s[6 * 33] * gk[6]), WQ(s[7 * 33] * gk[7]));
        *(GAS v4u*)(J.WT + (size_t)(drow0 + n) * J.K + k0 + 8 * c) = o; }
    if (J.mode) {
        float cs = 0.f, bw = 0.f; const int kh = (lane >> 5) * 32;
#pragma unroll 8
        for (int t = 0; t < 32; ++t) { const int kk = kh + t; const float w = scr[kk * 33 + (lane & 31)]; cs += bf_round(WQ(w * J.g[k0 + kk])); bw += w * J.b[k0 + kk]; }
        cs += shx(cs, 32, lane); bw += shx(bw, 32, lane);
        if (lane < 32) { J.pcs[(size_t)kb * J.N + drow0 + lane] = cs; J.pbw[(size_t)kb * J.N + drow0 + lane] = bw; }
    }
    LDS_WAIT(); asm volatile("" ::: "memory");
}

struct Args { const float* in[20]; float* out; unsigned char* ws; int ph_lo, ph_hi; };
#define CAS __attribute__((address_space(4)))
__device__ __forceinline__ const unsigned char CAS* kargs_() { const unsigned char CAS* p = (const unsigned char CAS*)__builtin_amdgcn_kernarg_segment_ptr(); asm volatile("" : "+s"(p)); return p; }
__device__ __forceinline__ const float* arg_in(int i) { return (const float*)(const GAS float*)*(const float* const CAS*)(kargs_() + 8 * i); }
__device__ __forceinline__ float* arg_out() { return (float*)(GAS float*)*(float* const CAS*)(kargs_() + 160); }
__device__ __forceinline__ unsigned char* arg_ws() { return (unsigned char*)(GAS unsigned char*)*(unsigned char* const CAS*)(kargs_() + 168); }
static_assert(sizeof(Args) == 184, "Args layout");

__device__ __forceinline__ TJob make_job(int id) {
    unsigned char* ws = arg_ws(); float* part = (float*)(ws + WS_PART);
    TJob J; J.mode = 0; J.g = nullptr; J.b = nullptr; J.pcs = nullptr; J.pbw = nullptr;
    switch (id) {
    case 0: J.W = arg_in(4); J.K = D; J.N = HW; J.WT = (bf16*)(ws + WS_W_IN); break;
    case 1: J.W = arg_in(9); J.K = D; J.N = D; J.WT = (bf16*)(ws + WS_W_OA); break;
    case 2: J.W = arg_in(10); J.K = D; J.N = NQKV; J.WT = (bf16*)(ws + WS_W_QKV); break;
    case 3: J.W = arg_in(11); J.K = AW; J.N = D; J.WT = (bf16*)(ws + WS_W_OB); break;
    case 4: case 5: { const int l = id - 4; J.W = arg_in(14) + (size_t)l * D * NGU; J.K = D; J.N = NGU; J.WT = (bf16*)(ws + WS_W_GU + l * W_GU_STRIDE); J.mode = 2;
        J.g = arg_in(12) + l * D; J.b = arg_in(13) + l * D; J.pcs = part + PART_GU + l * PART_GU_L; J.pbw = J.pcs + (size_t)KB32 * NGU; break; }
    case 6: case 7: { const int l = id - 6; J.W = arg_in(15) + (size_t)l * FF * D; J.K = FF; J.N = D; J.WT = (bf16*)(ws + WS_W_DN + l * W_DN_STRIDE); break; }
    case 8: case 9: { const int l = id - 8; J.W = arg_in(18) + (size_t)l * D * D; J.K = D; J.N = D; J.WT = (bf16*)(ws + WS_W_GT + l * W_GT_STRIDE); J.mode = 1;
        J.g = arg_in(16) + l * D; J.b = arg_in(17) + l * D; J.pcs = part + PART_GT + l * PART_GT_L; J.pbw = J.pcs + (size_t)KB32 * D; break; }
    default: { const int l = id - 10; J.W = arg_in(19) + (size_t)l * PLE * D; J.K = PLE; J.N = D; J.WT = (bf16*)(ws + WS_W_PJ + l * W_PJ_STRIDE); break; }
    }
    return J;
}
__device__ __forceinline__ int job_items(int id) {
    switch (id) { case 0: return (D / 64) * (HW / 32); case 1: return (D / 64) * (D / 32); case 2: return (D / 64) * (NQKV / 32); case 3: return (AW / 64) * (D / 32);
        case 4: case 5: return (D / 64) * (NGU / 32); case 6: case 7: return (FF / 64) * (D / 32); case 8: case 9: return (D / 64) * (D / 32); default: return (PLE / 64) * (D / 32); }
}

__device__ __forceinline__ void conv_bf16(const float* src, bf16* dst, size_t n8, size_t gt, size_t nthr) {
    for (size_t i = gt; i < n8; i += nthr) {
        const f32x4 a = *(const GAS f32x4*)(src + 8 * i), b = *(const GAS f32x4*)(src + 8 * i + 4);
        v4u o; o.x = pk2(a[0], a[1]); o.y = pk2(a[2], a[3]); o.z = pk2(b[0], b[1]); o.w = pk2(b[2], b[3]);
        *(GAS v4u*)(dst + 8 * i) = o;
    }
}

__device__ __forceinline__ void prologue_phase(LAS unsigned char* lds, int G, int wid0) {
    const int tid = opaque_tid(wid0), lane = tid & 63, wave = tid >> 6;
    LAS float* scr = (LAS float*)(lds + wave * 16384);
    const int gw = blockIdx.x * NWAVES + wave, NGW = G * NWAVES;
#pragma unroll 1
    for (int id = 0; id < 12; ++id) {
        const TJob J = make_job(id); const int ni = job_items(id);
#pragma unroll 1
        for (int it = gw; it < ni; it += NGW) tr_item(J, scr, it, lane);
    }
    const size_t gt = (size_t)blockIdx.x * 512 + tid, nthr = (size_t)G * 512;
    conv_bf16(arg_in(7), (bf16*)(arg_ws() + WS_W_S), (size_t)16 * 128 * 128 / 8, gt, nthr);
    float* rot = (float*)(arg_ws() + WS_ROT);
    for (size_t i = gt; i < (size_t)16384 * 16; i += nthr) { const int pos = (int)(i >> 4), f = (int)(i & 15); float s, c; sincos_f64((float)pos * kInvFreq[f], s, c); rot[pos * 32 + f] = c; rot[pos * 32 + 16 + f] = s; }
}
__device__ __forceinline__ void finalize_vecs(int G, int wid0) {
    const float* part = (const float*)(arg_ws() + WS_PART); float* vec = (float*)(arg_ws() + WS_VEC);
    const int gt = blockIdx.x * 512 + opaque_tid(wid0), nthr = G * 512;
    for (int i = gt; i < 2 * 2 * NGU; i += nthr) {
        const float* p = part + PART_GU + (size_t)(i / NGU) * KB32 * NGU + (i % NGU); float s = 0.f;
        for (int kb = 0; kb < KB32; ++kb) s += p[(size_t)kb * NGU];
        vec[VEC_GU + i] = s;
    }
    for (int i = gt; i < 2 * 2 * D; i += nthr) {
        const float* p = part + PART_GT + (size_t)(i / D) * KB32 * D + (i % D); float s = 0.f;
        for (int kb = 0; kb < KB32; ++kb) s += p[(size_t)kb * D];
        vec[VEC_GT + i] = s;
    }
}

__device__ __forceinline__ void sgu_phase(LAS unsigned char* lds, const bf16* H, bf16* GATED, const bf16* WS, const float* bs, const float* lng, const float* lnb, const float* stv, int G, int slot, int wid0) {
    const int tid = opaque_tid(wid0), lane = tid & 63, wave = tid >> 6, i16 = lane & 15, kq = lane >> 4;
    LAS f32x2v* SV = (LAS f32x2v*)(lds + STAB_OFF);
    LAS float* LG = (LAS float*)(lds + 65536); LAS float* LB = LG + D;
    for (int i = tid; i < D; i += 512) { LG[i] = lng[i]; LB[i] = lnb[i]; }
#pragma unroll 1
    for (int chunk = slot; chunk < MG / 128; chunk += G) {
        const size_t row0 = (size_t)chunk * 128;
        if (tid < 128) {
            const f32x4* pq = (const f32x4*)(stv + (row0 + tid) * 16);
            const f32x4 a = pq[0], b = pq[1], c = pq[2], d = pq[3];
            const float S_ = ((a[0] + a[2]) + (b[0] + b[2])) + ((c[0] + c[2]) + (d[0] + d[2]));
            const float Q_ = ((a[1] + a[3]) + (b[1] + b[3])) + ((c[1] + c[3]) + (d[1] + d[3]));
            const float mean = S_ * (1.0f / D); float var = Q_ * (1.0f / D) - mean * mean; var = var < 0.f ? 0.f : var;
            SV[tid] = (f32x2v){mean, 1.0f / sqrtf(var + LN_EPS)};
        }
        const int p = 16 * wave + i16;
        v4u vt[4];
#define SGU_VLOAD(g_) do { _Pragma("unroll") for (int n = 0; n < 4; ++n) { const int id = tid + 512 * n, q = id >> 4, ch = id & 15; vt[n] = *(const GAS v4u*)(H + (row0 + q) * HW + D + (g_) * 128 + ch * 8); } } while (0)
        SGU_VLOAD(0);
        bf16x8 wfn[4]; float biasn = bs[p];
#pragma unroll
        for (int s = 0; s < 4; ++s) wfn[s] = *(const GAS bf16x8*)(WS + ((size_t)p) * 128 + 32 * s + 8 * kq);
        v4u uwn[4];
#pragma unroll
        for (int cp = 0; cp < 4; ++cp) uwn[cp] = *(const GAS v4u*)(H + (row0 + p) * HW + 32 * cp + 8 * kq);
        WG_BAR();
#pragma unroll 1
        for (int g = 0; g < 16; ++g) {
            LAS unsigned char* img = lds + (g & 1) * 32768;
#pragma unroll
            for (int n = 0; n < 4; ++n) {
                const int id = tid + 512 * n, q = id >> 4, ch = id & 15; const int c0 = g * 128 + ch * 8;
                const v4u d = vt[n];
                const f32x2v sr = SV[q];
                const f32x4 g0 = *(const LAS f32x4*)(LG + c0), g1 = *(const LAS f32x4*)(LG + c0 + 4), b0 = *(const LAS f32x4*)(LB + c0), b1 = *(const LAS f32x4*)(LB + c0 + 4);
                f32x4 x0, x1; x0[0] = bf_lo(d.x); x0[1] = bf_hi(d.x); x0[2] = bf_lo(d.y); x0[3] = bf_hi(d.y); x1[0] = bf_lo(d.z); x1[1] = bf_hi(d.z); x1[2] = bf_lo(d.w); x1[3] = bf_hi(d.w);
                x0 = ((x0 - sr.x) * sr.y) * g0 + b0; x1 = ((x1 - sr.x) * sr.y) * g1 + b1;
                v4u o; o.x = pk2(x0[0], x0[1]); o.y = pk2(x0[2], x0[3]); o.z = pk2(x1[0], x1[1]); o.w = pk2(x1[2], x1[3]);
                *(LAS v4u*)(img + off_b(q, ch)) = o;
            }
            bf16x8 wf[4];
#pragma unroll
            for (int s = 0; s < 4; ++s) wf[s] = wfn[s];
            const float bias = biasn;
            v4u uw[4];
#pragma unroll
            for (int cp = 0; cp < 4; ++cp) uw[cp] = uwn[cp];
            if (g < 15) { SGU_VLOAD(g + 1);
#pragma unroll
                for (int s = 0; s < 4; ++s) wfn[s] = *(const GAS bf16x8*)(WS + ((size_t)((g + 1) * 128 + p)) * 128 + 32 * s + 8 * kq);
                biasn = bs[(g + 1) * 128 + p];
#pragma unroll
                for (int cp = 0; cp < 4; ++cp) uwn[cp] = *(const GAS v4u*)(H + (row0 + p) * HW + (g + 1) * 128 + 32 * cp + 8 * kq); }
            WG_BAR();
            f32x4 acc[8];
#pragma unroll
            for (int ct = 0; ct < 8; ++ct) {
                f32x4 c4 = (f32x4){0.f, 0.f, 0.f, 0.f};
#pragma unroll
                for (int s = 0; s < 4; ++s) {
                    const unsigned qq = (unsigned)(i16 >> 2), pp = (unsigned)(lane & 3);
                    const s16x4 lo = tr_read(img + off_b(32 * s + 8 * kq + qq, 4 * (ct >> 1) + pp) + 8 * (ct & 1));
                    const s16x4 hi = tr_read(img + off_b(32 * s + 8 * kq + 4 + qq, 4 * (ct >> 1) + pp) + 8 * (ct & 1));
                    const bf16x8 af = __builtin_shufflevector(lo, hi, 0, 1, 2, 3, 4, 5, 6, 7);
                    c4 = PG8_MFMA16(af, wf[s], c4);
                }
                acc[ct] = c4;
            }
#pragma unroll
            for (int cp = 0; cp < 4; ++cp) {
                const int c = g * 128 + 32 * cp + 8 * kq;
                const f32x4 a = acc[2 * cp], b = acc[2 * cp + 1];
                v4u ow;
                ow.x = pk2((a[0] + bias) * bf_lo(uw[cp].x), (a[1] + bias) * bf_hi(uw[cp].x)); ow.y = pk2((a[2] + bias) * bf_lo(uw[cp].y), (a[3] + bias) * bf_hi(uw[cp].y));
                ow.z = pk2((b[0] + bias) * bf_lo(uw[cp].z), (b[1] + bias) * bf_hi(uw[cp].z)); ow.w = pk2((b[2] + bias) * bf_lo(uw[cp].w), (b[3] + bias) * bf_hi(uw[cp].w));
                *(GAS v4u*)(GATED + (row0 + p) * D + c) = ow;
            }
        }
#undef SGU_VLOAD
        WG_BAR();
    }
}

struct AttnUnit { int g, h, dil, L, i0; size_t tok0; };
__device__ __forceinline__ AttnUnit attn_decode(int j, int xv, int S) {
    AttnUnit A; const int ltps = 24 - __builtin_clz((unsigned)S);
    A.g = j >> 8; const int rem = j & 255; A.h = (rem >> 3) & 7; const int ls = (rem & 7) | ((rem >> 6) << 3);
    const int ldil = 2 * A.g; A.dil = 1 << ldil; A.L = S >> ldil;
    int b, r, it;
    if (ltps <= 5) { b = (xv << (5 - ltps)) + (ls >> ltps); const int wslot = ls & ((1 << ltps) - 1), ltpr = ltps - ldil; r = wslot >> ltpr; it = wslot & ((1 << ltpr) - 1); }
    else { const int lq = ltps - 5, ltq = 5 - ldil; b = xv >> lq; const int q = xv & ((1 << lq) - 1); r = ls >> ltq; it = (q << ltq) + (ls & ((1 << ltq) - 1)); }
    A.i0 = it * 128;
    A.tok0 = (size_t)b * S + r;
    return A;
}
#define ATTN_KV_LOAD(A_) do { const int j0_ = (A_).i0 - 64 + (tid >> 4); \
    const bf16* Kp_ = QKV + (A_).g * 3072 + (A_).h * 128 + 1024 + ((A_).tok0 + (size_t)((long)j0_ * (A_).dil)) * NQKV + (tid & 15) * 8; const size_t rs_ = (size_t)32 * (A_).dil * NQKV;   \
    _Pragma("unroll") for (int n = 0; n < 8; ++n) { const int j = j0_ + 32 * n; \
        kreg[n] = (v4u){zz_, zz_, zz_, zz_}; vreg[n] = (v4u){zz_, zz_, zz_, zz_}; \
        if (j >= 0 && j < (A_).L) { kreg[n] = *(const GAS v4u*)(Kp_ + n * rs_); vreg[n] = *(const GAS v4u*)(Kp_ + n * rs_ + 1024); } } } while (0)
__device__ __forceinline__ void attn_phase(LAS unsigned char* lds, bf16* QKV, float* LSE, int S, int cv, bool dry, int wid0) {
    const int tid = opaque_tid(wid0), lane = tid & 63, wave = tid >> 6, iq = lane & 15, kq = lane >> 4;
    LAS unsigned char* Kimg = lds; LAS unsigned char* Vimg = lds + 65536;
    constexpr int NU = 3 * 8 * 32; const int xv = cv & 7;
    v4u kreg[8], vreg[8];
    unsigned zz_ = 0u; asm volatile("" : "+v"(zz_));
    int u = cv >> 3;
    bf16x8 qfn[4];
#define ATTN_Q_LOAD(A_) do { const size_t qt_ = (A_).tok0 + (size_t)((A_).i0 + 16 * wave + iq) * (A_).dil; const bf16* qb_ = QKV + (A_).g * 3072 + (A_).h * 128 + qt_ * NQKV + 8 * kq; \
    _Pragma("unroll") for (int s = 0; s < 4; ++s) qfn[s] = *(const GAS bf16x8*)(qb_ + 32 * s); } while (0)
    if (u < NU) { const AttnUnit A0 = attn_decode(u, xv, S); ATTN_KV_LOAD(A0); ATTN_Q_LOAD(A0); }
#pragma unroll 1
    while (u < NU) {
        const AttnUnit A = attn_decode(u, xv, S);
        const int g = A.g, h = A.h, dil = A.dil, L = A.L, i0 = A.i0; const size_t tok0 = A.tok0;
        bf16* Qb = QKV + g * 3072 + h * 128;
#pragma unroll
        for (int n = 0; n < 8; ++n) { const int id = tid + 512 * n, kl = id >> 4, ch = id & 15; *(LAS v4u*)(Kimg + off_b(kl, ch)) = kreg[n]; *(LAS v4u*)(Vimg + off_b(kl, ch)) = vreg[n]; }
        const int qi = i0 + 16 * wave + iq; const size_t qtok = tok0 + (size_t)qi * dil;
        bf16x8 qf[4];
#pragma unroll
        for (int s = 0; s < 4; ++s) qf[s] = qfn[s];
        WG_BAR();
        const int un = u + 32;
        if (un < NU) { const AttnUnit An = attn_decode(un, xv, S); ATTN_KV_LOAD(An); ATTN_Q_LOAD(An); }
        f32x4 st[9];
#pragma unroll
        for (int T = 0; T < 9; ++T) {
            f32x4 c4 = (f32x4){0.f, 0.f, 0.f, 0.f};
#pragma unroll
            for (int s = 0; s < 4; ++s) { const bf16x8 kf = *(const LAS bf16x8*)(Kimg + off_b(16 * wave + 16 * T + iq, 4 * s + kq)); c4 = PG8_MFMA16(kf, qf[s], c4); }
            st[T] = c4;
        }
#pragma unroll
        for (int e = 0; e < 4; ++e) { if (4 * kq + e - iq < 0) st[0][e] = -1.0e30f; if (4 * kq + e - iq > 0) st[8][e] = -1.0e30f; }
        if (i0 == 0 || i0 + 192 > L) {
#pragma unroll
            for (int T = 0; T < 9; ++T)
#pragma unroll
                for (int e = 0; e < 4; ++e) { const int j = i0 + 16 * wave - 64 + 16 * T + 4 * kq + e; if (j < 0 || j >= L) st[T][e] = -1.0e30f; }
        }
        float mx = -3.0e38f;
#pragma unroll
        for (int T = 0; T < 9; ++T)
#pragma unroll
            for (int e = 0; e < 4; ++e) mx = fmaxf(mx, st[T][e]);
        mx = fmaxf(mx, shx(mx, 16, lane)); mx = fmaxf(mx, shx(mx, 32, lane));
        float den = 0.f;
#pragma unroll
        for (int T = 0; T < 9; ++T)
#pragma unroll
            for (int e = 0; e < 4; ++e) { const float pv = fast_exp2(st[T][e] - mx); st[T][e] = pv; den += pv; }
        den += shx(den, 16, lane); den += shx(den, 32, lane);
        bf16x8 pf[5];
#pragma unroll
        for (int s2 = 0; s2 < 5; ++s2) {
            v4u w; w.x = pk2(st[2 * s2][0], st[2 * s2][1]); w.y = pk2(st[2 * s2][2], st[2 * s2][3]);
            if (s2 < 4) { w.z = pk2(st[2 * s2 + 1][0], st[2 * s2 + 1][1]); w.w = pk2(st[2 * s2 + 1][2], st[2 * s2 + 1][3]); } else { w.z = 0u; w.w = 0u; }
            pf[s2] = __builtin_bit_cast(bf16x8, w);
        }
        const float inv = 1.0f / den;
        const unsigned qq = (unsigned)(iq >> 2), pp = (unsigned)(lane & 3);
#pragma unroll
        for (int cp = 0; cp < 4; ++cp) {
            f32x4 oo[2];
#pragma unroll
            for (int hc = 0; hc < 2; ++hc) {
                f32x4 o4 = (f32x4){0.f, 0.f, 0.f, 0.f};
#pragma unroll
                for (int s2 = 0; s2 < 5; ++s2) {
                    unsigned r0 = 16 * wave + 32 * s2 + 4 * kq + qq, r1 = r0 + 16; r1 = r1 > 255u ? 255u : r1;
                    const s16x4 lo = tr_read(Vimg + off_b(r0, 4 * cp + pp) + 8 * hc);
                    const s16x4 hi = tr_read(Vimg + off_b(r1, 4 * cp + pp) + 8 * hc);
                    const bf16x8 vf = __builtin_shufflevector(lo, hi, 0, 1, 2, 3, 4, 5, 6, 7);
                    o4 = PG8_MFMA16(vf, pf[s2], o4);
                }
                oo[hc] = o4;
            }
            v4u ow; ow.x = pk2(oo[0][0] * inv, oo[0][1] * inv); ow.y = pk2(oo[0][2] * inv, oo[0][3] * inv); ow.z = pk2(oo[1][0] * inv, oo[1][1] * inv); ow.w = pk2(oo[1][2] * inv, oo[1][3] * inv);
            if (!dry) *(GAS v4u*)(Qb + qtok * NQKV + 32 * cp + 8 * kq) = ow;
        }
        if (kq == 0 && !dry) LSE[(qtok * 3 + g) * 8 + h] = (mx + __builtin_amdgcn_logf(den)) * LN2;
        WG_BAR();
        u = un;
    }
}
#undef ATTN_KV_LOAD
#undef ATTN_Q_LOAD
__device__ __forceinline__ void combine_phase(const bf16* QKV, const float* LSE, bf16* ATT, int slot, int wid0) {
    const int tid = opaque_tid(wid0), ch = tid & 127, h = ch >> 4;
#pragma unroll 1
    for (int it = 0; it < 8; ++it) {
        v4u a[4], b[4], c[4]; float l0[4], l1[4], l2[4];
#pragma unroll
        for (int k = 0; k < 4; ++k) { const size_t t = (size_t)slot * 128 + it * 16 + k * 4 + (tid >> 7);
            l0[k] = LSE[(t * 3 + 0) * 8 + h]; l1[k] = LSE[(t * 3 + 1) * 8 + h]; l2[k] = LSE[(t * 3 + 2) * 8 + h];
            a[k] = *(const GAS v4u*)(QKV + t * NQKV + ch * 8); b[k] = *(const GAS v4u*)(QKV + t * NQKV + 3072 + ch * 8); c[k] = *(const GAS v4u*)(QKV + t * NQKV + 6144 + ch * 8); }
#pragma unroll
        for (int k = 0; k < 4; ++k) { const size_t t = (size_t)slot * 128 + it * 16 + k * 4 + (tid >> 7);
            const float m = fmaxf(l0[k], fmaxf(l1[k], l2[k]));
            float w0 = fast_exp2((l0[k] - m) * 1.4426950408889634f), w1 = fast_exp2((l1[k] - m) * 1.4426950408889634f), w2 = fast_exp2((l2[k] - m) * 1.4426950408889634f);
            const float inv = 1.0f / (w0 + w1 + w2); w0 *= inv; w1 *= inv; w2 *= inv;
            v4u o;
            o.x = pk2(w0 * bf_lo(a[k].x) + w1 * bf_lo(b[k].x) + w2 * bf_lo(c[k].x), w0 * bf_hi(a[k].x) + w1 * bf_hi(b[k].x) + w2 * bf_hi(c[k].x));
            o.y = pk2(w0 * bf_lo(a[k].y) + w1 * bf_lo(b[k].y) + w2 * bf_lo(c[k].y), w0 * bf_hi(a[k].y) + w1 * bf_hi(b[k].y) + w2 * bf_hi(c[k].y));
            o.z = pk2(w0 * bf_lo(a[k].z) + w1 * bf_lo(b[k].z) + w2 * bf_lo(c[k].z), w0 * bf_hi(a[k].z) + w1 * bf_hi(b[k].z) + w2 * bf_hi(c[k].z));
            o.w = pk2(w0 * bf_lo(a[k].w) + w1 * bf_lo(b[k].w) + w2 * bf_lo(c[k].w), w0 * bf_hi(a[k].w) + w1 * bf_hi(b[k].w) + w2 * bf_hi(c[k].w));
            *(GAS v4u*)(ATT + t * AW + ch * 8) = o; }
    }
}

#ifndef MK_PER_PHASE
#define MK_PER_PHASE 0
#endif
constexpr int N_PHASES = 1 + 2 * (2 + 4 + 3 + 4);
#ifndef GEMM_SP2
#define GEMM_SP2 true
#endif
#ifndef PROBE_SITE
#define PROBE_SITE 0
#endif
#define REPS(site, cond) ((PROBE_SITE == (site) && (cond)) ? 2 : 1)
#ifndef PROBE_STAMP
#define PROBE_STAMP 0
#endif
#define STAMP_GAIN 4
constexpr int CW_ACC = 8192;
__device__ __forceinline__ unsigned long long wall_() { return __builtin_amdgcn_s_memrealtime(); }

__global__ void __launch_bounds__(NWAVES * 64, 2) trunk_fwd(Args args) {
    extern __shared__ __attribute__((aligned(16))) unsigned char lds_raw[];
    LAS unsigned char* lds = (LAS unsigned char*)lds_raw;
    LAS unsigned char* xl = lds + RING_BYTES;
    const int G = gridDim.x;
    const int wid0 = __builtin_amdgcn_readfirstlane((int)threadIdx.x >> 6);
    for (int u = threadIdx.x; u < (LDS_BYTES - RING_BYTES) / 4; u += NWAVES * 64) ((LAS unsigned*)(lds + RING_BYTES))[u] = 0u;
    __syncthreads();
    const int lo = __builtin_amdgcn_readfirstlane(args.ph_lo), hi = __builtin_amdgcn_readfirstlane(args.ph_hi);
    XcdBarrier bar; bar.wid0 = wid0; bar.bar = (unsigned*)(arg_ws() + WS_CTL); bar.x = 0; bar.st = (volatile LAS unsigned*)(lds + MISC_OFF) + 8;
    if (hi - lo > 1) { bar = xcd_barrier_post((unsigned*)(arg_ws() + WS_CTL), (volatile LAS unsigned*)(lds + MISC_OFF) + 8); bar.wid0 = wid0; }
    int pc = 0, nsp = 0; unsigned gate_t = 0u, gacc = 0u; (void)gacc;
#ifndef PROBE_DBLBAR
#define PROBE_DBLBAR 0
#endif
#define RUN_PH (pc >= lo && pc < hi)
#define SEAM() do { gate_t = 0u; if (pc >= lo && pc + 1 < hi) { if (PROBE_STAMP == 1 && opaque_tid(wid0) == 0) ((volatile LAS unsigned*)(lds + MISC_OFF))[16] = (unsigned)wall_(); XcdBarrier b2_ = bar; asm volatile("" : "+s"(b2_.bar), "+s"(b2_.x)); b2_.bar = (unsigned*)(GAS unsigned*)b2_.bar; xcd_barrier(b2_); if (PROBE_DBLBAR) { xcd_barrier(b2_); xcd_barrier(b2_); } if (PROBE_STAMP == 1 && opaque_tid(wid0) == 0) atomicAdd((unsigned long long*)(arg_ws() + WS_CTL) + CW_ACC / 2, (unsigned long long)((unsigned)wall_() - ((volatile LAS unsigned*)(lds + MISC_OFF))[16])); } pc = __builtin_amdgcn_readfirstlane(pc + 1); } while (0)
#define SEAML(WB_) do { gate_t = 0u; if (pc >= lo && pc + 1 < hi) { XcdBarrier b2_ = bar; asm volatile("" : "+s"(b2_.bar), "+s"(b2_.x)); b2_.bar = (unsigned*)(GAS unsigned*)b2_.bar; \
        if (PROBE_STAMP == 1 && opaque_tid(wid0) == 0) ((volatile LAS unsigned*)(lds + MISC_OFF))[16] = (unsigned)wall_(); \
        if (__builtin_amdgcn_readfirstlane((int)((volatile LAS unsigned*)(lds + MISC_OFF))[10]) != 0) { xcd_seam_local(b2_, WB_); if (PROBE_STAMP == 1 && opaque_tid(wid0) == 0) atomicAdd((unsigned long long*)(arg_ws() + WS_CTL) + CW_ACC / 2, (unsigned long long)((unsigned)wall_() - ((volatile LAS unsigned*)(lds + MISC_OFF))[16])); nsp = __builtin_amdgcn_readfirstlane(nsp + 1); gate_t = (unsigned)nsp * 8u; } else xcd_barrier(b2_); } \
    pc = __builtin_amdgcn_readfirstlane(pc + 1); } while (0)
#define ENDGATE() do { if (gate_t != 0u) xcd_gate((unsigned*)(arg_ws() + WS_CTL) + XB_TOPS, gate_t); } while (0)
#define GATE(So_) do { (So_).gate_p = (unsigned*)(arg_ws() + WS_CTL) + XB_TOPS; (So_).gate_t = gate_t; } while (0)
#define WSP(T, off) ((T*)(arg_ws() + (off)))
#define BIGP(T, off) ((T*)(arg_ws() + WS_BIG + (off)))
#define XOUT(grp) (arg_out() + (size_t)(grp) * MG * D)
#define VECP() ((const float*)(arg_ws() + WS_VEC))
#define PH_LOCALS int grp_ = grp, layer_ = layer; asm volatile("" : "+s"(grp_), "+s"(layer_)); const int S_ = grp_ == 0 ? 2048 : 16384; (void)layer_; (void)S_; const int cv_ = __builtin_amdgcn_readfirstlane((int)((volatile LAS unsigned*)(lds + MISC_OFF))[13]), slot_ = (cv_ & 7) * 32 + (cv_ >> 3); (void)slot_

#define THIN_BEGIN unsigned long long tt0_ = 0; if (PROBE_STAMP == 2) tt0_ = wall_();
#define THIN_END if (PROBE_STAMP == 2 && opaque_tid(wid0) == 0) atomicAdd((unsigned long long*)(arg_ws() + WS_CTL) + CW_ACC / 2, wall_() - tt0_);
    if (RUN_PH) { THIN_BEGIN _Pragma("unroll 1") for (int rep = 0; rep < REPS(1, true); ++rep) prologue_phase(lds, G, wid0);
        conv_bf16(arg_in(0), WSP(bf16, WS_XB), (size_t)MG * D / 8, (size_t)blockIdx.x * 512 + opaque_tid(wid0), (size_t)G * 512); THIN_END }
    SEAM();
    { volatile LAS unsigned* st_ = (volatile LAS unsigned*)(lds + MISC_OFF) + 8; if (opaque_tid(wid0) == 0) st_[5] = st_[2] ? st_[4] * 8u + st_[3] : blockIdx.x; __syncthreads(); }
#pragma unroll 1
    for (int grp = 0; grp < 2; ++grp) {
#pragma unroll 1
        for (int layer = 0; layer < 2; ++layer) {
            if (layer == 0) {
                if (RUN_PH) { PH_LOCALS; if (grp_ == 0) finalize_vecs(G, wid0);
                    _Pragma("unroll 1") for (int rep = 0; rep < REPS(3, grp_ == 0); ++rep) {
                    pg8::Gemm g{WSP(bf16, WS_XB), WSP(const bf16, WS_W_IN), MG, HW, D, wid0}; pg8::StaticOrder So; So.init(MG, HW, G, cv_);
                    pg8::EpiPlain<1> E{BIGP(bf16, BIG_H), HW, wid0, WSP(float, WS_ST1), xl, 8};
                    pg8::gemm_phase<pg8::EpiPlain<1>, pg8::StaticOrder, true, GEMM_SP2>(lds, g, So, E);
                } ENDGATE(); }
                if (grp == 0) SEAM(); else SEAML(true);
                if (RUN_PH) { PH_LOCALS; THIN_BEGIN _Pragma("unroll 1") for (int rep = 0; rep < REPS(4, grp_ == 0); ++rep) sgu_phase(lds, BIGP(const bf16, BIG_H), BIGP(bf16, BIG_GATED), WSP(const bf16, WS_W_S), arg_in(8), arg_in(5), arg_in(6), WSP(const float, WS_ST1), G, slot_, wid0); THIN_END }
                SEAML(true);
            } else {
                if (RUN_PH) { PH_LOCALS; _Pragma("unroll 1") for (int rep = 0; rep < REPS(5, grp_ == 0); ++rep) {
                    pg8::Gemm g{WSP(bf16, WS_XB), WSP(const bf16, WS_W_QKV), MG, NQKV, D, wid0}; pg8::StaticOrder So; So.init(MG, NQKV, G, cv_); GATE(So);
                    pg8::EpiQKV E{BIGP(bf16, BIG_QKV), WSP(const float, WS_ROT), S_ - 1, QSCALE, wid0};
                    pg8::gemm_phase<pg8::EpiQKV, pg8::StaticOrder, true, GEMM_SP2>(lds, g, So, E); if (PROBE_STAMP == 9) gacc = __builtin_amdgcn_readfirstlane(gacc + So.gwait);
                } }
                if (grp == 0) SEAML(true); else SEAM();
                if (RUN_PH) { PH_LOCALS; THIN_BEGIN _Pragma("unroll 1") for (int rep = REPS(6, grp_ == 0) - 1; rep >= 0; --rep) attn_phase(lds, BIGP(bf16, BIG_QKV), BIGP(float, BIG_LSE), S_, cv_, rep != 0, wid0); THIN_END }
                SEAML(true);
                if (RUN_PH) { PH_LOCALS; THIN_BEGIN _Pragma("unroll 1") for (int rep = 0; rep < REPS(7, grp_ == 0); ++rep) combine_phase(BIGP(const bf16, BIG_QKV), BIGP(const float, BIG_LSE), BIGP(bf16, BIG_ATT), slot_, wid0); THIN_END }
                SEAML(true);
            }
            if (RUN_PH) { PH_LOCALS; _Pragma("unroll 1") for (int rep = 0; rep < REPS(8, grp_ == 0 && layer_ == 0); ++rep) {
                pg8::Gemm g{layer_ == 0 ? BIGP(const bf16, BIG_GATED) : BIGP(const bf16, BIG_ATT), layer_ == 0 ? WSP(const bf16, WS_W_OA) : WSP(const bf16, WS_W_OB), MG, D, layer_ == 0 ? D : AW, wid0};
                pg8::StaticOrder So; So.init(MG, D, G, cv_);
                pg8::EpiY1 E{(const float*)nullptr, WSP(const bf16, WS_XB), WSP(bf16, WS_XB), WSP(float, WS_ST1), xl, ALPHA, wid0};
                pg8::gemm_phase<pg8::EpiY1, pg8::StaticOrder, true, GEMM_SP2>(lds, g, So, E);
                ENDGATE();
                conv_bf16(arg_in(2 + grp_) + ((size_t)layer_ * MG + (size_t)slot_ * 128) * PLE, BIGP(bf16, BIG_PB) + (size_t)slot_ * 128 * PLE, (size_t)128 * PLE / 8, (size_t)opaque_tid(wid0), (size_t)512);
            } }
            SEAML(true);
            if (RUN_PH) { PH_LOCALS; _Pragma("unroll 1") for (int rep = 0; rep < REPS(9, grp_ == 0 && layer_ == 0); ++rep) {
                unsigned long long ck0_ = 0, cw0_ = 0; if (PROBE_STAMP == 3) { ck0_ = clock64(); cw0_ = wall_(); }
                { pg8::Gemm g{WSP(const bf16, WS_XB), WSP(const bf16, WS_W_GU + layer_ * W_GU_STRIDE), MG, NGU, D, wid0}; pg8::StaticOrder So; So.init(MG, NGU, G, cv_);
                  pg8::EpiGU E{WSP(const float, WS_ST1), VECP() + VEC_GU + layer_ * VEC_GU_L, VECP() + VEC_GU + layer_ * VEC_GU_L + NGU, BIGP(bf16, BIG_HB), xl, LN_EPS, wid0};
                  pg8::gemm_phase<pg8::EpiGU, pg8::StaticOrder, true, GEMM_SP2>(lds, g, So, E); }
                if (PROBE_STAMP == 3 && grp_ == 0 && layer_ == 0 && blockIdx.x == 0 && opaque_tid(wid0) == 0) { const unsigned long long dc = clock64() - ck0_, dw = wall_() - cw0_; atomicAdd((unsigned long long*)(arg_ws() + WS_CTL) + CW_ACC / 2, dc * 100ull / (dw ? dw : 1ull) * 100ull * 256ull / STAMP_GAIN); }
                ENDGATE();
                { int kple = PLE; asm volatile("" : "+s"(kple));
                  pg8::Gemm g{BIGP(const bf16, BIG_PB), WSP(const bf16, WS_W_PJ + layer_ * W_PJ_STRIDE), MG, D, kple, wid0}; pg8::StaticOrder So; So.init(MG, D, G, cv_);
                  pg8::EpiPlain<0> E{BIGP(bf16, BIG_PP), D, wid0};
                  pg8::gemm_phase<pg8::EpiPlain<0>, pg8::StaticOrder, true, GEMM_SP2>(lds, g, So, E); }
            } }
            SEAML(true);
            if (PROBE_SITE == 10 && RUN_PH) { PH_LOCALS; if (grp_ == 0 && layer_ == 0) {
                pg8::Gemm g{BIGP(const bf16, BIG_HB), WSP(const bf16, WS_W_DN + layer_ * W_DN_STRIDE), MG, D, FF, wid0}; pg8::StaticOrder So; So.init(MG, D, G, cv_);
                pg8::EpiY2 E{WSP(const bf16, WS_XB), BIGP(bf16, BIG_XB2), WSP(const float, WS_ST1), WSP(float, WS_ST2), arg_in(12) + layer_ * D, arg_in(13) + layer_ * D, xl, ALPHA, LN_EPS, wid0};
                pg8::gemm_phase<pg8::EpiY2, pg8::StaticOrder, true, GEMM_SP2>(lds, g, So, E);
            } }
            if (RUN_PH) { PH_LOCALS; {
                pg8::Gemm g{BIGP(const bf16, BIG_HB), WSP(const bf16, WS_W_DN + layer_ * W_DN_STRIDE), MG, D, FF, wid0}; pg8::StaticOrder So; So.init(MG, D, G, cv_);
                pg8::EpiY2 E{WSP(const bf16, WS_XB), BIGP(bf16, BIG_XB2), WSP(const float, WS_ST1), WSP(float, WS_ST2), arg_in(12) + layer_ * D, arg_in(13) + layer_ * D, xl, ALPHA, LN_EPS, wid0};
                pg8::gemm_phase<pg8::EpiY2, pg8::StaticOrder, true, GEMM_SP2>(lds, g, So, E);
            } }
            SEAML(true);
            if (RUN_PH) { PH_LOCALS; _Pragma("unroll 1") for (int rep = 0; rep < REPS(11, grp_ == 0 && layer_ == 0); ++rep) {
                pg8::Gemm g{BIGP(const bf16, BIG_XB2), WSP(const bf16, WS_W_GT + layer_ * W_GT_STRIDE), MG, D, D, wid0}; pg8::StaticOrder So; So.init(MG, D, G, cv_);
                pg8::EpiPLE E{BIGP(const bf16, BIG_XB2), layer_ == 0 ? (float*)nullptr : XOUT(grp_), WSP(bf16, WS_XB), BIGP(const bf16, BIG_PP), WSP(const float, WS_ST2), arg_in(16) + layer_ * D, arg_in(17) + layer_ * D,
                              VECP() + VEC_GT + layer_ * VEC_GT_L, VECP() + VEC_GT + layer_ * VEC_GT_L + D, xl, LN_EPS, wid0};
                pg8::gemm_phase<pg8::EpiPLE, pg8::StaticOrder, true, GEMM_SP2>(lds, g, So, E);
                }
                ENDGATE();
                if (grp_ == 0 && layer_ == 1) conv_bf16(arg_in(1) + (size_t)slot_ * 128 * D, WSP(bf16, WS_XB) + (size_t)slot_ * 128 * D, (size_t)128 * D / 8, (size_t)opaque_tid(wid0), (size_t)512);
            }
            SEAML(true);
        }
    }
    if (PROBE_STAMP == 9 && opaque_tid(wid0) == 0) atomicAdd((unsigned long long*)(arg_ws() + WS_CTL) + CW_ACC / 2, (unsigned long long)gacc);
    if (PROBE_STAMP != 0 && hi - lo > 1) {
        { XcdBarrier b2_ = bar; asm volatile("" : "+s"(b2_.bar), "+s"(b2_.x)); b2_.bar = (unsigned*)(GAS unsigned*)b2_.bar; xcd_barrier(b2_); }
        if (blockIdx.x == 0 && opaque_tid(wid0) == 0) {
            unsigned long long acc = __hip_atomic_load((unsigned long long*)(arg_ws() + WS_CTL) + CW_ACC / 2, __ATOMIC_RELAXED, __HIP_MEMORY_SCOPE_AGENT);
            if (PROBE_STAMP == 7 || PROBE_STAMP == 8) { unsigned long long mn = ~0ull, sm = 0ull; for (int j = 0; j < 8; ++j) { const unsigned long long v = __hip_atomic_load((unsigned long long*)(arg_ws() + WS_CTL) + CW_ACC / 2 + 1 + j, __ATOMIC_RELAXED, __HIP_MEMORY_SCOPE_AGENT); mn = v < mn ? v : mn; sm += v; } acc = (PROBE_STAMP == 7 ? mn : sm / 8ull) * 256ull; }
            const unsigned long long ticks = acc / 256ull * STAMP_GAIN, t0 = wall_();
            while (wall_() - t0 < ticks) __builtin_amdgcn_s_sleep(32);
        }
        __syncthreads();
    }
#undef RUN_PH
#undef SEAM
}

extern "C" void kernel_launch(void* const* d_in, const int* in_sizes, int n_in, void* d_out, int out_size, void* d_ws, size_t ws_size, hipStream_t stream) {
    static int grid = 0;
    if (grid == 0) {
        if (n_in != 20 || in_sizes[0] != MG * D || in_sizes[1] != MG * D || out_size != 2 * MG * D || ws_size < WS_END) {
            fprintf(stderr, "kernel_launch: unexpected shapes (n_in %d, in0 %d, out %d, ws %zu < %zu); nothing launched\n", n_in, n_in > 0 ? in_sizes[0] : -1, out_size, ws_size, (size_t)WS_END); grid = -1; return; }
        int dev = 0, cus = 0, per_cu = 0;
        if (hipGetDevice(&dev) != hipSuccess || hipDeviceGetAttribute(&cus, hipDeviceAttributeMultiprocessorCount, dev) != hipSuccess) { grid = -1; return; }
        if (hipFuncSetAttribute((const void*)trunk_fwd, hipFuncAttributeMaxDynamicSharedMemorySize, LDS_BYTES) != hipSuccess) { fprintf(stderr, "kernel_launch: hipFuncSetAttribute failed\n"); grid = -1; return; }
        if (hipOccupancyMaxActiveBlocksPerMultiprocessor(&per_cu, (const void*)trunk_fwd, NWAVES * 64, LDS_BYTES) != hipSuccess || per_cu < 1)
            fprintf(stderr, "kernel_launch: note: occupancy query reports %d workgroups per CU\n", per_cu);
        (void)hipGetLastError();
        grid = cus;
    }
    if (grid < 0) return;
    if (hipMemsetAsync((char*)d_ws + WS_CTL, 0, CTL_ZERO_BYTES, stream) != hipSuccess) return;
    Args a{};
    for (int i = 0; i < 20; ++i) a.in[i] = (const float*)d_in[i];
    a.out = (float*)d_out; a.ws = (unsigned char*)d_ws;
#if MK_PER_PHASE
    for (int p = 0; p < N_PHASES; ++p) { a.ph_lo = p; a.ph_hi = p + 1; hipLaunchKernelGGL(trunk_fwd, dim3(grid), dim3(NWAVES * 64), LDS_BYTES, stream, a); }
#else
    a.ph_lo = 0; a.ph_hi = N_PHASES;
    hipLaunchKernelGGL(trunk_fwd, dim3(grid), dim3(NWAVES * 64), LDS_BYTES, stream, a);
#endif
    const hipError_t le = hipPeekAtLastError();
    if (le != hipSuccess) fprintf(stderr, "kernel_launch: launch failed: %s\n", hipGetErrorName(le));
}
```

```cpp
#include <hip/hip_runtime.h>
#include <cstdio>
#include <cstdint>
namespace pg8 {
#define PG8_LAS __attribute__((address_space(3)))
typedef unsigned short bf16_t;
typedef short bf16x8 __attribute__((ext_vector_type(8)));
typedef float f32x4 __attribute__((ext_vector_type(4)));
typedef unsigned u32x4 __attribute__((ext_vector_type(4)));
constexpr int BM = 256, BK = 64, HALF = 128, HTB = HALF * BK * 2  , STAGE_BYTES = 8 * HTB, NXCD = 8, WGM = 4;

__host__ __device__ __forceinline__ int lds_byte(int r, int c) { const int st = (r >> 4) * 2 + (c >> 5), rr = r & 15, cc = c & 31, ob = rr * 64 + cc * 2; return st * 1024 + (ob ^ (((ob >> 9) & 1) << 5)); }
__host__ __device__ __forceinline__ void stage_rc(int b, int& R, int& C) { const int st = b / 1024, sb = b % 1024, swz = sb ^ (((sb >> 9) & 1) << 5); R = (st >> 1) * 16 + swz / 64; C = (st & 1) * 32 + (swz % 64) / 2; }
__host__ __device__ __forceinline__ int perm32(int rho) { const int n = rho >> 4, i = rho & 15; return 8 * (i >> 2) + 4 * n + (i & 3); }

struct Unit { int pm, pn; };
struct Gemm { const bf16_t* A; const bf16_t* Bt; int M, N, K, wid0; };

struct StaticOrder {
    int nM, nN, nwg, G, c;
    __host__ __device__ void init(int M, int N, int G_, int c_) { nM = M / BM; nN = N / BM; nwg = nM * nN; G = G_; c = c_; }
    __host__ __device__ bool next(int i, Unit& u) const {
        const long L = (long)i * G + c; if (L >= nwg) return false;
        int wgid = (int)L; { const int q = nwg / NXCD, r = nwg % NXCD, xcd = wgid % NXCD, off = wgid / NXCD; wgid = (xcd < r ? xcd * (q + 1) : r * (q + 1) + (xcd - r) * q) + off; }
        const int nig = WGM * nN, gid = wgid / nig, fm = gid * WGM, gsz = (nM - fm) < WGM ? (nM - fm) : WGM;
        u.pm = fm + ((wgid % nig) % gsz); u.pn = (wgid % nig) / gsz; return true;
    }
    __device__ __forceinline__ void a_ready(const Unit&) const {}
    __device__ __forceinline__ void done(const Unit&) const {}
    unsigned* gate_p = nullptr; unsigned gate_t = 0u; mutable unsigned gwait = 0u;
    __device__ __forceinline__ void epi_gate(int ui) const {
#if PROBE_STAMP == 9
        if (ui == 0 && gate_t != 0u) { const unsigned tg0_ = (unsigned)__builtin_amdgcn_s_memrealtime(); while (__hip_atomic_load(gate_p, __ATOMIC_RELAXED, __HIP_MEMORY_SCOPE_AGENT) < gate_t) __builtin_amdgcn_s_sleep(1);
            gwait = (unsigned)__builtin_amdgcn_s_memrealtime() - tg0_; return; }
#endif
        if (ui == 0 && gate_t != 0u) { unsigned sp = 0u; while (__hip_atomic_load(gate_p, __ATOMIC_RELAXED, __HIP_MEMORY_SCOPE_AGENT) < gate_t) { __builtin_amdgcn_s_sleep(1); if (++sp > (1u << 18)) break; } asm volatile("" ::: "memory"); }
    }
};
typedef _Float16 h16x2 __attribute__((ext_vector_type(2)));
typedef _Float16 h16x8 __attribute__((ext_vector_type(8)));
typedef float f32x2p __attribute__((ext_vector_type(2)));
#ifndef USE_BF16
#define USE_BF16 1
#endif
#if USE_BF16
__device__ __forceinline__ unsigned cvt_pk16(float lo, float hi) { unsigned r; asm volatile("v_cvt_pk_bf16_f32 %0, %1, %2" : "=v"(r) : "v"(lo), "v"(hi)); return r; }
#define PG8_MFMA16(a, b, c) __builtin_amdgcn_mfma_f32_16x16x32_bf16((a), (b), (c), 0, 0, 0)
#else
__device__ __forceinline__ unsigned cvt_pk16(float lo, float hi) { const f32x2p v = {lo, hi}; return __builtin_bit_cast(unsigned, __builtin_convertvector(v, h16x2)); }
#define PG8_MFMA16(a, b, c) __builtin_amdgcn_mfma_f32_16x16x32_f16(__builtin_bit_cast(pg8::h16x8, (a)), __builtin_bit_cast(pg8::h16x8, (b)), (c), 0, 0, 0)
#endif
typedef float f32x2 __attribute__((ext_vector_type(2)));
__device__ __forceinline__ f32x2 gelu_pk(f32x2 v) {
    const f32x2 av = __builtin_elementwise_abs(v), d = av * 0.2316418882f + 1.0f;
    f32x2 t; t.x = __builtin_amdgcn_rcpf(d.x); t.y = __builtin_amdgcn_rcpf(d.y);
    f32x2 q = t * 0.5307027145f + (-0.7265760135f); q = q * t + 0.7107068705f; q = q * t + (-0.142248368f); q = q * t + 0.127414796f; q = q * t;
    const f32x2 s = (v * v) * (-0.72134752044f);
    f32x2 e; e.x = __builtin_amdgcn_exp2f(s.x); e.y = __builtin_amdgcn_exp2f(s.y);
    const f32x2 m = v * (q * e), r = v - m;
    f32x2 o; o.x = v.x < 0.f ? m.x : r.x; o.y = v.y < 0.f ? m.y : r.y; return o;
}

template <int ACT  > struct EpiBf16 {
    static constexpr bool PERM = true, AFTER_DRAIN = false; static_assert(ACT == 0 || ACT == 1, "EpiBf16: ACT is 0 (none) or 1 (gelu_pk)");
    bf16_t* O; int ldc; const float* bias; int split_cols; size_t split_stride; float scale0;
    __device__ __forceinline__ void operator()(const f32x4 (&acc)[2][2][4][2], const Unit& u, int wr, int wc, int fr, int fq) const {
        const int row0 = u.pm * BM + wr * 64 + fr; int colt = u.pn * BM; bf16_t* base = O;
        float sc = 1.f; if (split_cols) { const int t = colt / split_cols; base += (size_t)t * split_stride; colt -= t * split_cols; if (t == 0) sc = scale0; }
        const int col0 = colt + wc * 32 + 8 * fq, bcol0 = u.pn * BM + wc * 32 + 8 * fq;
        f32x4 bv[2][2];
#pragma unroll
        for (int bj = 0; bj < 2; ++bj)
#pragma unroll
            for (int n = 0; n < 2; ++n) bv[bj][n] = bias ? *(const f32x4*)(bias + bcol0 + bj * HALF + 4 * n) : (f32x4){0.f, 0.f, 0.f, 0.f};
#pragma unroll
        for (int ai = 0; ai < 2; ++ai)
#pragma unroll
            for (int m = 0; m < 4; ++m) { bf16_t* rowp = base + (size_t)(row0 + ai * HALF + m * 16) * ldc + col0;
#pragma unroll
                for (int bj = 0; bj < 2; ++bj) { f32x4 v0 = acc[ai][bj][m][0] + bv[bj][0], v1 = acc[ai][bj][m][1] + bv[bj][1];
                    if (ACT == 1) { f32x2 a = gelu_pk((f32x2){v0[0], v0[1]}), b = gelu_pk((f32x2){v0[2], v0[3]}), c = gelu_pk((f32x2){v1[0], v1[1]}), d = gelu_pk((f32x2){v1[2], v1[3]});
                        v0 = (f32x4){a.x, a.y, b.x, b.y}; v1 = (f32x4){c.x, c.y, d.x, d.y}; }
                    v0 = v0 * sc; v1 = v1 * sc; u32x4 w; w.x = cvt_pk16(v0[0], v0[1]); w.y = cvt_pk16(v0[2], v0[3]); w.z = cvt_pk16(v1[0], v1[1]); w.w = cvt_pk16(v1[2], v1[3]);
                    *(u32x4*)(rowp + bj * HALF) = w; } }
    }
};
}

constexpr int D = 2048, FF = 5632, NGU = 2 * FF, NQKV = 9216, AW = 1024, PLE = 256, HW = 4096;
constexpr int MG = 32768;
constexpr float LN_EPS = 1e-5f;
constexpr float ALPHA = 1.4142135623730951f;
constexpr float QSCALE = 0.08838834764831845f * 1.4426950408889634f;
constexpr float LN2 = 0.6931471805599453f;
constexpr int NWAVES = 8;

constexpr size_t MiB = 1u << 20;
constexpr size_t WS_CTL = 0, CTL_ZERO_BYTES = 65536;
constexpr size_t WS_ROT = 2 * MiB;
constexpr size_t WS_ST1 = 4 * MiB, WS_ST2 = 6 * MiB;
constexpr size_t WS_PART = 8 * MiB;
constexpr size_t WS_VEC = 16 * MiB;
constexpr size_t WS_W_IN = 17 * MiB, WS_W_OA = 33 * MiB, WS_W_S = 41 * MiB, WS_W_QKV = 42 * MiB, WS_W_OB = 78 * MiB;
constexpr size_t WS_W_GU = 82 * MiB, W_GU_STRIDE = 44 * MiB, WS_W_DN = 170 * MiB, W_DN_STRIDE = 22 * MiB;
constexpr size_t WS_W_GT = 214 * MiB, W_GT_STRIDE = 8 * MiB, WS_W_PJ = 230 * MiB, W_PJ_STRIDE = 1 * MiB;
constexpr size_t WS_XB = 232 * MiB;
constexpr size_t WS_BIG = 360 * MiB;
constexpr size_t BIG_H = 0, BIG_GATED = 384 * MiB, BIG_PB = 644 * MiB, BIG_XB2 = 384 * MiB, BIG_HB = 0, BIG_PP = 512 * MiB;
constexpr size_t BIG_QKV = 0, BIG_ATT = 576 * MiB, BIG_LSE = 640 * MiB;
constexpr size_t WS_END = WS_BIG + 660 * MiB;
constexpr int KB32 = 32;
constexpr size_t PART_GU = 0, PART_GU_L = (size_t)2 * KB32 * NGU, PART_GT = 2 * PART_GU_L, PART_GT_L = (size_t)2 * KB32 * D;
constexpr size_t VEC_GU = 0, VEC_GU_L = 2 * NGU, VEC_GT = 2 * VEC_GU_L, VEC_GT_L = 2 * D;
static_assert((PART_GT + 2 * PART_GT_L) * 4 <= 8 * MiB && (VEC_GT + 2 * VEC_GT_L) * 4 <= 1 * MiB, "partials");

constexpr int RING_BYTES = 131072;
constexpr int MISC_OFF = RING_BYTES + 320;
constexpr int STAB_OFF = RING_BYTES + 512;
constexpr int PTAB_OFF = STAB_OFF + 2048;
constexpr int LDS_BYTES = 147456;
static_assert(PTAB_OFF + 8192 <= LDS_BYTES, "LDS map");

#define GAS __attribute__((address_space(1)))
#define LAS __attribute__((address_space(3)))
typedef unsigned short bf16;
typedef unsigned v4u __attribute__((ext_vector_type(4)));
typedef unsigned v2u __attribute__((ext_vector_type(2)));
typedef float f32x4 __attribute__((ext_vector_type(4)));
typedef float f32x2v __attribute__((ext_vector_type(2)));
typedef short bf16x8 __attribute__((ext_vector_type(8)));
typedef short s16x4 __attribute__((ext_vector_type(4)));
#define LDS_WAIT() asm volatile("s_waitcnt lgkmcnt(0)" ::: "memory")
#define VM_WAIT() asm volatile("s_waitcnt vmcnt(0)" ::: "memory")
#define WG_BAR() do { asm volatile("s_waitcnt lgkmcnt(0)" ::: "memory"); __builtin_amdgcn_s_barrier(); asm volatile("" ::: "memory"); } while (0)

#if USE_BF16
__device__ __forceinline__ float bf_round(float f) { unsigned u = __builtin_bit_cast(unsigned, f); u = (u + 0x7fffu + ((u >> 16) & 1u)) & 0xffff0000u; return __builtin_bit_cast(float, u); }
#else
__device__ __forceinline__ float bf_round(float f) { return (float)(_Float16)f; }
#endif
__device__ __forceinline__ unsigned pk2(float lo, float hi) { return pg8::cvt_pk16(lo, hi); }
#if USE_BF16
__device__ __forceinline__ float bf_lo(unsigned w) { return __builtin_bit_cast(float, w << 16); }
__device__ __forceinline__ float bf_hi(unsigned w) { return __builtin_bit_cast(float, w & 0xffff0000u); }
#else
__device__ __forceinline__ float bf_lo(unsigned w) { return (float)__builtin_bit_cast(pg8::h16x2, w).x; }
__device__ __forceinline__ float bf_hi(unsigned w) { return (float)__builtin_bit_cast(pg8::h16x2, w).y; }
#endif
__device__ __forceinline__ int opaque_tid(int wid0) { int t; asm volatile("v_mbcnt_lo_u32_b32 %0, -1, 0\n\tv_mbcnt_hi_u32_b32 %0, -1, %0" : "=v"(t)); return (wid0 << 6) | t; }
__device__ __forceinline__ float shx(float v, int mask, int lane) { return __builtin_bit_cast(float, __builtin_amdgcn_ds_bpermute((lane ^ mask) << 2, __builtin_bit_cast(int, v))); }
__device__ __forceinline__ float wave_sum(float v, int lane) {
#pragma unroll
    for (int o = 1; o < 64; o <<= 1) v += shx(v, o, lane);
    return v;
}
__device__ __forceinline__ float fast_exp2(float x) { return __builtin_amdgcn_exp2f(x); }
__device__ __forceinline__ float fast_rcp(float x) { return __builtin_amdgcn_rcpf(x); }
__device__ __forceinline__ float sigmoidf_(float x) { return fast_rcp(1.0f + fast_exp2(-1.4426950408889634f * x)); }
__device__ __forceinline__ unsigned off_b(unsigned row, unsigned ch) { return 256u * row + 16u * (ch ^ (((row & 3u) << 2) | ((row >> 2) & 3u))); }
typedef short v4i16_t __attribute__((ext_vector_type(4)));
__device__ __forceinline__ s16x4 tr_read(LAS const unsigned char* p) { return __builtin_bit_cast(s16x4, __builtin_amdgcn_ds_read_tr16_b64_v4i16((LAS v4i16_t*)p)); }

namespace pg8 {
__device__ __forceinline__ void stab_from_partials(const float* st, int pm, PG8_LAS unsigned char* xl, float eps, int wid0) {
    const int tid = opaque_tid(wid0);
    if (tid < 256) {
        const f32x4* p = (const f32x4*)(st + ((size_t)(pm * BM + tid)) * 16);
        const f32x4 a = p[0], b = p[1], c = p[2], d = p[3];
        const float S = ((a[0] + a[2]) + (b[0] + b[2])) + ((c[0] + c[2]) + (d[0] + d[2]));
        const float Q = ((a[1] + a[3]) + (b[1] + b[3])) + ((c[1] + c[3]) + (d[1] + d[3]));
        const float mean = S * (1.0f / 2048.0f); float var = Q * (1.0f / 2048.0f) - mean * mean; var = var < 0.f ? 0.f : var;
        ((PG8_LAS f32x2*)(xl + (STAB_OFF - RING_BYTES)))[tid] = (f32x2){mean, 1.0f / sqrtf(var + eps)};
    }
    asm volatile("s_waitcnt lgkmcnt(0)" ::: "memory"); __builtin_amdgcn_s_barrier(); asm volatile("" ::: "memory");
}
__device__ __forceinline__ void partials_to_st(float* st, const Unit& u, PG8_LAS unsigned char* xl, int wid0) {
    asm volatile("s_waitcnt lgkmcnt(0)" ::: "memory"); __builtin_amdgcn_s_barrier(); asm volatile("" ::: "memory");
    const int tid = opaque_tid(wid0);
    if (tid < 256) {
        const PG8_LAS f32x4* P = (const PG8_LAS f32x4*)(xl + (PTAB_OFF - RING_BYTES)) + tid * 2;
        const f32x4 a = P[0], b = P[1];
        f32x2 o; o.x = (a[0] + a[2]) + (b[0] + b[2]); o.y = (a[1] + a[3]) + (b[1] + b[3]);
        *(f32x2*)(st + ((size_t)(u.pm * BM + tid) * 8 + u.pn) * 2) = o;
    }
}
#ifndef NT_STREAM
#define NT_STREAM 1
#endif
#if NT_STREAM
#define NT_STORE16(p, v) __builtin_nontemporal_store((v), (u32x4*)(p))
#else
#define NT_STORE16(p, v) (*(u32x4*)(p) = (v))
#endif
struct LaneId { int wr, wc, fr, fq; };
__device__ __forceinline__ LaneId lane_id(int wid0) { const int t = opaque_tid(wid0); const int wid = wid0, lane = t & 63; LaneId L; L.wr = wid >> 2; L.wc = wid & 3; L.fr = lane & 15; L.fq = lane >> 4; return L; }
__device__ __forceinline__ f32x4 fma4(f32x4 a, float k, float c) { return a * k + c; }
__device__ __forceinline__ f32x4 sigmoid4(f32x4 t) {
    const f32x4 m = t * (-1.4426950408889634f); f32x4 e;
    e[0] = __builtin_amdgcn_exp2f(m[0]); e[1] = __builtin_amdgcn_exp2f(m[1]); e[2] = __builtin_amdgcn_exp2f(m[2]); e[3] = __builtin_amdgcn_exp2f(m[3]);
    const f32x4 d = e + 1.0f; f32x4 r;
    r[0] = __builtin_amdgcn_rcpf(d[0]); r[1] = __builtin_amdgcn_rcpf(d[1]); r[2] = __builtin_amdgcn_rcpf(d[2]); r[3] = __builtin_amdgcn_rcpf(d[3]);
    return r;
}
#define PG8_ROWSUM(s, q, v) do { s += ((v)[0] + (v)[1]) + ((v)[2] + (v)[3]); q += ((v)[0] * (v)[0] + (v)[1] * (v)[1]) + ((v)[2] * (v)[2] + (v)[3] * (v)[3]); } while (0)

template <int ACT> struct EpiPlain {
    static constexpr bool PERM = true, AFTER_DRAIN = false;
    bf16_t* O; int ldc; int wid0; float* st = nullptr; PG8_LAS unsigned char* xl = nullptr; int st_pn0 = 0;
    __device__ __forceinline__ void operator()(const f32x4 (&acc)[2][2][4][2], const Unit& u, int, int, int, int) const {
        const LaneId L_ = lane_id(wid0); const int wr = L_.wr, wc = L_.wc, fr = L_.fr, fq = L_.fq;
        const int row0 = u.pm * BM + wr * 64 + fr, col0 = u.pn * BM + wc * 32 + 8 * fq, ln_ = fr + 16 * fq;
        const bool stats = st != nullptr && u.pn >= st_pn0;
        PG8_LAS f32x2* P = (PG8_LAS f32x2*)(xl + (PTAB_OFF - RING_BYTES));
#pragma unroll
        for (int ai = 0; ai < 2; ++ai)
#pragma unroll
            for (int m = 0; m < 4; ++m) { bf16_t* rowp = O + (size_t)(row0 + ai * HALF + m * 16) * ldc + col0; float ss = 0.f, qq = 0.f;
#pragma unroll
                for (int bj = 0; bj < 2; ++bj) { f32x4 v0 = acc[ai][bj][m][0], v1 = acc[ai][bj][m][1];
                    if (ACT == 1) { f32x2 a = gelu_pk((f32x2){v0[0], v0[1]}), b = gelu_pk((f32x2){v0[2], v0[3]}), c = gelu_pk((f32x2){v1[0], v1[1]}), d = gelu_pk((f32x2){v1[2], v1[3]});
                        v0 = (f32x4){a.x, a.y, b.x, b.y}; v1 = (f32x4){c.x, c.y, d.x, d.y}; }
                    if (stats) { PG8_ROWSUM(ss, qq, v0); PG8_ROWSUM(ss, qq, v1); }
                    u32x4 w; w.x = cvt_pk16(v0[0], v0[1]); w.y = cvt_pk16(v0[2], v0[3]); w.z = cvt_pk16(v1[0], v1[1]); w.w = cvt_pk16(v1[2], v1[3]);
                    NT_STORE16(rowp + bj * HALF, w); }
                if (stats) { ss += shx(ss, 16, ln_); qq += shx(qq, 16, ln_); ss += shx(ss, 32, ln_); qq += shx(qq, 32, ln_);
                    if (fq == 0) P[(ai * HALF + wr * 64 + m * 16 + fr) * 4 + wc] = (f32x2){ss, qq}; } }
        if (stats) { Unit u2 = u; u2.pn = u.pn - st_pn0; partials_to_st(st, u2, xl, wid0); }
    }
};
struct EpiQKV {
    static constexpr bool PERM = true, AFTER_DRAIN = false;
    bf16_t* O; const float* rot; int seq_mask; float qscale; int wid0;
    __device__ __forceinline__ void operator()(const f32x4 (&acc)[2][2][4][2], const Unit& u, int, int, int, int) const {
        const LaneId L_ = lane_id(wid0); const int wr = L_.wr, wc = L_.wc, fr = L_.fr, fq = L_.fq;
        const int colt = u.pn * BM, tsel = (colt % 3072) / 1024;
        const float sc = tsel == 0 ? qscale : 1.0f;
        const bool dorot = (tsel < 2) && (wc == 0);
        const int row0 = u.pm * BM + wr * 64 + fr, col0 = colt + wc * 32 + 8 * fq;
        const float sgn = fq < 2 ? -1.0f : 1.0f;
#pragma unroll
        for (int ai = 0; ai < 2; ++ai)
#pragma unroll
            for (int m = 0; m < 4; ++m) {
                const int row = row0 + ai * HALF + m * 16;
                f32x4 cs[2], sn[2];
                if (dorot) { const float* rp = rot + (size_t)(row & seq_mask) * 32 + 8 * (fq & 1);
                    cs[0] = *(const f32x4*)(rp); cs[1] = *(const f32x4*)(rp + 4); sn[0] = *(const f32x4*)(rp + 16); sn[1] = *(const f32x4*)(rp + 20); }
#pragma unroll
                for (int bj = 0; bj < 2; ++bj) {
                    f32x4 v[2] = {acc[ai][bj][m][0], acc[ai][bj][m][1]};
                    if (dorot) {
#pragma unroll
                        for (int n = 0; n < 2; ++n) { f32x4 pr;
#pragma unroll
                            for (int j = 0; j < 4; ++j) pr[j] = shx(v[n][j], 32, fr + 16 * fq);
                            v[n] = v[n] * cs[n] + (pr * sn[n]) * sgn; }
                    }
                    v[0] = v[0] * sc; v[1] = v[1] * sc;
                    u32x4 w; w.x = cvt_pk16(v[0][0], v[0][1]); w.y = cvt_pk16(v[0][2], v[0][3]); w.z = cvt_pk16(v[1][0], v[1][1]); w.w = cvt_pk16(v[1][2], v[1][3]);
                    NT_STORE16(O + (size_t)row * NQKV + col0 + bj * HALF, w);
                }
            }
    }
};
#define PG8_UNPACK8(W_, v0, v1) do { v0[0] = bf_lo((W_)[0]); v0[1] = bf_hi((W_)[0]); v0[2] = bf_lo((W_)[1]); v0[3] = bf_hi((W_)[1]); v1[0] = bf_lo((W_)[2]); v1[1] = bf_hi((W_)[2]); v1[2] = bf_lo((W_)[3]); v1[3] = bf_hi((W_)[3]); } while (0)
#define PG8_PACK8(W_, v0, v1) do { (W_)[0] = cvt_pk16(v0[0], v0[1]); (W_)[1] = cvt_pk16(v0[2], v0[3]); (W_)[2] = cvt_pk16(v1[0], v1[1]); (W_)[3] = cvt_pk16(v1[2], v1[3]); } while (0)
struct EpiY1 {
    static constexpr bool PERM = true, AFTER_DRAIN = false;
    const float* xin32; const bf16_t* xin16; bf16_t* yb; float* st; PG8_LAS unsigned char* xl; float alpha; int wid0;
    __device__ __forceinline__ void operator()(const f32x4 (&acc)[2][2][4][2], const Unit& u, int, int, int, int) const {
        const LaneId L_ = lane_id(wid0); const int wr = L_.wr, wc = L_.wc, fr = L_.fr, fq = L_.fq;
        const int row0 = u.pm * BM + wr * 64 + fr, col0 = u.pn * BM + wc * 32 + 8 * fq, ln_ = fr + 16 * fq;
        PG8_LAS f32x2* P = (PG8_LAS f32x2*)(xl + (PTAB_OFF - RING_BYTES));
        const unsigned eb0 = (unsigned)(row0 * D + col0) * 2u;
        u32x4 xw[2][4];
#pragma unroll
        for (int m = 0; m < 4; ++m) xw[0][m] = *(const u32x4*)(((const char*)xin16 + (size_t)(m * 16 * D) * 2) + (size_t)eb0);
#pragma unroll
        for (int ai = 0; ai < 2; ++ai) {
            float s[4] = {0.f, 0.f, 0.f, 0.f}, q[4] = {0.f, 0.f, 0.f, 0.f};
#pragma unroll
            for (int bj = 0; bj < 2; ++bj) {
                const int b = ai * 2 + bj;
                if (b < 3) { const int ai2 = (b + 1) >> 1, bj2 = (b + 1) & 1;
#pragma unroll
                    for (int m = 0; m < 4; ++m) xw[(b + 1) & 1][m] = *(const u32x4*)(((const char*)xin16 + (size_t)((ai2 * HALF + m * 16) * D + bj2 * HALF) * 2) + (size_t)eb0); }
#pragma unroll
                for (int m = 0; m < 4; ++m) {
                    f32x4 x0, x1; PG8_UNPACK8(xw[b & 1][m], x0, x1);
                    const f32x4 y0 = x0 * alpha + acc[ai][bj][m][0], y1 = x1 * alpha + acc[ai][bj][m][1];
                    u32x4 w; PG8_PACK8(w, y0, y1); *(u32x4*)(((char*)yb + (size_t)((ai * HALF + m * 16) * D + bj * HALF) * 2) + (size_t)eb0) = w;
                    PG8_ROWSUM(s[m], q[m], y0); PG8_ROWSUM(s[m], q[m], y1); }
                asm volatile("" ::: "memory");
            }
#pragma unroll
            for (int m = 0; m < 4; ++m) { float ss = s[m], qq = q[m]; ss += shx(ss, 16, ln_); qq += shx(qq, 16, ln_); ss += shx(ss, 32, ln_); qq += shx(qq, 32, ln_);
                if (fq == 0) P[(ai * HALF + wr * 64 + m * 16 + fr) * 4 + wc] = (f32x2){ss, qq}; }
        }
        partials_to_st(st, u, xl, wid0);
    }
};
struct EpiGU {
    static constexpr bool PERM = true, AFTER_DRAIN = false;
    const float* st; const float* cs; const float* bw; bf16_t* H; PG8_LAS unsigned char* xl; float eps; int wid0; mutable int last_pm = -1;
    __device__ __forceinline__ void operator()(const f32x4 (&acc)[2][2][4][2], const Unit& u, int, int, int, int) const {
        const LaneId L_ = lane_id(wid0); const int wr = L_.wr, wc = L_.wc, fr = L_.fr, fq = L_.fq;
        if (u.pm != last_pm) { stab_from_partials(st, u.pm, xl, eps, wid0); last_pm = u.pm; }
        const PG8_LAS f32x2* S = (const PG8_LAS f32x2*)(xl + (STAB_OFF - RING_BYTES));
        const int row0 = u.pm * BM + wr * 64 + fr, col0 = u.pn * BM + wc * 32 + 8 * fq, hcol0 = u.pn * HALF + wc * 32 + 8 * fq;
        f32x4 csv[2][2], bwv[2][2];
#pragma unroll
        for (int bj = 0; bj < 2; ++bj)
#pragma unroll
            for (int n = 0; n < 2; ++n) { csv[bj][n] = *(const f32x4*)(cs + col0 + bj * HALF + 4 * n); bwv[bj][n] = *(const f32x4*)(bw + col0 + bj * HALF + 4 * n); }
#pragma unroll
        for (int ai = 0; ai < 2; ++ai)
#pragma unroll
            for (int m = 0; m < 4; ++m) {
                const int rl = ai * HALF + wr * 64 + m * 16 + fr; const f32x2 sr = S[rl]; const float nmr = -sr.x * sr.y;
                f32x4 h[2];
#pragma unroll
                for (int n = 0; n < 2; ++n) {
                    const f32x4 g = acc[ai][0][m][n] * sr.y + (csv[0][n] * nmr + bwv[0][n]);
                    const f32x4 uu = acc[ai][1][m][n] * sr.y + (csv[1][n] * nmr + bwv[1][n]);
                    h[n] = (g * sigmoid4(g)) * uu;
                }
                u32x4 w; w.x = cvt_pk16(h[0][0], h[0][1]); w.y = cvt_pk16(h[0][2], h[0][3]); w.z = cvt_pk16(h[1][0], h[1][1]); w.w = cvt_pk16(h[1][2], h[1][3]);
                NT_STORE16(H + (size_t)(row0 + ai * HALF + m * 16) * FF + hcol0, w);
            }
    }
};
struct EpiY2 {
    static constexpr bool PERM = true, AFTER_DRAIN = false;
    const bf16_t* y1b; bf16_t* yb; const float* st1; float* st2; const float* lng; const float* lnb; PG8_LAS unsigned char* xl; float alpha, eps; int wid0; mutable int last_pm = -1;
    __device__ __forceinline__ void operator()(const f32x4 (&acc)[2][2][4][2], const Unit& u, int, int, int, int) const {
        const LaneId L_ = lane_id(wid0); const int wr = L_.wr, wc = L_.wc, fr = L_.fr, fq = L_.fq;
        const int row0 = u.pm * BM + wr * 64 + fr, col0 = u.pn * BM + wc * 32 + 8 * fq, ln_ = fr + 16 * fq;
        const unsigned eb0 = (unsigned)(row0 * D + col0) * 2u;
        u32x4 aw[2][4];
#define PG8_Y2_LOAD(buf, k) do { _Pragma("unroll") for (int m = 0; m < 4; ++m) aw[buf][m] = *(const u32x4*)(((const char*)y1b + (size_t)(((((k) >> 1) * HALF + m * 16) * D + ((k) & 1) * HALF) * 2)) + (size_t)eb0); } while (0)
        PG8_Y2_LOAD(0, 0); PG8_Y2_LOAD(1, 1);
        if (u.pm != last_pm) { stab_from_partials(st1, u.pm, xl, eps, wid0); last_pm = u.pm; }
        const PG8_LAS f32x2* S = (const PG8_LAS f32x2*)(xl + (STAB_OFF - RING_BYTES));
        PG8_LAS f32x2* P = (PG8_LAS f32x2*)(xl + (PTAB_OFF - RING_BYTES));
        f32x4 gv[2][2], bv[2][2];
#pragma unroll
        for (int bj = 0; bj < 2; ++bj)
#pragma unroll
            for (int n = 0; n < 2; ++n) { gv[bj][n] = *(const f32x4*)(lng + col0 + bj * HALF + 4 * n); bv[bj][n] = *(const f32x4*)(lnb + col0 + bj * HALF + 4 * n); }
#pragma unroll
        for (int ai = 0; ai < 2; ++ai) {
            float s[4] = {0.f, 0.f, 0.f, 0.f}, q[4] = {0.f, 0.f, 0.f, 0.f}; f32x2 sr[4];
#pragma unroll
            for (int m = 0; m < 4; ++m) sr[m] = S[ai * HALF + wr * 64 + m * 16 + fr];
#pragma unroll
            for (int bj = 0; bj < 2; ++bj) {
                const int k = ai * 2 + bj, buf = k & 1;
#pragma unroll
                for (int m = 0; m < 4; ++m) { const size_t cofs = (size_t)(((ai * HALF + m * 16) * D + bj * HALF) * 2);
                    f32x4 a0, a1; PG8_UNPACK8(aw[buf][m], a0, a1);
                    const float nmr = -sr[m].x * sr[m].y; const f32x4 x0 = fma4(a0, sr[m].y, nmr) * gv[bj][0] + bv[bj][0], x1 = fma4(a1, sr[m].y, nmr) * gv[bj][1] + bv[bj][1];
                    const f32x4 y0 = x0 * alpha + acc[ai][bj][m][0], y1 = x1 * alpha + acc[ai][bj][m][1];
                    u32x4 w; PG8_PACK8(w, y0, y1); *(u32x4*)(((char*)yb + cofs) + (size_t)eb0) = w;
                    PG8_ROWSUM(s[m], q[m], y0); PG8_ROWSUM(s[m], q[m], y1); }
                if (k < 2) PG8_Y2_LOAD(buf, k + 2);
            }
#pragma unroll
            for (int m = 0; m < 4; ++m) { float ss = s[m], qq = q[m]; ss += shx(ss, 16, ln_); qq += shx(qq, 16, ln_); ss += shx(ss, 32, ln_); qq += shx(qq, 32, ln_);
                if (fq == 0) P[(ai * HALF + wr * 64 + m * 16 + fr) * 4 + wc] = (f32x2){ss, qq}; }
        }
#undef PG8_Y2_LOAD
        partials_to_st(st2, u, xl, wid0);
    }
};
struct EpiPLE {
    static constexpr bool PERM = true, AFTER_DRAIN = false;
    const bf16_t* y2b; float* out32; bf16_t* xb; const bf16_t* pp; const float* st2; const float* lng; const float* lnb; const float* cs; const float* bw; PG8_LAS unsigned char* xl; float eps; int wid0; mutable int last_pm = -1;
    __device__ __forceinline__ void operator()(const f32x4 (&acc)[2][2][4][2], const Unit& u, int, int, int, int) const {
        const LaneId L_ = lane_id(wid0); const int wr = L_.wr, wc = L_.wc, fr = L_.fr, fq = L_.fq;
        const int row0 = u.pm * BM + wr * 64 + fr, col0 = u.pn * BM + wc * 32 + 8 * fq;
        const unsigned eb0 = (unsigned)(row0 * D + col0) * 2u;
        u32x4 aw[2][2], pw[2][2];
#define PLE_LOAD(hb_) do { const int bj_ = (hb_) >> 2, ai_ = ((hb_) >> 1) & 1, mh_ = (hb_) & 1; _Pragma("unroll") for (int r_ = 0; r_ < 2; ++r_) { const size_t co_ = (size_t)((ai_ * HALF + (2 * mh_ + r_) * 16) * D + bj_ * HALF) * 2; \
            aw[(hb_) & 1][r_] = *(const u32x4*)(((const char*)y2b + co_) + (size_t)eb0); pw[(hb_) & 1][r_] = *(const u32x4*)(((const char*)pp + co_) + (size_t)eb0); } } while (0)
        PLE_LOAD(0);
        if (u.pm != last_pm) { stab_from_partials(st2, u.pm, xl, eps, wid0); last_pm = u.pm; }
        const PG8_LAS f32x2* S = (const PG8_LAS f32x2*)(xl + (STAB_OFF - RING_BYTES));
#pragma unroll
        for (int bj = 0; bj < 2; ++bj) {
            f32x4 gv[2], bv[2], csv[2], bwv[2];
#pragma unroll
            for (int n = 0; n < 2; ++n) { const int c = col0 + bj * HALF + 4 * n; gv[n] = *(const f32x4*)(lng + c); bv[n] = *(const f32x4*)(lnb + c); csv[n] = *(const f32x4*)(cs + c); bwv[n] = *(const f32x4*)(bw + c); }
#pragma unroll
            for (int ai = 0; ai < 2; ++ai) {
#pragma unroll
                for (int mh = 0; mh < 2; ++mh) {
                    const int hb = bj * 4 + ai * 2 + mh;
                    if (hb < 7) PLE_LOAD(hb + 1);
#pragma unroll
                    for (int r = 0; r < 2; ++r) {
                        const int m = 2 * mh + r, rl = ai * HALF + wr * 64 + m * 16 + fr; const size_t co = (size_t)((ai * HALF + m * 16) * D + bj * HALF); const f32x2 sr = S[rl];
                        f32x4 a0, a1, p0, p1; PG8_UNPACK8(aw[hb & 1][r], a0, a1); PG8_UNPACK8(pw[hb & 1][r], p0, p1);
                        const float nmr = -sr.x * sr.y; const f32x4 x0 = fma4(a0, sr.y, nmr) * gv[0] + bv[0], x1 = fma4(a1, sr.y, nmr) * gv[1] + bv[1];
                        const f32x4 t0 = acc[ai][bj][m][0] * sr.y + (csv[0] * nmr + bwv[0]), t1 = acc[ai][bj][m][1] * sr.y + (csv[1] * nmr + bwv[1]);
                        const f32x4 o0 = x0 + sigmoid4(t0) * p0, o1 = x1 + sigmoid4(t1) * p1;
                        if (out32) { float* op = (float*)(((char*)out32 + co * 4) + (size_t)eb0 * 2); *(f32x4*)op = o0; *(f32x4*)(op + 4) = o1; }
                        else { u32x4 w; PG8_PACK8(w, o0, o1); *(u32x4*)(((char*)xb + co * 2) + (size_t)eb0) = w; }
                    }
                    asm volatile("" ::: "memory");
                }
            }
        }
#undef PLE_LOAD
    }
};
}
namespace pg8 {
template <class Epi, class Sched, bool ALIGN_EPI = false, bool SP2 = false>
__device__ __forceinline__ void gemm_phase(PG8_LAS unsigned char* lds, const Gemm g, const Sched& S, const Epi& E) {
    int wid_ = g.wid0; asm volatile("" : "+s"(wid_));     const int tid = opaque_tid(wid_), wid = wid_, lane = tid & 63, wr = wid >> 2, wc = wid & 3, fr = lane & 15, fq = lane >> 4;
    const int K = g.K, nt = K / BK;
    unsigned voffA[2], voffB[2];
#pragma unroll
    for (int i = 0; i < 2; ++i) { int R, C; stage_rc(tid * 16 + i * 8192, R, C); const int Rb = Epi::PERM ? ((R & ~31) + perm32(R & 31)) : R;
        voffA[i] = (unsigned)(R * K + C) * 2u; voffB[i] = (unsigned)(Rb * K + C) * 2u; }
    const size_t kstep = (size_t)(BK * 2);
    const size_t hstep = (size_t)HALF * K * 2;
    const size_t tstep = 2 * hstep;
    const unsigned ldsw = (unsigned)wid * 1024u;
    const int aoff = lds_byte(wr * 64 + fr, fq * 8), boff = lds_byte(wc * 32 + fr, fq * 8);
#define PG8_SA(b, h) (((b) * 2 + (h)) * HTB)
#define PG8_SB(b, h) ((4 + (b) * 2 + (h)) * HTB)
#define PG8_STAGE(bufoff, gbase, voff) do { _Pragma("unroll") for (int _i = 0; _i < 2; ++_i) \
        __builtin_amdgcn_global_load_lds((const unsigned*)((const char*)(gbase) + (voff)[_i]), (PG8_LAS unsigned*)(lds + (bufoff) + ldsw + _i * 8192), 16, 0, 0); } while (0)
#define PG8_LDA(dst, b, h) do { _Pragma("unroll") for (int m = 0; m < 4; ++m) _Pragma("unroll") for (int k = 0; k < 2; ++k) dst[m][k] = *(const PG8_LAS bf16x8*)(lds + PG8_SA(b, h) + aoff + m * 2048 + k * 1024); } while (0)
#define PG8_LDB(dst, b, h) do { _Pragma("unroll") for (int n = 0; n < 2; ++n) _Pragma("unroll") for (int k = 0; k < 2; ++k) dst[n][k] = *(const PG8_LAS bf16x8*)(lds + PG8_SB(b, h) + boff + n * 2048 + k * 1024); } while (0)
#define PG8_MMA(ai, bj, At, Bt) do { __builtin_amdgcn_s_setprio(1); _Pragma("unroll") for (int m = 0; m < 4; ++m) _Pragma("unroll") for (int n = 0; n < 2; ++n) _Pragma("unroll") for (int k = 0; k < 2; ++k) \
        acc[ai][bj][m][n] = PG8_MFMA16(Bt[n][k], At[m][k], acc[ai][bj][m][n]); __builtin_amdgcn_s_setprio(0); } while (0)
#define PG8_WAIT_V(n) asm volatile("s_waitcnt vmcnt(" #n ")" ::: "memory")
#define PG8_WAIT_L(n) asm volatile("s_waitcnt lgkmcnt(" #n ")" ::: "memory")
#define PG8_BAR __builtin_amdgcn_s_barrier()
#define PG8_SCHED __builtin_amdgcn_sched_barrier(0)
    Unit cur, nxt; int ui = 0;
    float z0_ = 0.f; asm volatile("" : "+v"(z0_));
    if (!S.next(0, cur)) return;
    f32x4 acc[2][2][4][2];
#pragma unroll
    for (int a = 0; a < 2; ++a)
#pragma unroll
        for (int b = 0; b < 2; ++b)
#pragma unroll
            for (int m = 0; m < 4; ++m)
#pragma unroll
                for (int n = 0; n < 2; ++n) acc[a][b][m][n] = (f32x4){z0_, z0_, z0_, z0_};
    bf16x8 At[4][2], B0[2][2], B1[2][2];
    const char* cA = (const char*)g.A + (size_t)cur.pm * tstep; const char* cB = (const char*)g.Bt + (size_t)cur.pn * tstep;
    S.a_ready(cur);
    if constexpr (SP2) {
        PG8_STAGE(PG8_SB(0, 0), cB, voffB); PG8_STAGE(PG8_SB(0, 1), cB + hstep, voffB); PG8_STAGE(PG8_SA(0, 0), cA, voffA); PG8_STAGE(PG8_SA(0, 1), cA + hstep, voffA);
        if (wr == 1) PG8_BAR;
        PG8_WAIT_V(2); PG8_BAR;
        PG8_STAGE(PG8_SB(1, 0), cB + kstep, voffB); PG8_STAGE(PG8_SA(1, 0), cA + kstep, voffA); PG8_STAGE(PG8_SB(1, 1), cB + hstep + kstep, voffB);
        PG8_WAIT_V(6); PG8_BAR;
    } else {
        PG8_STAGE(PG8_SB(0, 0), cB, voffB); PG8_STAGE(PG8_SA(0, 0), cA, voffA); PG8_STAGE(PG8_SB(0, 1), cB + hstep, voffB); PG8_STAGE(PG8_SA(0, 1), cA + hstep, voffA);
        if (wr == 1) PG8_BAR;
        PG8_WAIT_V(4); PG8_BAR;
        PG8_STAGE(PG8_SB(1, 0), cB + kstep, voffB); PG8_STAGE(PG8_SA(1, 0), cA + kstep, voffA); PG8_STAGE(PG8_SB(1, 1), cB + hstep + kstep, voffB);
        PG8_WAIT_V(6); PG8_BAR;
    }
    for (;;) {
        const bool has_next = S.next(ui + 1, nxt);
        const char* nA = has_next ? (const char*)g.A + (size_t)nxt.pm * tstep : cA; const char* nB = has_next ? (const char*)g.Bt + (size_t)nxt.pn * tstep : cB;
        for (int t = 0; t < nt; t += 2) {
            const bool last = (t == nt - 2);
            const char* a1 = cA + (size_t)(t + 1) * kstep;
            const char* a2 = last ? nA : cA + (size_t)(t + 2) * kstep; const char* b2 = last ? nB : cB + (size_t)(t + 2) * kstep;
            const char* a3 = a2 + kstep; const char* b3 = b2 + kstep;
            if (last && has_next) S.a_ready(nxt);
            if constexpr (SP2) {
            PG8_LDB(B0, 0, 0); PG8_LDB(B1, 0, 1); PG8_SCHED; PG8_LDA(At, 0, 0); PG8_STAGE(PG8_SA(1, 1), a1 + hstep, voffA);
            PG8_WAIT_V(8); PG8_WAIT_L(0); PG8_BAR; PG8_MMA(0, 0, At, B0); PG8_MMA(0, 1, At, B1); PG8_BAR; PG8_SCHED;
            PG8_LDA(At, 0, 1); PG8_STAGE(PG8_SB(0, 0), b2, voffB); PG8_STAGE(PG8_SB(0, 1), b2 + hstep, voffB); PG8_STAGE(PG8_SA(0, 0), a2, voffA);
            PG8_WAIT_V(8); PG8_WAIT_L(0); PG8_BAR; PG8_MMA(1, 0, At, B0); PG8_MMA(1, 1, At, B1); PG8_BAR; PG8_SCHED;
            PG8_LDB(B0, 1, 0); PG8_LDB(B1, 1, 1); PG8_SCHED; PG8_LDA(At, 1, 0); PG8_STAGE(PG8_SA(0, 1), a2 + hstep, voffA);
            PG8_WAIT_V(8); PG8_WAIT_L(0); PG8_BAR; PG8_MMA(0, 0, At, B0); PG8_MMA(0, 1, At, B1); PG8_BAR; PG8_SCHED;
            PG8_LDA(At, 1, 1); PG8_STAGE(PG8_SB(1, 0), b3, voffB); PG8_STAGE(PG8_SB(1, 1), b3 + hstep, voffB); PG8_STAGE(PG8_SA(1, 0), a3, voffA);
            PG8_WAIT_V(8); PG8_WAIT_L(0); PG8_BAR; PG8_MMA(1, 0, At, B0); PG8_MMA(1, 1, At, B1); PG8_BAR; PG8_SCHED;
            } else {
            PG8_LDB(B0, 0, 0); PG8_SCHED; PG8_LDA(At, 0, 0); PG8_STAGE(PG8_SA(1, 1), a1 + hstep, voffA);
            PG8_WAIT_L(8); PG8_BAR; PG8_WAIT_L(0); PG8_MMA(0, 0, At, B0); PG8_BAR; PG8_SCHED;
            PG8_LDB(B1, 0, 1); PG8_STAGE(PG8_SB(0, 0), b2, voffB);
            PG8_BAR; PG8_WAIT_L(0); PG8_MMA(0, 1, At, B1); PG8_BAR;
            PG8_LDA(At, 0, 1); PG8_STAGE(PG8_SA(0, 0), a2, voffA);
            PG8_BAR; PG8_WAIT_L(0); PG8_MMA(1, 0, At, B0); PG8_BAR; PG8_SCHED;
            PG8_STAGE(PG8_SB(0, 1), b2 + hstep, voffB);
            PG8_WAIT_V(6); PG8_BAR; PG8_MMA(1, 1, At, B1); PG8_BAR;
            PG8_LDB(B0, 1, 0); PG8_SCHED; PG8_LDA(At, 1, 0); PG8_STAGE(PG8_SA(0, 1), a2 + hstep, voffA);
            PG8_WAIT_L(8); PG8_BAR; PG8_WAIT_L(0); PG8_MMA(0, 0, At, B0); PG8_BAR; PG8_SCHED;
            PG8_LDB(B1, 1, 1); PG8_STAGE(PG8_SB(1, 0), b3, voffB);
            PG8_BAR; PG8_WAIT_L(0); PG8_MMA(0, 1, At, B1); PG8_BAR;
            PG8_LDA(At, 1, 1); PG8_STAGE(PG8_SA(1, 0), a3, voffA);
            PG8_BAR; PG8_WAIT_L(0); PG8_MMA(1, 0, At, B0); PG8_BAR; PG8_SCHED;
            PG8_STAGE(PG8_SB(1, 1), b3 + hstep, voffB);
            PG8_WAIT_V(6); PG8_BAR; PG8_MMA(1, 1, At, B1); PG8_BAR;
            }
        }
        if constexpr (ALIGN_EPI) { if (wr == 0) PG8_BAR; }
        if constexpr (!Epi::AFTER_DRAIN) { S.epi_gate(ui); E(acc, cur, wr, wc, fr, fq); S.done(cur); }
        if (!has_next) break;
#pragma unroll
        for (int a = 0; a < 2; ++a)
#pragma unroll
            for (int b = 0; b < 2; ++b)
#pragma unroll
                for (int m = 0; m < 4; ++m)
#pragma unroll
                    for (int n = 0; n < 2; ++n) acc[a][b][m][n] = (f32x4){z0_, z0_, z0_, z0_};
        cur = nxt; cA = nA; cB = nB; ++ui;
        if constexpr (ALIGN_EPI) { if (wr == 1) PG8_BAR; }
    }
    PG8_WAIT_V(0);
    if constexpr (!ALIGN_EPI) { if (wr == 0) PG8_BAR; }
    PG8_BAR;
    if constexpr (Epi::AFTER_DRAIN) { E.fused(acc, cur, wr, wc, fr, fq, lds, wid, lane); S.done(cur); }
#undef PG8_SA
#undef PG8_SB
#undef PG8_STAGE
#undef PG8_LDA
#undef PG8_LDB
#undef PG8_MMA
#undef PG8_WAIT_V
#undef PG8_WAIT_L
#undef PG8_BAR
#undef PG8_SCHED
}
}
#define XB_TMO      128
#define XB_XCNT(j)  (256  + 64 * (j))
#define XB_XSUB(j)  (1280 + 64 * (j))
#define XB_XGEN(j)  (2304 + 64 * (j))
#define XB_TOP      3328
#define XB_TOPGEN   3392
#define XB_TOPS     3456
#define XCD_BAR_WORDS 3520
#define XB_SPIN_CAP (1u << 18)
#ifndef PROBE_FORCE_FULL
#define PROBE_FORCE_FULL 0
#endif

__device__ __forceinline__ unsigned xb_ld(unsigned* p)              { return __hip_atomic_load(p, __ATOMIC_RELAXED, __HIP_MEMORY_SCOPE_AGENT); }
__device__ __forceinline__ unsigned xb_add(unsigned* p, unsigned v) { return __hip_atomic_fetch_add(p, v, __ATOMIC_RELAXED, __HIP_MEMORY_SCOPE_AGENT); }
__device__ __forceinline__ unsigned xb_xcc_id() { return (unsigned)__builtin_amdgcn_s_getreg((3 << 11) | 20) & 0xFu; }
#define XB_SPIN(cond, bar) do { unsigned _sp = 0; while (cond) { __builtin_amdgcn_s_sleep(1); \
    if ((++_sp & 255u) == 0u) { if (xb_ld(&(bar)[XB_TMO])) break; if (_sp > XB_SPIN_CAP) { atomicAdd(&(bar)[XB_TMO], 1u); break; } } } } while (0)

struct XcdBarrier {
    int wid0;
    unsigned* bar; unsigned x;
    volatile LAS unsigned* st;
};

__device__ __forceinline__ XcdBarrier xcd_barrier_post(unsigned* bar, volatile LAS unsigned* st) {
    XcdBarrier b; b.bar = bar; b.x = xb_xcc_id(); b.st = st;
    if (threadIdx.x == 0) st[4] = xb_add(&bar[XB_XCNT(b.x)], 1u);
    return b;
}
__device__ __forceinline__ void xcd_barrier_complete(unsigned* bar, unsigned x, unsigned& nloc, unsigned& nx, unsigned& uni, unsigned& xv) {
    const unsigned G = gridDim.x * gridDim.y * gridDim.z;
    unsigned sum, cnt, mine, below, odd, sp = 0u;
    for (;;) {
        sum = 0u; cnt = 0u; mine = 0u; below = 0u; odd = 0u;
#pragma unroll
        for (unsigned j = 0; j < 16; ++j) { const unsigned c = xb_ld(&bar[XB_XCNT(j)]); sum += c; cnt += (c > 0u) ? 1u : 0u; mine = (j == x) ? c : mine; below += (c > 0u && j < x) ? 1u : 0u; odd += (c > 0u && c * 8u != G) ? 1u : 0u; }
        if (sum == G) break;
        __builtin_amdgcn_s_sleep(1);
        if ((++sp & 255u) == 0u) { if (xb_ld(&bar[XB_TMO])) break; if (sp > XB_SPIN_CAP) { atomicAdd(&bar[XB_TMO], 1u); break; } }
    }
    nloc = mine > 0u ? mine : 1u; nx = cnt > 0u ? cnt : 1u;
    uni = (sum == G && cnt == 8u && odd == 0u && !PROBE_FORCE_FULL) ? 1u : 0u; xv = below;
}

__device__ __forceinline__ void xcd_barrier(const XcdBarrier& b) {
    asm volatile("s_waitcnt vmcnt(0)" ::: "memory");
    __syncthreads();
    if (opaque_tid(b.wid0) == 0) {
        unsigned* bar = b.bar;
        __builtin_amdgcn_s_waitcnt(0);
        unsigned nloc = b.st[0], nx = b.st[1];
        if (nloc == 0u) { unsigned uni, xv; xcd_barrier_complete(bar, b.x, nloc, nx, uni, xv); b.st[0] = nloc; b.st[1] = nx; b.st[2] = uni; b.st[3] = xv; }
        const unsigned old = xb_add(&bar[XB_XSUB(b.x)], 1u);
        const unsigned gen = old / nloc;
        if (old + 1u == (gen + 1u) * nloc) {
            __builtin_amdgcn_fence(__ATOMIC_RELEASE, "agent");
            asm volatile("s_waitcnt vmcnt(0)" ::: "memory");
            const unsigned og = xb_add(&bar[XB_TOP], 1u);
            const unsigned tg = og / nx;
            if (og + 1u == (tg + 1u) * nx) xb_add(&bar[XB_TOPGEN], 1u);
#if PROBE_STAMP == 7 || PROBE_STAMP == 8
            else { const unsigned long long tq0_ = __builtin_amdgcn_s_memrealtime(); XB_SPIN(xb_ld(&bar[XB_TOPGEN]) == tg, bar); atomicAdd((unsigned long long*)bar + 4096 + 1 + b.x, __builtin_amdgcn_s_memrealtime() - tq0_); }
#else
            else XB_SPIN(xb_ld(&bar[XB_TOPGEN]) == tg, bar);
#endif
            __builtin_amdgcn_fence(__ATOMIC_ACQUIRE, "agent");
            xb_add(&bar[XB_XGEN(b.x)], 1u);
            asm volatile("s_waitcnt vmcnt(0)" ::: "memory");
        } else {
            XB_SPIN(xb_ld(&bar[XB_XGEN(b.x)]) == gen, bar);
            __builtin_amdgcn_fence(__ATOMIC_ACQUIRE, "agent");
            asm volatile("s_waitcnt vmcnt(0)" ::: "memory");
        }
    }
    __syncthreads();
}

__device__ __forceinline__ void xcd_seam_local(const XcdBarrier& b, const bool wb) {
    asm volatile("s_waitcnt vmcnt(0)" ::: "memory");
    __syncthreads();
    if (opaque_tid(b.wid0) == 0) {
        unsigned* bar = b.bar;
        __builtin_amdgcn_s_waitcnt(0);
        const unsigned nloc = b.st[0];
        const unsigned old = xb_add(&bar[XB_XSUB(b.x)], 1u);
        const unsigned gen = old / nloc;
        if (old + 1u == (gen + 1u) * nloc) {
            xb_add(&bar[XB_XGEN(b.x)], 1u);
            if (wb) {
            __builtin_amdgcn_fence(__ATOMIC_RELEASE, "agent");
            asm volatile("s_waitcnt vmcnt(0)" ::: "memory");
            }
            xb_add(&bar[XB_TOPS], 1u);
        }
        else XB_SPIN(xb_ld(&bar[XB_XGEN(b.x)]) == gen, bar);
        __builtin_amdgcn_fence(__ATOMIC_ACQUIRE, "agent");
        asm volatile("s_waitcnt vmcnt(0)" ::: "memory");
    }
    __syncthreads();
}
__device__ __forceinline__ void xcd_gate(unsigned* tops, unsigned target) {
    unsigned sp = 0u;
    while (xb_ld(tops) < target) { __builtin_amdgcn_s_sleep(1); if (++sp > XB_SPIN_CAP) break; }
    asm volatile("" ::: "memory");
}

__device__ const float kInvFreq[16] = {1.000000000e+00f, 4.403665960e-01f, 1.939227432e-01f, 8.539710194e-02f, 3.760603070e-02f, 1.656044088e-02f, 7.292664610e-03f, 3.211446106e-03f,
                                       1.414213562e-03f, 6.227724371e-04f, 2.742481884e-04f, 1.207697351e-04f, 5.318295734e-05f, 2.341999971e-05f, 1.031338525e-05f, 4.541670478e-06f};

__device__ __forceinline__ void sincos_f64(float angf, float& so, float& co) {
    const double a = (double)angf;
    const double k = __builtin_rint(a * 0.63661977236758134308);
    const double r = __builtin_fma(-k, 6.123233995736766e-17, __builtin_fma(-k, 1.5707963267948966, a));
    const double r2 = r * r;
    double s = -7.6471637318198164759e-13; s = s * r2 + 1.6059043836821614599e-10; s = s * r2 - 2.5052108385441718775e-8; s = s * r2 + 2.7557319223985890653e-6;
    s = s * r2 - 1.9841269841269841270e-4; s = s * r2 + 8.3333333333333333333e-3; s = s * r2 - 1.6666666666666666667e-1; s = s * r2 * r + r;
    double c = 4.7794773323873852974e-14; c = c * r2 - 1.1470745597729724714e-11; c = c * r2 + 2.0876756987868098979e-9; c = c * r2 - 2.7557319223985890653e-7;
    c = c * r2 + 2.4801587301587301587e-5; c = c * r2 - 1.3888888888888888889e-3; c = c * r2 + 4.1666666666666666667e-2; c = c * r2 - 0.5; c = c * r2 + 1.0;
    const int q = (int)((long long)k & 3);
    const double sv = (q == 0) ? s : (q == 1) ? c : (q == 2) ? -s : -c;
    const double cv = (q == 0) ? c : (q == 1) ? -s : (q == 2) ? -c : s;
    so = (float)sv; co = (float)cv;
}

#ifndef W8BIT
#define W8BIT 0
#endif
#if W8BIT
__device__ __forceinline__ float WQ(float f) { unsigned u = __builtin_bit_cast(unsigned, f); u = (u + 0x7fffu + ((u >> 16) & 1u)) & 0xffff0000u; return __builtin_bit_cast(float, u); }
#else
#define WQ(x) (x)
#endif
struct TJob { const float* W; int K, N; bf16* WT; int mode; const float* g; const float* b; float* pcs; float* pbw; };
__device__ __forceinline__ void tr_item(const TJob& J, LAS float* scr, int item, int lane) {
    const int nblk = J.N / 32, kb = item / nblk, nb = item - kb * nblk, k0 = 64 * kb, n0 = 32 * nb;
#pragma unroll 8
    for (int i = 0; i < 32; ++i) { const int kk = 2 * i + (lane >> 5); scr[kk * 33 + (lane & 31)] = J.W[(size_t)(k0 + kk) * J.N + n0 + (lane & 31)]; }
    LDS_WAIT(); asm volatile("" ::: "memory");
    int drow0 = n0;
    if (J.mode == 2) { const int isup = n0 >= FF ? 1 : 0, hc = n0 - isup * FF; drow0 = 256 * (hc >> 7) + 128 * isup + (hc & 127); }
    const int c = lane & 7;
    float gk[8];
#pragma unroll
    for (int j = 0; j < 8; ++j) gk[j] = J.mode ? J.g[k0 + 8 * c + j] : 1.0f;
#pragma unroll
    for (int j = 0; j < 4; ++j) { const int n = (lane >> 3) + 8 * j; const LAS float* s = scr + (8 * c) * 33 + n;
        v4u o; o.x = pk2(WQ(s[0 * 33] * gk[0]), WQ(s[1 * 33] * gk[1])); o.y = pk2(WQ(s[2 * 33] * gk[2]), WQ(s[3 * 33] * gk[3])); o.z = pk2(WQ(s[4 * 33] * gk[4]), WQ(s[5 * 33] * gk[5])); o.w = pk2(WQ(s[6 * 33] * gk[6]), WQ(s[7 * 33] * gk[7]));
        *(GAS v4u*)(J.WT + (size_t)(drow0 + n) * J.K + k0 + 8 * c) = o; }
    if (J.mode) {
        float cs = 0.f, bw = 0.f; const int kh = (lane >> 5) * 32;
#pragma unroll 8
        for (int t = 0; t < 32; ++t) { const int kk = kh + t; const float w = scr[kk * 33 + (lane & 31)]; cs += bf_round(WQ(w * J.g[k0 + kk])); bw += w * J.b[k0 + kk]; }
        cs += shx(cs, 32, lane); bw += shx(bw, 32, lane);
        if (lane < 32) { J.pcs[(size_t)kb * J.N + drow0 + lane] = cs; J.pbw[(size_t)kb * J.N + drow0 + lane] = bw; }
    }
    LDS_WAIT(); asm volatile("" ::: "memory");
}

struct Args { const float* in[20]; float* out; unsigned char* ws; int ph_lo, ph_hi; };
#define CAS __attribute__((address_space(4)))
__device__ __forceinline__ const unsigned char CAS* kargs_() { const unsigned char CAS* p = (const unsigned char CAS*)__builtin_amdgcn_kernarg_segment_ptr(); asm volatile("" : "+s"(p)); return p; }
__device__ __forceinline__ const float* arg_in(int i) { return (const float*)(const GAS float*)*(const float* const CAS*)(kargs_() + 8 * i); }
__device__ __forceinline__ float* arg_out() { return (float*)(GAS float*)*(float* const CAS*)(kargs_() + 160); }
__device__ __forceinline__ unsigned char* arg_ws() { return (unsigned char*)(GAS unsigned char*)*(unsigned char* const CAS*)(kargs_() + 168); }
static_assert(sizeof(Args) == 184, "Args layout");

__device__ __forceinline__ TJob make_job(int id) {
    unsigned char* ws = arg_ws(); float* part = (float*)(ws + WS_PART);
    TJob J; J.mode = 0; J.g = nullptr; J.b = nullptr; J.pcs = nullptr; J.pbw = nullptr;
    switch (id) {
    case 0: J.W = arg_in(4); J.K = D; J.N = HW; J.WT = (bf16*)(ws + WS_W_IN); break;
    case 1: J.W = arg_in(9); J.K = D; J.N = D; J.WT = (bf16*)(ws + WS_W_OA); break;
    case 2: J.W = arg_in(10); J.K = D; J.N = NQKV; J.WT = (bf16*)(ws + WS_W_QKV); break;
    case 3: J.W = arg_in(11); J.K = AW; J.N = D; J.WT = (bf16*)(ws + WS_W_OB); break;
    case 4: case 5: { const int l = id - 4; J.W = arg_in(14) + (size_t)l * D * NGU; J.K = D; J.N = NGU; J.WT = (bf16*)(ws + WS_W_GU + l * W_GU_STRIDE); J.mode = 2;
        J.g = arg_in(12) + l * D; J.b = arg_in(13) + l * D; J.pcs = part + PART_GU + l * PART_GU_L; J.pbw = J.pcs + (size_t)KB32 * NGU; break; }
    case 6: case 7: { const int l = id - 6; J.W = arg_in(15) + (size_t)l * FF * D; J.K = FF; J.N = D; J.WT = (bf16*)(ws + WS_W_DN + l * W_DN_STRIDE); break; }
    case 8: case 9: { const int l = id - 8; J.W = arg_in(18) + (size_t)l * D * D; J.K = D; J.N = D; J.WT = (bf16*)(ws + WS_W_GT + l * W_GT_STRIDE); J.mode = 1;
        J.g = arg_in(16) + l * D; J.b = arg_in(17) + l * D; J.pcs = part + PART_GT + l * PART_GT_L; J.pbw = J.pcs + (size_t)KB32 * D; break; }
    default: { const int l = id - 10; J.W = arg_in(19) + (size_t)l * PLE * D; J.K = PLE; J.N = D; J.WT = (bf16*)(ws + WS_W_PJ + l * W_PJ_STRIDE); break; }
    }
    return J;
}
__device__ __forceinline__ int job_items(int id) {
    switch (id) { case 0: return (D / 64) * (HW / 32); case 1: return (D / 64) * (D / 32); case 2: return (D / 64) * (NQKV / 32); case 3: return (AW / 64) * (D / 32);
        case 4: case 5: return (D / 64) * (NGU / 32); case 6: case 7: return (FF / 64) * (D / 32); case 8: case 9: return (D / 64) * (D / 32); default: return (PLE / 64) * (D / 32); }
}

__device__ __forceinline__ void conv_bf16(const float* src, bf16* dst, size_t n8, size_t gt, size_t nthr) {
    size_t i = gt;
#pragma unroll 1
    for (; i + 3 * nthr < n8; i += 4 * nthr) {
        f32x4 a[4], b[4];
#pragma unroll
        for (int k = 0; k < 4; ++k) { a[k] = *(const GAS f32x4*)(src + 8 * (i + k * nthr)); b[k] = *(const GAS f32x4*)(src + 8 * (i + k * nthr) + 4); }
#pragma unroll
        for (int k = 0; k < 4; ++k) { v4u o; o.x = pk2(a[k][0], a[k][1]); o.y = pk2(a[k][2], a[k][3]); o.z = pk2(b[k][0], b[k][1]); o.w = pk2(b[k][2], b[k][3]); *(GAS v4u*)(dst + 8 * (i + k * nthr)) = o; }
    }
    for (; i < n8; i += nthr) {
        const f32x4 a = *(const GAS f32x4*)(src + 8 * i), b = *(const GAS f32x4*)(src + 8 * i + 4);
        v4u o; o.x = pk2(a[0], a[1]); o.y = pk2(a[2], a[3]); o.z = pk2(b[0], b[1]); o.w = pk2(b[2], b[3]);
        *(GAS v4u*)(dst + 8 * i) = o;
    }
}

__device__ __forceinline__ void prologue_phase(LAS unsigned char* lds, int G, int wid0) {
    const int tid = opaque_tid(wid0), lane = tid & 63, wave = tid >> 6;
    LAS float* scr = (LAS float*)(lds + wave * 16384);
    const int gw = blockIdx.x * NWAVES + wave, NGW = G * NWAVES;
#pragma unroll 1
    for (int id = 0; id < 12; ++id) {
        const TJob J = make_job(id); const int ni = job_items(id);
#pragma unroll 1
        for (int it = gw; it < ni; it += NGW) tr_item(J, scr, it, lane);
    }
    const size_t gt = (size_t)blockIdx.x * 512 + tid, nthr = (size_t)G * 512;
    conv_bf16(arg_in(7), (bf16*)(arg_ws() + WS_W_S), (size_t)16 * 128 * 128 / 8, gt, nthr);
    float* rot = (float*)(arg_ws() + WS_ROT);
    for (size_t i = gt; i < (size_t)16384 * 16; i += nthr) { const int pos = (int)(i >> 4), f = (int)(i & 15); float s, c; sincos_f64((float)pos * kInvFreq[f], s, c); rot[pos * 32 + f] = c; rot[pos * 32 + 16 + f] = s; }
}
__device__ __forceinline__ void finalize_vecs(int G, int wid0) {
    const float* part = (const float*)(arg_ws() + WS_PART); float* vec = (float*)(arg_ws() + WS_VEC);
    const int gt = blockIdx.x * 512 + opaque_tid(wid0), nthr = G * 512;
    for (int i = gt; i < 2 * 2 * NGU; i += nthr) {
        const float* p = part + PART_GU + (size_t)(i / NGU) * KB32 * NGU + (i % NGU); float s = 0.f;
        for (int kb = 0; kb < KB32; ++kb) s += p[(size_t)kb * NGU];
        vec[VEC_GU + i] = s;
    }
    for (int i = gt; i < 2 * 2 * D; i += nthr) {
        const float* p = part + PART_GT + (size_t)(i / D) * KB32 * D + (i % D); float s = 0.f;
        for (int kb = 0; kb < KB32; ++kb) s += p[(size_t)kb * D];
        vec[VEC_GT + i] = s;
    }
}

__device__ __forceinline__ void sgu_phase(LAS unsigned char* lds, const bf16* H, bf16* GATED, const bf16* WS, const float* bs, const float* lng, const float* lnb, const float* stv, int G, int slot, int wid0) {
    const int tid = opaque_tid(wid0), lane = tid & 63, wave = tid >> 6, i16 = lane & 15, kq = lane >> 4;
    LAS f32x2v* SV = (LAS f32x2v*)(lds + STAB_OFF);
    LAS float* LG = (LAS float*)(lds + 65536); LAS float* LB = LG + D;
    for (int i = tid; i < D; i += 512) { LG[i] = lng[i]; LB[i] = lnb[i]; }
#pragma unroll 1
    for (int chunk = slot; chunk < MG / 128; chunk += G) {
        const size_t row0 = (size_t)chunk * 128;
        if (tid < 128) {
            const f32x4* pq = (const f32x4*)(stv + (row0 + tid) * 16);
            const f32x4 a = pq[0], b = pq[1], c = pq[2], d = pq[3];
            const float S_ = ((a[0] + a[2]) + (b[0] + b[2])) + ((c[0] + c[2]) + (d[0] + d[2]));
            const float Q_ = ((a[1] + a[3]) + (b[1] + b[3])) + ((c[1] + c[3]) + (d[1] + d[3]));
            const float mean = S_ * (1.0f / D); float var = Q_ * (1.0f / D) - mean * mean; var = var < 0.f ? 0.f : var;
            SV[tid] = (f32x2v){mean, 1.0f / sqrtf(var + LN_EPS)};
        }
        const int p = 16 * wave + i16;
        v4u vt[4];
#define SGU_VLOAD(g_) do { _Pragma("unroll") for (int n = 0; n < 4; ++n) { const int id = tid + 512 * n, q = id >> 4, ch = id & 15; vt[n] = *(const GAS v4u*)(H + (row0 + q) * HW + D + (g_) * 128 + ch * 8); } } while (0)
        SGU_VLOAD(0);
        bf16x8 wfn[4]; float biasn = bs[p];
#pragma unroll
        for (int s = 0; s < 4; ++s) wfn[s] = *(const GAS bf16x8*)(WS + ((size_t)p) * 128 + 32 * s + 8 * kq);
        v4u uwn[4];
#pragma unroll
        for (int cp = 0; cp < 4; ++cp) uwn[cp] = *(const GAS v4u*)(H + (row0 + p) * HW + 32 * cp + 8 * kq);
        WG_BAR();
#pragma unroll 1
        for (int g = 0; g < 16; ++g) {
            LAS unsigned char* img = lds + (g & 1) * 32768;
#pragma unroll
            for (int n = 0; n < 4; ++n) {
                const int id = tid + 512 * n, q = id >> 4, ch = id & 15; const int c0 = g * 128 + ch * 8;
                const v4u d = vt[n];
                const f32x2v sr = SV[q];
                const f32x4 g0 = *(const LAS f32x4*)(LG + c0), g1 = *(const LAS f32x4*)(LG + c0 + 4), b0 = *(const LAS f32x4*)(LB + c0), b1 = *(const LAS f32x4*)(LB + c0 + 4);
                f32x4 x0, x1; x0[0] = bf_lo(d.x); x0[1] = bf_hi(d.x); x0[2] = bf_lo(d.y); x0[3] = bf_hi(d.y); x1[0] = bf_lo(d.z); x1[1] = bf_hi(d.z); x1[2] = bf_lo(d.w); x1[3] = bf_hi(d.w);
                x0 = ((x0 - sr.x) * sr.y) * g0 + b0; x1 = ((x1 - sr.x) * sr.y) * g1 + b1;
                v4u o; o.x = pk2(x0[0], x0[1]); o.y = pk2(x0[2], x0[3]); o.z = pk2(x1[0], x1[1]); o.w = pk2(x1[2], x1[3]);
                *(LAS v4u*)(img + off_b(q, ch)) = o;
            }
            bf16x8 wf[4];
#pragma unroll
            for (int s = 0; s < 4; ++s) wf[s] = wfn[s];
            const float bias = biasn;
            v4u uw[4];
#pragma unroll
            for (int cp = 0; cp < 4; ++cp) uw[cp] = uwn[cp];
            if (g < 15) { SGU_VLOAD(g + 1);
#pragma unroll
                for (int s = 0; s < 4; ++s) wfn[s] = *(const GAS bf16x8*)(WS + ((size_t)((g + 1) * 128 + p)) * 128 + 32 * s + 8 * kq);
                biasn = bs[(g + 1) * 128 + p];
#pragma unroll
                for (int cp = 0; cp < 4; ++cp) uwn[cp] = *(const GAS v4u*)(H + (row0 + p) * HW + (g + 1) * 128 + 32 * cp + 8 * kq); }
            WG_BAR();
            f32x4 acc[8];
#pragma unroll
            for (int ct = 0; ct < 8; ++ct) {
                f32x4 c4 = (f32x4){0.f, 0.f, 0.f, 0.f};
#pragma unroll
                for (int s = 0; s < 4; ++s) {
                    const unsigned qq = (unsigned)(i16 >> 2), pp = (unsigned)(lane & 3);
                    const s16x4 lo = tr_read(img + off_b(32 * s + 8 * kq + qq, 4 * (ct >> 1) + pp) + 8 * (ct & 1));
                    const s16x4 hi = tr_read(img + off_b(32 * s + 8 * kq + 4 + qq, 4 * (ct >> 1) + pp) + 8 * (ct & 1));
                    const bf16x8 af = __builtin_shufflevector(lo, hi, 0, 1, 2, 3, 4, 5, 6, 7);
                    c4 = PG8_MFMA16(af, wf[s], c4);
                }
                acc[ct] = c4;
            }
#pragma unroll
            for (int cp = 0; cp < 4; ++cp) {
                const int c = g * 128 + 32 * cp + 8 * kq;
                const f32x4 a = acc[2 * cp], b = acc[2 * cp + 1];
                v4u ow;
                ow.x = pk2((a[0] + bias) * bf_lo(uw[cp].x), (a[1] + bias) * bf_hi(uw[cp].x)); ow.y = pk2((a[2] + bias) * bf_lo(uw[cp].y), (a[3] + bias) * bf_hi(uw[cp].y));
                ow.z = pk2((b[0] + bias) * bf_lo(uw[cp].z), (b[1] + bias) * bf_hi(uw[cp].z)); ow.w = pk2((b[2] + bias) * bf_lo(uw[cp].w), (b[3] + bias) * bf_hi(uw[cp].w));
                *(GAS v4u*)(GATED + (row0 + p) * D + c) = ow;
            }
        }
#undef SGU_VLOAD
        WG_BAR();
    }
}

struct AttnUnit { int g, h, dil, L, i0; size_t tok0; };
__device__ __forceinline__ AttnUnit attn_decode(int j, int xv, int S) {
    AttnUnit A; const int ltps = 24 - __builtin_clz((unsigned)S);
    A.g = j >> 8; const int rem = j & 255; A.h = (rem >> 3) & 7; const int ls = (rem & 7) | ((rem >> 6) << 3);
    const int ldil = 2 * A.g; A.dil = 1 << ldil; A.L = S >> ldil;
    int b, r, it;
    if (ltps <= 5) { b = (xv << (5 - ltps)) + (ls >> ltps); const int wslot = ls & ((1 << ltps) - 1), ltpr = ltps - ldil; r = wslot >> ltpr; it = wslot & ((1 << ltpr) - 1); }
    else { const int lq = ltps - 5, ltq = 5 - ldil; b = xv >> lq; const int q = xv & ((1 << lq) - 1); r = ls >> ltq; it = (q << ltq) + (ls & ((1 << ltq) - 1)); }
    A.i0 = it * 128;
    A.tok0 = (size_t)b * S + r;
    return A;
}
#define ATTN_KV_LOAD(A_) do { const int j0_ = (A_).i0 - 64 + (tid >> 4); \
    const bf16* Kp_ = QKV + (A_).g * 3072 + (A_).h * 128 + 1024 + ((A_).tok0 + (size_t)((long)j0_ * (A_).dil)) * NQKV + (tid & 15) * 8; const size_t rs_ = (size_t)32 * (A_).dil * NQKV;   \
    _Pragma("unroll") for (int n = 0; n < 8; ++n) { const int j = j0_ + 32 * n; \
        kreg[n] = (v4u){zz_, zz_, zz_, zz_}; vreg[n] = (v4u){zz_, zz_, zz_, zz_}; \
        if (j >= 0 && j < (A_).L) { kreg[n] = *(const GAS v4u*)(Kp_ + n * rs_); vreg[n] = *(const GAS v4u*)(Kp_ + n * rs_ + 1024); } } } while (0)
__device__ __forceinline__ void attn_phase(LAS unsigned char* lds, bf16* QKV, float* LSE, int S, int cv, bool dry, int wid0) {
    const int tid = opaque_tid(wid0), lane = tid & 63, wave = tid >> 6, iq = lane & 15, kq = lane >> 4;
    LAS unsigned char* Kimg = lds; LAS unsigned char* Vimg = lds + 65536;
    constexpr int NU = 3 * 8 * 32; const int xv = cv & 7;
    v4u kreg[8], vreg[8];
    unsigned zz_ = 0u; asm volatile("" : "+v"(zz_));
    int u = cv >> 3;
    bf16x8 qfn[4];
#define ATTN_Q_LOAD(A_) do { const size_t qt_ = (A_).tok0 + (size_t)((A_).i0 + 16 * wave + iq) * (A_).dil; const bf16* qb_ = QKV + (A_).g * 3072 + (A_).h * 128 + qt_ * NQKV + 8 * kq; \
    _Pragma("unroll") for (int s = 0; s < 4; ++s) qfn[s] = *(const GAS bf16x8*)(qb_ + 32 * s); } while (0)
    if (u < NU) { const AttnUnit A0 = attn_decode(u, xv, S); ATTN_KV_LOAD(A0); ATTN_Q_LOAD(A0); }
#pragma unroll 1
    while (u < NU) {
        const AttnUnit A = attn_decode(u, xv, S);
        const int g = A.g, h = A.h, dil = A.dil, L = A.L, i0 = A.i0; const size_t tok0 = A.tok0;
        bf16* Qb = QKV + g * 3072 + h * 128;
#pragma unroll
        for (int n = 0; n < 8; ++n) { const int id = tid + 512 * n, kl = id >> 4, ch = id & 15; *(LAS v4u*)(Kimg + off_b(kl, ch)) = kreg[n]; *(LAS v4u*)(Vimg + off_b(kl, ch)) = vreg[n]; }
        const int qi = i0 + 16 * wave + iq; const size_t qtok = tok0 + (size_t)qi * dil;
        bf16x8 qf[4];
#pragma unroll
        for (int s = 0; s < 4; ++s) qf[s] = qfn[s];
        WG_BAR();
        const int un = u + 32;
        if (un < NU) { const AttnUnit An = attn_decode(un, xv, S); ATTN_KV_LOAD(An); ATTN_Q_LOAD(An); }
        f32x4 st[9];
#pragma unroll
        for (int T = 0; T < 9; ++T) {
            f32x4 c4 = (f32x4){0.f, 0.f, 0.f, 0.f};
#pragma unroll
            for (int s = 0; s < 4; ++s) { const bf16x8 kf = *(const LAS bf16x8*)(Kimg + off_b(16 * wave + 16 * T + iq, 4 * s + kq)); c4 = PG8_MFMA16(kf, qf[s], c4); }
            st[T] = c4;
        }
#pragma unroll
        for (int e = 0; e < 4; ++e) { if (4 * kq + e - iq < 0) st[0][e] = -1.0e30f; if (4 * kq + e - iq > 0) st[8][e] = -1.0e30f; }
        if (i0 == 0 || i0 + 192 > L) {
#pragma unroll
            for (int T = 0; T < 9; ++T)
#pragma unroll
                for (int e = 0; e < 4; ++e) { const int j = i0 + 16 * wave - 64 + 16 * T + 4 * kq + e; if (j < 0 || j >= L) st[T][e] = -1.0e30f; }
        }
        float mx = -3.0e38f;
#pragma unroll
        for (int T = 0; T < 9; ++T)
#pragma unroll
            for (int e = 0; e < 4; ++e) mx = fmaxf(mx, st[T][e]);
        mx = fmaxf(mx, shx(mx, 16, lane)); mx = fmaxf(mx, shx(mx, 32, lane));
        float den = 0.f;
#pragma unroll
        for (int T = 0; T < 9; ++T)
#pragma unroll
            for (int e = 0; e < 4; ++e) { const float pv = fast_exp2(st[T][e] - mx); st[T][e] = pv; den += pv; }
        den += shx(den, 16, lane); den += shx(den, 32, lane);
        bf16x8 pf[5];
#pragma unroll
        for (int s2 = 0; s2 < 5; ++s2) {
            v4u w; w.x = pk2(st[2 * s2][0], st[2 * s2][1]); w.y = pk2(st[2 * s2][2], st[2 * s2][3]);
            if (s2 < 4) { w.z = pk2(st[2 * s2 + 1][0], st[2 * s2 + 1][1]); w.w = pk2(st[2 * s2 + 1][2], st[2 * s2 + 1][3]); } else { w.z = 0u; w.w = 0u; }
            pf[s2] = __builtin_bit_cast(bf16x8, w);
        }
        const float inv = 1.0f / den;
        const unsigned qq = (unsigned)(iq >> 2), pp = (unsigned)(lane & 3);
#pragma unroll
        for (int cp = 0; cp < 4; ++cp) {
            f32x4 oo[2];
#pragma unroll
            for (int hc = 0; hc < 2; ++hc) {
                f32x4 o4 = (f32x4){0.f, 0.f, 0.f, 0.f};
#pragma unroll
                for (int s2 = 0; s2 < 5; ++s2) {
                    unsigned r0 = 16 * wave + 32 * s2 + 4 * kq + qq, r1 = r0 + 16; r1 = r1 > 255u ? 255u : r1;
                    const s16x4 lo = tr_read(Vimg + off_b(r0, 4 * cp + pp) + 8 * hc);
                    const s16x4 hi = tr_read(Vimg + off_b(r1, 4 * cp + pp) + 8 * hc);
                    const bf16x8 vf = __builtin_shufflevector(lo, hi, 0, 1, 2, 3, 4, 5, 6, 7);
                    o4 = PG8_MFMA16(vf, pf[s2], o4);
                }
                oo[hc] = o4;
            }
            v4u ow; ow.x = pk2(oo[0][0] * inv, oo[0][1] * inv); ow.y = pk2(oo[0][2] * inv, oo[0][3] * inv); ow.z = pk2(oo[1][0] * inv, oo[1][1] * inv); ow.w = pk2(oo[1][2] * inv, oo[1][3] * inv);
            if (!dry) *(GAS v4u*)(Qb + qtok * NQKV + 32 * cp + 8 * kq) = ow;
        }
        if (kq == 0 && !dry) LSE[(qtok * 3 + g) * 8 + h] = (mx + __builtin_amdgcn_logf(den)) * LN2;
        WG_BAR();
        u = un;
    }
}
#undef ATTN_KV_LOAD
#undef ATTN_Q_LOAD
__device__ __forceinline__ void combine_phase(const bf16* QKV, const float* LSE, bf16* ATT, int slot, int wid0) {
    const int tid = opaque_tid(wid0), ch = tid & 127, h = ch >> 4;
#pragma unroll 1
    for (int it = 0; it < 8; ++it) {
        v4u a[4], b[4], c[4]; float l0[4], l1[4], l2[4];
#pragma unroll
        for (int k = 0; k < 4; ++k) { const size_t t = (size_t)slot * 128 + it * 16 + k * 4 + (tid >> 7);
            l0[k] = LSE[(t * 3 + 0) * 8 + h]; l1[k] = LSE[(t * 3 + 1) * 8 + h]; l2[k] = LSE[(t * 3 + 2) * 8 + h];
            a[k] = *(const GAS v4u*)(QKV + t * NQKV + ch * 8); b[k] = *(const GAS v4u*)(QKV + t * NQKV + 3072 + ch * 8); c[k] = *(const GAS v4u*)(QKV + t * NQKV + 6144 + ch * 8); }
#pragma unroll
        for (int k = 0; k < 4; ++k) { const size_t t = (size_t)slot * 128 + it * 16 + k * 4 + (tid >> 7);
            const float m = fmaxf(l0[k], fmaxf(l1[k], l2[k]));
            float w0 = fast_exp2((l0[k] - m) * 1.4426950408889634f), w1 = fast_exp2((l1[k] - m) * 1.4426950408889634f), w2 = fast_exp2((l2[k] - m) * 1.4426950408889634f);
            const float inv = 1.0f / (w0 + w1 + w2); w0 *= inv; w1 *= inv; w2 *= inv;
            v4u o;
            o.x = pk2(w0 * bf_lo(a[k].x) + w1 * bf_lo(b[k].x) + w2 * bf_lo(c[k].x), w0 * bf_hi(a[k].x) + w1 * bf_hi(b[k].x) + w2 * bf_hi(c[k].x));
            o.y = pk2(w0 * bf_lo(a[k].y) + w1 * bf_lo(b[k].y) + w2 * bf_lo(c[k].y), w0 * bf_hi(a[k].y) + w1 * bf_hi(b[k].y) + w2 * bf_hi(c[k].y));
            o.z = pk2(w0 * bf_lo(a[k].z) + w1 * bf_lo(b[k].z) + w2 * bf_lo(c[k].z), w0 * bf_hi(a[k].z) + w1 * bf_hi(b[k].z) + w2 * bf_hi(c[k].z));
            o.w = pk2(w0 * bf_lo(a[k].w) + w1 * bf_lo(b[k].w) + w2 * bf_lo(c[k].w), w0 * bf_hi(a[k].w) + w1 * bf_hi(b[k].w) + w2 * bf_hi(c[k].w));
            *(GAS v4u*)(ATT + t * AW + ch * 8) = o; }
    }
}

#ifndef MK_PER_PHASE
#define MK_PER_PHASE 0
#endif
constexpr int N_PHASES = 1 + 2 * (2 + 4 + 3 + 4);
#ifndef GEMM_SP2
#define GEMM_SP2 true
#endif
#ifndef PROBE_SITE
#define PROBE_SITE 0
#endif
#define REPS(site, cond) ((PROBE_SITE == (site) && (cond)) ? 2 : 1)
#ifndef PROBE_STAMP
#define PROBE_STAMP 0
#endif
#define STAMP_GAIN 4
constexpr int CW_ACC = 8192;
__device__ __forceinline__ unsigned long long wall_() { return __builtin_amdgcn_s_memrealtime(); }

__global__ void __launch_bounds__(NWAVES * 64, 2) trunk_fwd(Args args) {
    extern __shared__ __attribute__((aligned(16))) unsigned char lds_raw[];
    LAS unsigned char* lds = (LAS unsigned char*)lds_raw;
    LAS unsigned char* xl = lds + RING_BYTES;
    const int G = gridDim.x;
    const int wid0 = __builtin_amdgcn_readfirstlane((int)threadIdx.x >> 6);
    for (int u = threadIdx.x; u < (LDS_BYTES - RING_BYTES) / 4; u += NWAVES * 64) ((LAS unsigned*)(lds + RING_BYTES))[u] = 0u;
    __syncthreads();
    const int lo = __builtin_amdgcn_readfirstlane(args.ph_lo), hi = __builtin_amdgcn_readfirstlane(args.ph_hi);
    XcdBarrier bar; bar.wid0 = wid0; bar.bar = (unsigned*)(arg_ws() + WS_CTL); bar.x = 0; bar.st = (volatile LAS unsigned*)(lds + MISC_OFF) + 8;
    if (hi - lo > 1) { bar = xcd_barrier_post((unsigned*)(arg_ws() + WS_CTL), (volatile LAS unsigned*)(lds + MISC_OFF) + 8); bar.wid0 = wid0; }
    int pc = 0, nsp = 0; unsigned gate_t = 0u, gacc = 0u; (void)gacc;
#ifndef PROBE_DBLBAR
#define PROBE_DBLBAR 0
#endif
#define RUN_PH (pc >= lo && pc < hi)
#define SEAM() do { gate_t = 0u; if (pc >= lo && pc + 1 < hi) { if (PROBE_STAMP == 1 && opaque_tid(wid0) == 0) ((volatile LAS unsigned*)(lds + MISC_OFF))[16] = (unsigned)wall_(); XcdBarrier b2_ = bar; asm volatile("" : "+s"(b2_.bar), "+s"(b2_.x)); b2_.bar = (unsigned*)(GAS unsigned*)b2_.bar; xcd_barrier(b2_); if (PROBE_DBLBAR) { xcd_barrier(b2_); xcd_barrier(b2_); } if (PROBE_STAMP == 1 && opaque_tid(wid0) == 0) atomicAdd((unsigned long long*)(arg_ws() + WS_CTL) + CW_ACC / 2, (unsigned long long)((unsigned)wall_() - ((volatile LAS unsigned*)(lds + MISC_OFF))[16])); } pc = __builtin_amdgcn_readfirstlane(pc + 1); } while (0)
#define SEAML(WB_) do { gate_t = 0u; if (pc >= lo && pc + 1 < hi) { XcdBarrier b2_ = bar; asm volatile("" : "+s"(b2_.bar), "+s"(b2_.x)); b2_.bar = (unsigned*)(GAS unsigned*)b2_.bar; \
        if (PROBE_STAMP == 1 && opaque_tid(wid0) == 0) ((volatile LAS unsigned*)(lds + MISC_OFF))[16] = (unsigned)wall_(); \
        if (__builtin_amdgcn_readfirstlane((int)((volatile LAS unsigned*)(lds + MISC_OFF))[10]) != 0) { xcd_seam_local(b2_, WB_); if (PROBE_STAMP == 1 && opaque_tid(wid0) == 0) atomicAdd((unsigned long long*)(arg_ws() + WS_CTL) + CW_ACC / 2, (unsigned long long)((unsigned)wall_() - ((volatile LAS unsigned*)(lds + MISC_OFF))[16])); nsp = __builtin_amdgcn_readfirstlane(nsp + 1); gate_t = (unsigned)nsp * 8u; } else xcd_barrier(b2_); } \
    pc = __builtin_amdgcn_readfirstlane(pc + 1); } while (0)
#define ENDGATE() do { if (gate_t != 0u) xcd_gate((unsigned*)(arg_ws() + WS_CTL) + XB_TOPS, gate_t); } while (0)
#define GATE(So_) do { (So_).gate_p = (unsigned*)(arg_ws() + WS_CTL) + XB_TOPS; (So_).gate_t = gate_t; } while (0)
#define WSP(T, off) ((T*)(arg_ws() + (off)))
#define BIGP(T, off) ((T*)(arg_ws() + WS_BIG + (off)))
#define XOUT(grp) (arg_out() + (size_t)(grp) * MG * D)
#define VECP() ((const float*)(arg_ws() + WS_VEC))
#define PH_LOCALS int grp_ = grp, layer_ = layer; asm volatile("" : "+s"(grp_), "+s"(layer_)); const int S_ = grp_ == 0 ? 2048 : 16384; (void)layer_; (void)S_; const int cv_ = __builtin_amdgcn_readfirstlane((int)((volatile LAS unsigned*)(lds + MISC_OFF))[13]), slot_ = (cv_ & 7) * 32 + (cv_ >> 3); (void)slot_

#define THIN_BEGIN unsigned long long tt0_ = 0; if (PROBE_STAMP == 2) tt0_ = wall_();
#define THIN_END if (PROBE_STAMP == 2 && opaque_tid(wid0) == 0) atomicAdd((unsigned long long*)(arg_ws() + WS_CTL) + CW_ACC / 2, wall_() - tt0_);
    if (RUN_PH) { THIN_BEGIN _Pragma("unroll 1") for (int rep = 0; rep < REPS(1, true); ++rep) prologue_phase(lds, G, wid0);
        conv_bf16(arg_in(0), WSP(bf16, WS_XB), (size_t)MG * D / 8, (size_t)blockIdx.x * 512 + opaque_tid(wid0), (size_t)G * 512); THIN_END }
    SEAM();
    { volatile LAS unsigned* st_ = (volatile LAS unsigned*)(lds + MISC_OFF) + 8; if (opaque_tid(wid0) == 0) st_[5] = st_[2] ? st_[4] * 8u + st_[3] : blockIdx.x; __syncthreads(); }
#pragma unroll 1
    for (int grp = 0; grp < 2; ++grp) {
#pragma unroll 1
        for (int layer = 0; layer < 2; ++layer) {
            if (layer == 0) {
                if (RUN_PH) { PH_LOCALS; if (grp_ == 0) finalize_vecs(G, wid0);
                    _Pragma("unroll 1") for (int rep = 0; rep < REPS(3, grp_ == 0); ++rep) {
                    pg8::Gemm g{WSP(bf16, WS_XB), WSP(const bf16, WS_W_IN), MG, HW, D, wid0}; pg8::StaticOrder So; So.init(MG, HW, G, cv_);
                    pg8::EpiPlain<1> E{BIGP(bf16, BIG_H), HW, wid0, WSP(float, WS_ST1), xl, 8};
                    pg8::gemm_phase<pg8::EpiPlain<1>, pg8::StaticOrder, true, GEMM_SP2>(lds, g, So, E);
                } ENDGATE(); }
                if (grp == 0) SEAM(); else SEAML(true);
                if (RUN_PH) { PH_LOCALS; THIN_BEGIN _Pragma("unroll 1") for (int rep = 0; rep < REPS(4, grp_ == 0); ++rep) sgu_phase(lds, BIGP(const bf16, BIG_H), BIGP(bf16, BIG_GATED), WSP(const bf16, WS_W_S), arg_in(8), arg_in(5), arg_in(6), WSP(const float, WS_ST1), G, slot_, wid0); THIN_END }
                SEAML(true);
            } else {
                if (RUN_PH) { PH_LOCALS; _Pragma("unroll 1") for (int rep = 0; rep < REPS(5, grp_ == 0); ++rep) {
                    pg8::Gemm g{WSP(bf16, WS_XB), WSP(const bf16, WS_W_QKV), MG, NQKV, D, wid0}; pg8::StaticOrder So; So.init(MG, NQKV, G, cv_); GATE(So);
                    pg8::EpiQKV E{BIGP(bf16, BIG_QKV), WSP(const float, WS_ROT), S_ - 1, QSCALE, wid0};
                    pg8::gemm_phase<pg8::EpiQKV, pg8::StaticOrder, true, GEMM_SP2>(lds, g, So, E); if (PROBE_STAMP == 9) gacc = __builtin_amdgcn_readfirstlane(gacc + So.gwait);
                } }
                if (grp == 0) SEAML(true); else SEAM();
                if (RUN_PH) { PH_LOCALS; THIN_BEGIN _Pragma("unroll 1") for (int rep = REPS(6, grp_ == 0) - 1; rep >= 0; --rep) attn_phase(lds, BIGP(bf16, BIG_QKV), BIGP(float, BIG_LSE), S_, cv_, rep != 0, wid0); THIN_END }
                SEAML(true);
                if (RUN_PH) { PH_LOCALS; THIN_BEGIN _Pragma("unroll 1") for (int rep = 0; rep < REPS(7, grp_ == 0); ++rep) combine_phase(BIGP(const bf16, BIG_QKV), BIGP(const float, BIG_LSE), BIGP(bf16, BIG_ATT), slot_, wid0); THIN_END }
                SEAML(true);
            }
            if (RUN_PH) { PH_LOCALS; _Pragma("unroll 1") for (int rep = 0; rep < REPS(8, grp_ == 0 && layer_ == 0); ++rep) {
                pg8::Gemm g{layer_ == 0 ? BIGP(const bf16, BIG_GATED) : BIGP(const bf16, BIG_ATT), layer_ == 0 ? WSP(const bf16, WS_W_OA) : WSP(const bf16, WS_W_OB), MG, D, layer_ == 0 ? D : AW, wid0};
                pg8::StaticOrder So; So.init(MG, D, G, cv_);
                pg8::EpiY1 E{(const float*)nullptr, WSP(const bf16, WS_XB), WSP(bf16, WS_XB), WSP(float, WS_ST1), xl, ALPHA, wid0};
                pg8::gemm_phase<pg8::EpiY1, pg8::StaticOrder, true, GEMM_SP2>(lds, g, So, E);
                ENDGATE();
                conv_bf16(arg_in(2 + grp_) + ((size_t)layer_ * MG + (size_t)slot_ * 128) * PLE, BIGP(bf16, BIG_PB) + (size_t)slot_ * 128 * PLE, (size_t)128 * PLE / 8, (size_t)opaque_tid(wid0), (size_t)512);
            } }
            SEAML(true);
            if (RUN_PH) { PH_LOCALS; _Pragma("unroll 1") for (int rep = 0; rep < REPS(9, grp_ == 0 && layer_ == 0); ++rep) {
                unsigned long long ck0_ = 0, cw0_ = 0; if (PROBE_STAMP == 3) { ck0_ = clock64(); cw0_ = wall_(); }
                { pg8::Gemm g{WSP(const bf16, WS_XB), WSP(const bf16, WS_W_GU + layer_ * W_GU_STRIDE), MG, NGU, D, wid0}; pg8::StaticOrder So; So.init(MG, NGU, G, cv_);
                  pg8::EpiGU E{WSP(const float, WS_ST1), VECP() + VEC_GU + layer_ * VEC_GU_L, VECP() + VEC_GU + layer_ * VEC_GU_L + NGU, BIGP(bf16, BIG_HB), xl, LN_EPS, wid0};
                  pg8::gemm_phase<pg8::EpiGU, pg8::StaticOrder, true, GEMM_SP2>(lds, g, So, E); }
                if (PROBE_STAMP == 3 && grp_ == 0 && layer_ == 0 && blockIdx.x == 0 && opaque_tid(wid0) == 0) { const unsigned long long dc = clock64() - ck0_, dw = wall_() - cw0_; atomicAdd((unsigned long long*)(arg_ws() + WS_CTL) + CW_ACC / 2, dc * 100ull / (dw ? dw : 1ull) * 100ull * 256ull / STAMP_GAIN); }
                ENDGATE();
                { int kple = PLE; asm volatile("" : "+s"(kple));
                  pg8::Gemm g{BIGP(const bf16, BIG_PB), WSP(const bf16, WS_W_PJ + layer_ * W_PJ_STRIDE), MG, D, kple, wid0}; pg8::StaticOrder So; So.init(MG, D, G, cv_);
                  pg8::EpiPlain<0> E{BIGP(bf16, BIG_PP), D, wid0};
                  pg8::gemm_phase<pg8::EpiPlain<0>, pg8::StaticOrder, true, GEMM_SP2>(lds, g, So, E); }
            } }
            SEAML(true);
            if (PROBE_SITE == 10 && RUN_PH) { PH_LOCALS; if (grp_ == 0 && layer_ == 0) {
                pg8::Gemm g{BIGP(const bf16, BIG_HB), WSP(const bf16, WS_W_DN + layer_ * W_DN_STRIDE), MG, D, FF, wid0}; pg8::StaticOrder So; So.init(MG, D, G, cv_);
                pg8::EpiY2 E{WSP(const bf16, WS_XB), BIGP(bf16, BIG_XB2), WSP(const float, WS_ST1), WSP(float, WS_ST2), arg_in(12) + layer_ * D, arg_in(13) + layer_ * D, xl, ALPHA, LN_EPS, wid0};
                pg8::gemm_phase<pg8::EpiY2, pg8::StaticOrder, true, GEMM_SP2>(lds, g, So, E);
            } }
            if (RUN_PH) { PH_LOCALS; {
                pg8::Gemm g{BIGP(const bf16, BIG_HB), WSP(const bf16, WS_W_DN + layer_ * W_DN_STRIDE), MG, D, FF, wid0}; pg8::StaticOrder So; So.init(MG, D, G, cv_);
                pg8::EpiY2 E{WSP(const bf16, WS_XB), BIGP(bf16, BIG_XB2), WSP(const float, WS_ST1), WSP(float, WS_ST2), arg_in(12) + layer_ * D, arg_in(13) + layer_ * D, xl, ALPHA, LN_EPS, wid0};
                pg8::gemm_phase<pg8::EpiY2, pg8::StaticOrder, true, GEMM_SP2>(lds, g, So, E);
            } }
            SEAML(true);
            if (RUN_PH) { PH_LOCALS; _Pragma("unroll 1") for (int rep = 0; rep < REPS(11, grp_ == 0 && layer_ == 0); ++rep) {
                pg8::Gemm g{BIGP(const bf16, BIG_XB2), WSP(const bf16, WS_W_GT + layer_ * W_GT_STRIDE), MG, D, D, wid0}; pg8::StaticOrder So; So.init(MG, D, G, cv_);
                pg8::EpiPLE E{BIGP(const bf16, BIG_XB2), layer_ == 0 ? (float*)nullptr : XOUT(grp_), WSP(bf16, WS_XB), BIGP(const bf16, BIG_PP), WSP(const float, WS_ST2), arg_in(16) + layer_ * D, arg_in(17) + layer_ * D,
                              VECP() + VEC_GT + layer_ * VEC_GT_L, VECP() + VEC_GT + layer_ * VEC_GT_L + D, xl, LN_EPS, wid0};
                pg8::gemm_phase<pg8::EpiPLE, pg8::StaticOrder, true, GEMM_SP2>(lds, g, So, E);
                }
                ENDGATE();
                if (grp_ == 0 && layer_ == 1) conv_bf16(arg_in(1) + (size_t)slot_ * 128 * D, WSP(bf16, WS_XB) + (size_t)slot_ * 128 * D, (size_t)128 * D / 8, (size_t)opaque_tid(wid0), (size_t)512);
            }
            SEAML(true);
        }
    }
    if (PROBE_STAMP == 9 && opaque_tid(wid0) == 0) atomicAdd((unsigned long long*)(arg_ws() + WS_CTL) + CW_ACC / 2, (unsigned long long)gacc);
    if (PROBE_STAMP != 0 && hi - lo > 1) {
        { XcdBarrier b2_ = bar; asm volatile("" : "+s"(b2_.bar), "+s"(b2_.x)); b2_.bar = (unsigned*)(GAS unsigned*)b2_.bar; xcd_barrier(b2_); }
        if (blockIdx.x == 0 && opaque_tid(wid0) == 0) {
            unsigned long long acc = __hip_atomic_load((unsigned long long*)(arg_ws() + WS_CTL) + CW_ACC / 2, __ATOMIC_RELAXED, __HIP_MEMORY_SCOPE_AGENT);
            if (PROBE_STAMP == 7 || PROBE_STAMP == 8) { unsigned long long mn = ~0ull, sm = 0ull; for (int j = 0; j < 8; ++j) { const unsigned long long v = __hip_atomic_load((unsigned long long*)(arg_ws() + WS_CTL) + CW_ACC / 2 + 1 + j, __ATOMIC_RELAXED, __HIP_MEMORY_SCOPE_AGENT); mn = v < mn ? v : mn; sm += v; } acc = (PROBE_STAMP == 7 ? mn : sm / 8ull) * 256ull; }
            const unsigned long long ticks = acc / 256ull * STAMP_GAIN, t0 = wall_();
            while (wall_() - t0 < ticks) __builtin_amdgcn_s_sleep(32);
        }
        __syncthreads();
    }
#undef RUN_PH
#undef SEAM
}

extern "C" void kernel_launch(void* const* d_in, const int* in_sizes, int n_in, void* d_out, int out_size, void* d_ws, size_t ws_size, hipStream_t stream) {
    static int grid = 0;
    if (grid == 0) {
        if (n_in != 20 || in_sizes[0] != MG * D || in_sizes[1] != MG * D || out_size != 2 * MG * D || ws_size < WS_END) {
            fprintf(stderr, "kernel_launch: unexpected shapes (n_in %d, in0 %d, out %d, ws %zu < %zu); nothing launched\n", n_in, n_in > 0 ? in_sizes[0] : -1, out_size, ws_size, (size_t)WS_END); grid = -1; return; }
        int dev = 0, cus = 0, per_cu = 0;
        if (hipGetDevice(&dev) != hipSuccess || hipDeviceGetAttribute(&cus, hipDeviceAttributeMultiprocessorCount, dev) != hipSuccess) { grid = -1; return; }
        if (hipFuncSetAttribute((const void*)trunk_fwd, hipFuncAttributeMaxDynamicSharedMemorySize, LDS_BYTES) != hipSuccess) { fprintf(stderr, "kernel_launch: hipFuncSetAttribute failed\n"); grid = -1; return; }
        if (hipOccupancyMaxActiveBlocksPerMultiprocessor(&per_cu, (const void*)trunk_fwd, NWAVES * 64, LDS_BYTES) != hipSuccess || per_cu < 1)
            fprintf(stderr, "kernel_launch: note: occupancy query reports %d workgroups per CU\n", per_cu);
        (void)hipGetLastError();
        grid = cus;
    }
    if (grid < 0) return;
    if (hipMemsetAsync((char*)d_ws + WS_CTL, 0, CTL_ZERO_BYTES, stream) != hipSuccess) return;
    Args a{};
    for (int i = 0; i < 20; ++i) a.in[i] = (const float*)d_in[i];
    a.out = (float*)d_out; a.ws = (unsigned char*)d_ws;
#if MK_PER_PHASE
    for (int p = 0; p < N_PHASES; ++p) { a.ph_lo = p; a.ph_hi = p + 1; hipLaunchKernelGGL(trunk_fwd, dim3(grid), dim3(NWAVES * 64), LDS_BYTES, stream, a); }
#else
    a.ph_lo = 0; a.ph_hi = N_PHASES;
    hipLaunchKernelGGL(trunk_fwd, dim3(grid), dim3(NWAVES * 64), LDS_BYTES, stream, a);
#endif
    const hipError_t le = hipPeekAtLastError();
    if (le != hipSuccess) fprintf(stderr, "kernel_launch: launch failed: %s\n", hipGetErrorName(le));
}
```

```cpp
#include <hip/hip_runtime.h>
#include <cstdio>
#include <cstdint>
namespace pg8 {
#define PG8_LAS __attribute__((address_space(3)))
typedef unsigned short bf16_t;
typedef short bf16x8 __attribute__((ext_vector_type(8)));
typedef float f32x4 __attribute__((ext_vector_type(4)));
typedef unsigned u32x4 __attribute__((ext_vector_type(4)));
constexpr int BM = 256, BK = 64, HALF = 128, HTB = HALF * BK * 2  , STAGE_BYTES = 8 * HTB, NXCD = 8, WGM = 4;

__host__ __device__ __forceinline__ int lds_byte(int r, int c) { const int st = (r >> 4) * 2 + (c >> 5), rr = r & 15, cc = c & 31, ob = rr * 64 + cc * 2; return st * 1024 + (ob ^ (((ob >> 9) & 1) << 5)); }
__host__ __device__ __forceinline__ void stage_rc(int b, int& R, int& C) { const int st = b / 1024, sb = b % 1024, swz = sb ^ (((sb >> 9) & 1) << 5); R = (st >> 1) * 16 + swz / 64; C = (st & 1) * 32 + (swz % 64) / 2; }
__host__ __device__ __forceinline__ int perm32(int rho) { const int n = rho >> 4, i = rho & 15; return 8 * (i >> 2) + 4 * n + (i & 3); }

struct Unit { int pm, pn; };
struct Gemm { const bf16_t* A; const bf16_t* Bt; int M, N, K, wid0; };

struct StaticOrder {
    int nM, nN, nwg, G, c;
    __host__ __device__ void init(int M, int N, int G_, int c_) { nM = M / BM; nN = N / BM; nwg = nM * nN; G = G_; c = c_; }
    __host__ __device__ bool next(int i, Unit& u) const {
        const long L = (long)i * G + c; if (L >= nwg) return false;
        int wgid = (int)L; { const int q = nwg / NXCD, r = nwg % NXCD, xcd = wgid % NXCD, off = wgid / NXCD; wgid = (xcd < r ? xcd * (q + 1) : r * (q + 1) + (xcd - r) * q) + off; }
        const int nig = WGM * nN, gid = wgid / nig, fm = gid * WGM, gsz = (nM - fm) < WGM ? (nM - fm) : WGM;
        u.pm = fm + ((wgid % nig) % gsz); u.pn = (wgid % nig) / gsz; return true;
    }
    __device__ __forceinline__ void a_ready(const Unit&) const {}
    __device__ __forceinline__ void done(const Unit&) const {}
    unsigned* gate_p = nullptr; unsigned gate_t = 0u; mutable unsigned gwait = 0u;
    __device__ __forceinline__ void epi_gate(int ui) const {
#if PROBE_STAMP == 9
        if (ui == 0 && gate_t != 0u) { const unsigned tg0_ = (unsigned)__builtin_amdgcn_s_memrealtime(); while (__hip_atomic_load(gate_p, __ATOMIC_RELAXED, __HIP_MEMORY_SCOPE_AGENT) < gate_t) __builtin_amdgcn_s_sleep(1);
            gwait = (unsigned)__builtin_amdgcn_s_memrealtime() - tg0_; return; }
#endif
        if (ui == 0 && gate_t != 0u) { unsigned sp = 0u; while (__hip_atomic_load(gate_p, __ATOMIC_RELAXED, __HIP_MEMORY_SCOPE_AGENT) < gate_t) { __builtin_amdgcn_s_sleep(1); if (++sp > (1u << 18)) break; } asm volatile("" ::: "memory"); }
    }
};
typedef _Float16 h16x2 __attribute__((ext_vector_type(2)));
typedef _Float16 h16x8 __attribute__((ext_vector_type(8)));
typedef float f32x2p __attribute__((ext_vector_type(2)));
#ifndef USE_BF16
#define USE_BF16 1
#endif
#if USE_BF16
__device__ __forceinline__ unsigned cvt_pk16(float lo, float hi) { unsigned r; asm volatile("v_cvt_pk_bf16_f32 %0, %1, %2" : "=v"(r) : "v"(lo), "v"(hi)); return r; }
#define PG8_MFMA16(a, b, c) __builtin_amdgcn_mfma_f32_16x16x32_bf16((a), (b), (c), 0, 0, 0)
#else
__device__ __forceinline__ unsigned cvt_pk16(float lo, float hi) { const f32x2p v = {lo, hi}; return __builtin_bit_cast(unsigned, __builtin_convertvector(v, h16x2)); }
#define PG8_MFMA16(a, b, c) __builtin_amdgcn_mfma_f32_16x16x32_f16(__builtin_bit_cast(pg8::h16x8, (a)), __builtin_bit_cast(pg8::h16x8, (b)), (c), 0, 0, 0)
#endif
typedef float f32x2 __attribute__((ext_vector_type(2)));
__device__ __forceinline__ f32x2 gelu_pk(f32x2 v) {
    const f32x2 av = __builtin_elementwise_abs(v), d = av * 0.2316418882f + 1.0f;
    f32x2 t; t.x = __builtin_amdgcn_rcpf(d.x); t.y = __builtin_amdgcn_rcpf(d.y);
    f32x2 q = t * 0.5307027145f + (-0.7265760135f); q = q * t + 0.7107068705f; q = q * t + (-0.142248368f); q = q * t + 0.127414796f; q = q * t;
    const f32x2 s = (v * v) * (-0.72134752044f);
    f32x2 e; e.x = __builtin_amdgcn_exp2f(s.x); e.y = __builtin_amdgcn_exp2f(s.y);
    const f32x2 m = v * (q * e), r = v - m;
    f32x2 o; o.x = v.x < 0.f ? m.x : r.x; o.y = v.y < 0.f ? m.y : r.y; return o;
}

template <int ACT  > struct EpiBf16 {
    static constexpr bool PERM = true, AFTER_DRAIN = false; static_assert(ACT == 0 || ACT == 1, "EpiBf16: ACT is 0 (none) or 1 (gelu_pk)");
    bf16_t* O; int ldc; const float* bias; int split_cols; size_t split_stride; float scale0;
    __device__ __forceinline__ void operator()(const f32x4 (&acc)[2][2][4][2], const Unit& u, int wr, int wc, int fr, int fq) const {
        const int row0 = u.pm * BM + wr * 64 + fr; int colt = u.pn * BM; bf16_t* base = O;
        float sc = 1.f; if (split_cols) { const int t = colt / split_cols; base += (size_t)t * split_stride; colt -= t * split_cols; if (t == 0) sc = scale0; }
        const int col0 = colt + wc * 32 + 8 * fq, bcol0 = u.pn * BM + wc * 32 + 8 * fq;
        f32x4 bv[2][2];
#pragma unroll
        for (int bj = 0; bj < 2; ++bj)
#pragma unroll
            for (int n = 0; n < 2; ++n) bv[bj][n] = bias ? *(const f32x4*)(bias + bcol0 + bj * HALF + 4 * n) : (f32x4){0.f, 0.f, 0.f, 0.f};
#pragma unroll
        for (int ai = 0; ai < 2; ++ai)
#pragma unroll
            for (int m = 0; m < 4; ++m) { bf16_t* rowp = base + (size_t)(row0 + ai * HALF + m * 16) * ldc + col0;
#pragma unroll
                for (int bj = 0; bj < 2; ++bj) { f32x4 v0 = acc[ai][bj][m][0] + bv[bj][0], v1 = acc[ai][bj][m][1] + bv[bj][1];
                    if (ACT == 1) { f32x2 a = gelu_pk((f32x2){v0[0], v0[1]}), b = gelu_pk((f32x2){v0[2], v0[3]}), c = gelu_pk((f32x2){v1[0], v1[1]}), d = gelu_pk((f32x2){v1[2], v1[3]});
                        v0 = (f32x4){a.x, a.y, b.x, b.y}; v1 = (f32x4){c.x, c.y, d.x, d.y}; }
                    v0 = v0 * sc; v1 = v1 * sc; u32x4 w; w.x = cvt_pk16(v0[0], v0[1]); w.y = cvt_pk16(v0[2], v0[3]); w.z = cvt_pk16(v1[0], v1[1]); w.w = cvt_pk16(v1[2], v1[3]);
                    *(u32x4*)(rowp + bj * HALF) = w; } }
    }
};
}

constexpr int D = 2048, FF = 5632, NGU = 2 * FF, NQKV = 9216, AW = 1024, PLE = 256, HW = 4096;
constexpr int MG = 32768;
constexpr float LN_EPS = 1e-5f;
constexpr float ALPHA = 1.4142135623730951f;
constexpr float QSCALE = 0.08838834764831845f * 1.4426950408889634f;
constexpr float LN2 = 0.6931471805599453f;
constexpr int NWAVES = 8;

constexpr size_t MiB = 1u << 20;
constexpr size_t WS_CTL = 0, CTL_ZERO_BYTES = 65536;
constexpr size_t WS_ROT = 2 * MiB;
constexpr size_t WS_ST1 = 4 * MiB, WS_ST2 = 6 * MiB;
constexpr size_t WS_PART = 8 * MiB;
constexpr size_t WS_VEC = 16 * MiB;
constexpr size_t WS_W_IN = 17 * MiB, WS_W_OA = 33 * MiB, WS_W_S = 41 * MiB, WS_W_QKV = 42 * MiB, WS_W_OB = 78 * MiB;
constexpr size_t WS_W_GU = 82 * MiB, W_GU_STRIDE = 44 * MiB, WS_W_DN = 170 * MiB, W_DN_STRIDE = 22 * MiB;
constexpr size_t WS_W_GT = 214 * MiB, W_GT_STRIDE = 8 * MiB, WS_W_PJ = 230 * MiB, W_PJ_STRIDE = 1 * MiB;
constexpr size_t WS_XB = 232 * MiB;
constexpr size_t WS_BIG = 360 * MiB;
constexpr size_t BIG_H = 0, BIG_GATED = 384 * MiB, BIG_PB = 644 * MiB, BIG_XB2 = 384 * MiB, BIG_HB = 0, BIG_PP = 512 * MiB;
constexpr size_t BIG_QKV = 0, BIG_ATT = 576 * MiB, BIG_LSE = 640 * MiB;
constexpr size_t WS_END = WS_BIG + 660 * MiB;
constexpr int KB32 = 32;
constexpr size_t PART_GU = 0, PART_GU_L = (size_t)2 * KB32 * NGU, PART_GT = 2 * PART_GU_L, PART_GT_L = (size_t)2 * KB32 * D;
constexpr size_t VEC_GU = 0, VEC_GU_L = 2 * NGU, VEC_GT = 2 * VEC_GU_L, VEC_GT_L = 2 * D;
static_assert((PART_GT + 2 * PART_GT_L) * 4 <= 8 * MiB && (VEC_GT + 2 * VEC_GT_L) * 4 <= 1 * MiB, "partials");

constexpr int RING_BYTES = 131072;
constexpr int MISC_OFF = RING_BYTES + 320;
constexpr int STAB_OFF = RING_BYTES + 512;
constexpr int PTAB_OFF = STAB_OFF + 2048;
constexpr int LDS_BYTES = 147456;
static_assert(PTAB_OFF + 8192 <= LDS_BYTES, "LDS map");

#define GAS __attribute__((address_space(1)))
#define LAS __attribute__((address_space(3)))
typedef unsigned short bf16;
typedef unsigned v4u __attribute__((ext_vector_type(4)));
typedef unsigned v2u __attribute__((ext_vector_type(2)));
typedef float f32x4 __attribute__((ext_vector_type(4)));
typedef float f32x2v __attribute__((ext_vector_type(2)));
typedef short bf16x8 __attribute__((ext_vector_type(8)));
typedef short s16x4 __attribute__((ext_vector_type(4)));
#define LDS_WAIT() asm volatile("s_waitcnt lgkmcnt(0)" ::: "memory")
#define VM_WAIT() asm volatile("s_waitcnt vmcnt(0)" ::: "memory")
#define WG_BAR() do { asm volatile("s_waitcnt lgkmcnt(0)" ::: "memory"); __builtin_amdgcn_s_barrier(); asm volatile("" ::: "memory"); } while (0)

#if USE_BF16
__device__ __forceinline__ float bf_round(float f) { unsigned u = __builtin_bit_cast(unsigned, f); u = (u + 0x7fffu + ((u >> 16) & 1u)) & 0xffff0000u; return __builtin_bit_cast(float, u); }
#else
__device__ __forceinline__ float bf_round(float f) { return (float)(_Float16)f; }
#endif
__device__ __forceinline__ unsigned pk2(float lo, float hi) { return pg8::cvt_pk16(lo, hi); }
#if USE_BF16
__device__ __forceinline__ float bf_lo(unsigned w) { return __builtin_bit_cast(float, w << 16); }
__device__ __forceinline__ float bf_hi(unsigned w) { return __builtin_bit_cast(float, w & 0xffff0000u); }
#else
__device__ __forceinline__ float bf_lo(unsigned w) { return (float)__builtin_bit_cast(pg8::h16x2, w).x; }
__device__ __forceinline__ float bf_hi(unsigned w) { return (float)__builtin_bit_cast(pg8::h16x2, w).y; }
#endif
__device__ __forceinline__ int opaque_tid(int wid0) { int t; asm volatile("v_mbcnt_lo_u32_b32 %0, -1, 0\n\tv_mbcnt_hi_u32_b32 %0, -1, %0" : "=v"(t)); return (wid0 << 6) | t; }
__device__ __forceinline__ float shx(float v, int mask, int lane) { return __builtin_bit_cast(float, __builtin_amdgcn_ds_bpermute((lane ^ mask) << 2, __builtin_bit_cast(int, v))); }
__device__ __forceinline__ float wave_sum(float v, int lane) {
#pragma unroll
    for (int o = 1; o < 64; o <<= 1) v += shx(v, o, lane);
    return v;
}
__device__ __forceinline__ float fast_exp2(float x) { return __builtin_amdgcn_exp2f(x); }
__device__ __forceinline__ float fast_rcp(float x) { return __builtin_amdgcn_rcpf(x); }
__device__ __forceinline__ float sigmoidf_(float x) { return fast_rcp(1.0f + fast_exp2(-1.4426950408889634f * x)); }
__device__ __forceinline__ unsigned off_b(unsigned row, unsigned ch) { return 256u * row + 16u * (ch ^ (((row & 3u) << 2) | ((row >> 2) & 3u))); }
typedef short v4i16_t __attribute__((ext_vector_type(4)));
__device__ __forceinline__ s16x4 tr_read(LAS const unsigned char* p) { return __builtin_bit_cast(s16x4, __builtin_amdgcn_ds_read_tr16_b64_v4i16((LAS v4i16_t*)p)); }

namespace pg8 {
__device__ __forceinline__ void stab_from_partials(const float* st, int pm, PG8_LAS unsigned char* xl, float eps, int wid0) {
    const int tid = opaque_tid(wid0);
    if (tid < 256) {
        const f32x4* p = (const f32x4*)(st + ((size_t)(pm * BM + tid)) * 16);
        const f32x4 a = p[0], b = p[1], c = p[2], d = p[3];
        const float S = ((a[0] + a[2]) + (b[0] + b[2])) + ((c[0] + c[2]) + (d[0] + d[2]));
        const float Q = ((a[1] + a[3]) + (b[1] + b[3])) + ((c[1] + c[3]) + (d[1] + d[3]));
        const float mean = S * (1.0f / 2048.0f); float var = Q * (1.0f / 2048.0f) - mean * mean; var = var < 0.f ? 0.f : var;
        ((PG8_LAS f32x2*)(xl + (STAB_OFF - RING_BYTES)))[tid] = (f32x2){mean, 1.0f / sqrtf(var + eps)};
    }
    asm volatile("s_waitcnt lgkmcnt(0)" ::: "memory"); __builtin_amdgcn_s_barrier(); asm volatile("" ::: "memory");
}
__device__ __forceinline__ void partials_to_st(float* st, const Unit& u, PG8_LAS unsigned char* xl, int wid0) {
    asm volatile("s_waitcnt lgkmcnt(0)" ::: "memory"); __builtin_amdgcn_s_barrier(); asm volatile("" ::: "memory");
    const int tid = opaque_tid(wid0);
    if (tid < 256) {
        const PG8_LAS f32x4* P = (const PG8_LAS f32x4*)(xl + (PTAB_OFF - RING_BYTES)) + tid * 2;
        const f32x4 a = P[0], b = P[1];
        f32x2 o; o.x = (a[0] + a[2]) + (b[0] + b[2]); o.y = (a[1] + a[3]) + (b[1] + b[3]);
        *(f32x2*)(st + ((size_t)(u.pm * BM + tid) * 8 + u.pn) * 2) = o;
    }
}
#ifndef NT_STREAM
#define NT_STREAM 1
#endif
#if NT_STREAM
#define NT_STORE16(p, v) __builtin_nontemporal_store((v), (u32x4*)(p))
#else
#define NT_STORE16(p, v) (*(u32x4*)(p) = (v))
#endif
struct LaneId { int wr, wc, fr, fq; };
__device__ __forceinline__ LaneId lane_id(int wid0) { const int t = opaque_tid(wid0); const int wid = wid0, lane = t & 63; LaneId L; L.wr = wid >> 2; L.wc = wid & 3; L.fr = lane & 15; L.fq = lane >> 4; return L; }
__device__ __forceinline__ f32x4 fma4(f32x4 a, float k, float c) { return a * k + c; }
__device__ __forceinline__ f32x4 sigmoid4(f32x4 t) {
    const f32x4 m = t * (-1.4426950408889634f); f32x4 e;
    e[0] = __builtin_amdgcn_exp2f(m[0]); e[1] = __builtin_amdgcn_exp2f(m[1]); e[2] = __builtin_amdgcn_exp2f(m[2]); e[3] = __builtin_amdgcn_exp2f(m[3]);
    const f32x4 d = e + 1.0f; f32x4 r;
    r[0] = __builtin_amdgcn_rcpf(d[0]); r[1] = __builtin_amdgcn_rcpf(d[1]); r[2] = __builtin_amdgcn_rcpf(d[2]); r[3] = __builtin_amdgcn_rcpf(d[3]);
    return r;
}
#define PG8_ROWSUM(s, q, v) do { s += ((v)[0] + (v)[1]) + ((v)[2] + (v)[3]); q += ((v)[0] * (v)[0] + (v)[1] * (v)[1]) + ((v)[2] * (v)[2] + (v)[3] * (v)[3]); } while (0)

template <int ACT> struct EpiPlain {
    static constexpr bool PERM = true, AFTER_DRAIN = false;
    bf16_t* O; int ldc; int wid0; float* st = nullptr; PG8_LAS unsigned char* xl = nullptr; int st_pn0 = 0;
    __device__ __forceinline__ void operator()(const f32x4 (&acc)[2][2][4][2], const Unit& u, int, int, int, int) const {
        const LaneId L_ = lane_id(wid0); const int wr = L_.wr, wc = L_.wc, fr = L_.fr, fq = L_.fq;
        const int row0 = u.pm * BM + wr * 64 + fr, col0 = u.pn * BM + wc * 32 + 8 * fq, ln_ = fr + 16 * fq;
        const bool stats = st != nullptr && u.pn >= st_pn0;
        PG8_LAS f32x2* P = (PG8_LAS f32x2*)(xl + (PTAB_OFF - RING_BYTES));
#pragma unroll
        for (int ai = 0; ai < 2; ++ai)
#pragma unroll
            for (int m = 0; m < 4; ++m) { bf16_t* rowp = O + (size_t)(row0 + ai * HALF + m * 16) * ldc + col0; float ss = 0.f, qq = 0.f;
#pragma unroll
                for (int bj = 0; bj < 2; ++bj) { f32x4 v0 = acc[ai][bj][m][0], v1 = acc[ai][bj][m][1];
                    if (ACT == 1) { f32x2 a = gelu_pk((f32x2){v0[0], v0[1]}), b = gelu_pk((f32x2){v0[2], v0[3]}), c = gelu_pk((f32x2){v1[0], v1[1]}), d = gelu_pk((f32x2){v1[2], v1[3]});
                        v0 = (f32x4){a.x, a.y, b.x, b.y}; v1 = (f32x4){c.x, c.y, d.x, d.y}; }
                    if (stats) { PG8_ROWSUM(ss, qq, v0); PG8_ROWSUM(ss, qq, v1); }
                    u32x4 w; w.x = cvt_pk16(v0[0], v0[1]); w.y = cvt_pk16(v0[2], v0[3]); w.z = cvt_pk16(v1[0], v1[1]); w.w = cvt_pk16(v1[2], v1[3]);
                    NT_STORE16(rowp + bj * HALF, w); }
                if (stats) { ss += shx(ss, 16, ln_); qq += shx(qq, 16, ln_); ss += shx(ss, 32, ln_); qq += shx(qq, 32, ln_);
                    if (fq == 0) P[(ai * HALF + wr * 64 + m * 16 + fr) * 4 + wc] = (f32x2){ss, qq}; } }
        if (stats) { Unit u2 = u; u2.pn = u.pn - st_pn0; partials_to_st(st, u2, xl, wid0); }
    }
};
struct EpiQKV {
    static constexpr bool PERM = true, AFTER_DRAIN = false;
    bf16_t* O; const float* rot; int seq_mask; float qscale; int wid0;
    __device__ __forceinline__ void operator()(const f32x4 (&acc)[2][2][4][2], const Unit& u, int, int, int, int) const {
        const LaneId L_ = lane_id(wid0); const int wr = L_.wr, wc = L_.wc, fr = L_.fr, fq = L_.fq;
        const int colt = u.pn * BM, tsel = (colt % 3072) / 1024;
        const float sc = tsel == 0 ? qscale : 1.0f;
        const bool dorot = (tsel < 2) && (wc == 0);
        const int row0 = u.pm * BM + wr * 64 + fr, col0 = colt + wc * 32 + 8 * fq;
        const float sgn = fq < 2 ? -1.0f : 1.0f;
#pragma unroll
        for (int ai = 0; ai < 2; ++ai)
#pragma unroll
            for (int m = 0; m < 4; ++m) {
                const int row = row0 + ai * HALF + m * 16;
                f32x4 cs[2], sn[2];
                if (dorot) { const float* rp = rot + (size_t)(row & seq_mask) * 32 + 8 * (fq & 1);
                    cs[0] = *(const f32x4*)(rp); cs[1] = *(const f32x4*)(rp + 4); sn[0] = *(const f32x4*)(rp + 16); sn[1] = *(const f32x4*)(rp + 20); }
#pragma unroll
                for (int bj = 0; bj < 2; ++bj) {
                    f32x4 v[2] = {acc[ai][bj][m][0], acc[ai][bj][m][1]};
                    if (dorot) {
#pragma unroll
                        for (int n = 0; n < 2; ++n) { f32x4 pr;
#pragma unroll
                            for (int j = 0; j < 4; ++j) pr[j] = shx(v[n][j], 32, fr + 16 * fq);
                            v[n] = v[n] * cs[n] + (pr * sn[n]) * sgn; }
                    }
                    v[0] = v[0] * sc; v[1] = v[1] * sc;
                    u32x4 w; w.x = cvt_pk16(v[0][0], v[0][1]); w.y = cvt_pk16(v[0][2], v[0][3]); w.z = cvt_pk16(v[1][0], v[1][1]); w.w = cvt_pk16(v[1][2], v[1][3]);
                    NT_STORE16(O + (size_t)row * NQKV + col0 + bj * HALF, w);
                }
            }
    }
};
#define PG8_UNPACK8(W_, v0, v1) do { v0[0] = bf_lo((W_)[0]); v0[1] = bf_hi((W_)[0]); v0[2] = bf_lo((W_)[1]); v0[3] = bf_hi((W_)[1]); v1[0] = bf_lo((W_)[2]); v1[1] = bf_hi((W_)[2]); v1[2] = bf_lo((W_)[3]); v1[3] = bf_hi((W_)[3]); } while (0)
#define PG8_PACK8(W_, v0, v1) do { (W_)[0] = cvt_pk16(v0[0], v0[1]); (W_)[1] = cvt_pk16(v0[2], v0[3]); (W_)[2] = cvt_pk16(v1[0], v1[1]); (W_)[3] = cvt_pk16(v1[2], v1[3]); } while (0)
struct EpiY1 {
    static constexpr bool PERM = true, AFTER_DRAIN = false;
    const float* xin32; const bf16_t* xin16; bf16_t* yb; float* st; PG8_LAS unsigned char* xl; float alpha; int wid0;
    __device__ __forceinline__ void operator()(const f32x4 (&acc)[2][2][4][2], const Unit& u, int, int, int, int) const {
        const LaneId L_ = lane_id(wid0); const int wr = L_.wr, wc = L_.wc, fr = L_.fr, fq = L_.fq;
        const int row0 = u.pm * BM + wr * 64 + fr, col0 = u.pn * BM + wc * 32 + 8 * fq, ln_ = fr + 16 * fq;
        PG8_LAS f32x2* P = (PG8_LAS f32x2*)(xl + (PTAB_OFF - RING_BYTES));
        const unsigned eb0 = (unsigned)(row0 * D + col0) * 2u;
        u32x4 xw[2][4];
#pragma unroll
        for (int m = 0; m < 4; ++m) xw[0][m] = *(const u32x4*)(((const char*)xin16 + (size_t)(m * 16 * D) * 2) + (size_t)eb0);
#pragma unroll
        for (int ai = 0; ai < 2; ++ai) {
            float s[4] = {0.f, 0.f, 0.f, 0.f}, q[4] = {0.f, 0.f, 0.f, 0.f};
#pragma unroll
            for (int bj = 0; bj < 2; ++bj) {
                const int b = ai * 2 + bj;
                if (b < 3) { const int ai2 = (b + 1) >> 1, bj2 = (b + 1) & 1;
#pragma unroll
                    for (int m = 0; m < 4; ++m) xw[(b + 1) & 1][m] = *(const u32x4*)(((const char*)xin16 + (size_t)((ai2 * HALF + m * 16) * D + bj2 * HALF) * 2) + (size_t)eb0); }
#pragma unroll
                for (int m = 0; m < 4; ++m) {
                    f32x4 x0, x1; PG8_UNPACK8(xw[b & 1][m], x0, x1);
                    const f32x4 y0 = x0 * alpha + acc[ai][bj][m][0], y1 = x1 * alpha + acc[ai][bj][m][1];
                    u32x4 w; PG8_PACK8(w, y0, y1); *(u32x4*)(((char*)yb + (size_t)((ai * HALF + m * 16) * D + bj * HALF) * 2) + (size_t)eb0) = w;
                    PG8_ROWSUM(s[m], q[m], y0); PG8_ROWSUM(s[m], q[m], y1); }
                asm volatile("" ::: "memory");
            }
#pragma unroll
            for (int m = 0; m < 4; ++m) { float ss = s[m], qq = q[m]; ss += shx(ss, 16, ln_); qq += shx(qq, 16, ln_); ss += shx(ss, 32, ln_); qq += shx(qq, 32, ln_);
                if (fq == 0) P[(ai * HALF + wr * 64 + m * 16 + fr) * 4 + wc] = (f32x2){ss, qq}; }
        }
        partials_to_st(st, u, xl, wid0);
    }
};
struct EpiGU {
    static constexpr bool PERM = true, AFTER_DRAIN = false;
    const float* st; const float* cs; const float* bw; bf16_t* H; PG8_LAS unsigned char* xl; float eps; int wid0; mutable int last_pm = -1;
    __device__ __forceinline__ void operator()(const f32x4 (&acc)[2][2][4][2], const Unit& u, int, int, int, int) const {
        const LaneId L_ = lane_id(wid0); const int wr = L_.wr, wc = L_.wc, fr = L_.fr, fq = L_.fq;
        if (u.pm != last_pm) { stab_from_partials(st, u.pm, xl, eps, wid0); last_pm = u.pm; }
        const PG8_LAS f32x2* S = (const PG8_LAS f32x2*)(xl + (STAB_OFF - RING_BYTES));
        const int row0 = u.pm * BM + wr * 64 + fr, col0 = u.pn * BM + wc * 32 + 8 * fq, hcol0 = u.pn * HALF + wc * 32 + 8 * fq;
        f32x4 csv[2][2], bwv[2][2];
#pragma unroll
        for (int bj = 0; bj < 2; ++bj)
#pragma unroll
            for (int n = 0; n < 2; ++n) { csv[bj][n] = *(const f32x4*)(cs + col0 + bj * HALF + 4 * n); bwv[bj][n] = *(const f32x4*)(bw + col0 + bj * HALF + 4 * n); }
#pragma unroll
        for (int ai = 0; ai < 2; ++ai)
#pragma unroll
            for (int m = 0; m < 4; ++m) {
                const int rl = ai * HALF + wr * 64 + m * 16 + fr; const f32x2 sr = S[rl]; const float nmr = -sr.x * sr.y;
                f32x4 h[2];
#pragma unroll
                for (int n = 0; n < 2; ++n) {
                    const f32x4 g = acc[ai][0][m][n] * sr.y + (csv[0][n] * nmr + bwv[0][n]);
                    const f32x4 uu = acc[ai][1][m][n] * sr.y + (csv[1][n] * nmr + bwv[1][n]);
                    h[n] = (g * sigmoid4(g)) * uu;
                }
                u32x4 w; w.x = cvt_pk16(h[0][0], h[0][1]); w.y = cvt_pk16(h[0][2], h[0][3]); w.z = cvt_pk16(h[1][0], h[1][1]); w.w = cvt_pk16(h[1][2], h[1][3]);
                NT_STORE16(H + (size_t)(row0 + ai * HALF + m * 16) * FF + hcol0, w);
            }
    }
};
struct EpiY2 {
    static constexpr bool PERM = true, AFTER_DRAIN = false;
    const bf16_t* y1b; bf16_t* yb; const float* st1; float* st2; const float* lng; const float* lnb; PG8_LAS unsigned char* xl; float alpha, eps; int wid0; mutable int last_pm = -1;
    __device__ __forceinline__ void operator()(const f32x4 (&acc)[2][2][4][2], const Unit& u, int, int, int, int) const {
        const LaneId L_ = lane_id(wid0); const int wr = L_.wr, wc = L_.wc, fr = L_.fr, fq = L_.fq;
        const int row0 = u.pm * BM + wr * 64 + fr, col0 = u.pn * BM + wc * 32 + 8 * fq, ln_ = fr + 16 * fq;
        const unsigned eb0 = (unsigned)(row0 * D + col0) * 2u;
        u32x4 aw[2][4];
#define PG8_Y2_LOAD(buf, k) do { _Pragma("unroll") for (int m = 0; m < 4; ++m) aw[buf][m] = *(const u32x4*)(((const char*)y1b + (size_t)(((((k) >> 1) * HALF + m * 16) * D + ((k) & 1) * HALF) * 2)) + (size_t)eb0); } while (0)
        PG8_Y2_LOAD(0, 0); PG8_Y2_LOAD(1, 1);
        if (u.pm != last_pm) { stab_from_partials(st1, u.pm, xl, eps, wid0); last_pm = u.pm; }
        const PG8_LAS f32x2* S = (const PG8_LAS f32x2*)(xl + (STAB_OFF - RING_BYTES));
        PG8_LAS f32x2* P = (PG8_LAS f32x2*)(xl + (PTAB_OFF - RING_BYTES));
        f32x4 gv[2][2], bv[2][2];
#pragma unroll
        for (int bj = 0; bj < 2; ++bj)
#pragma unroll
            for (int n = 0; n < 2; ++n) { gv[bj][n] = *(const f32x4*)(lng + col0 + bj * HALF + 4 * n); bv[bj][n] = *(const f32x4*)(lnb + col0 + bj * HALF + 4 * n); }
#pragma unroll
        for (int ai = 0; ai < 2; ++ai) {
            float s[4] = {0.f, 0.f, 0.f, 0.f}, q[4] = {0.f, 0.f, 0.f, 0.f}; f32x2 sr[4];
#pragma unroll
            for (int m = 0; m < 4; ++m) sr[m] = S[ai * HALF + wr * 64 + m * 16 + fr];
#pragma unroll
            for (int bj = 0; bj < 2; ++bj) {
                const int k = ai * 2 + bj, buf = k & 1;
#pragma unroll
                for (int m = 0; m < 4; ++m) { const size_t cofs = (size_t)(((ai * HALF + m * 16) * D + bj * HALF) * 2);
                    f32x4 a0, a1; PG8_UNPACK8(aw[buf][m], a0, a1);
                    const float nmr = -sr[m].x * sr[m].y; const f32x4 x0 = fma4(a0, sr[m].y, nmr) * gv[bj][0] + bv[bj][0], x1 = fma4(a1, sr[m].y, nmr) * gv[bj][1] + bv[bj][1];
                    const f32x4 y0 = x0 * alpha + acc[ai][bj][m][0], y1 = x1 * alpha + acc[ai][bj][m][1];
                    u32x4 w; PG8_PACK8(w, y0, y1); *(u32x4*)(((char*)yb + cofs) + (size_t)eb0) = w;
                    PG8_ROWSUM(s[m], q[m], y0); PG8_ROWSUM(s[m], q[m], y1); }
                if (k < 2) PG8_Y2_LOAD(buf, k + 2);
            }
#pragma unroll
            for (int m = 0; m < 4; ++m) { float ss = s[m], qq = q[m]; ss += shx(ss, 16, ln_); qq += shx(qq, 16, ln_); ss += shx(ss, 32, ln_); qq += shx(qq, 32, ln_);
                if (fq == 0) P[(ai * HALF + wr * 64 + m * 16 + fr) * 4 + wc] = (f32x2){ss, qq}; }
        }
#undef PG8_Y2_LOAD
        partials_to_st(st2, u, xl, wid0);
    }
};
struct EpiPLE {
    static constexpr bool PERM = true, AFTER_DRAIN = false;
    const bf16_t* y2b; float* out32; bf16_t* xb; const bf16_t* pp; const float* st2; const float* lng; const float* lnb; const float* cs; const float* bw; PG8_LAS unsigned char* xl; float eps; int wid0; mutable int last_pm = -1;
    __device__ __forceinline__ void operator()(const f32x4 (&acc)[2][2][4][2], const Unit& u, int, int, int, int) const {
        const LaneId L_ = lane_id(wid0); const int wr = L_.wr, wc = L_.wc, fr = L_.fr, fq = L_.fq;
        const int row0 = u.pm * BM + wr * 64 + fr, col0 = u.pn * BM + wc * 32 + 8 * fq;
        const unsigned eb0 = (unsigned)(row0 * D + col0) * 2u;
        u32x4 aw[2][2], pw[2][2];
#define PLE_LOAD(hb_) do { const int bj_ = (hb_) >> 2, ai_ = ((hb_) >> 1) & 1, mh_ = (hb_) & 1; _Pragma("unroll") for (int r_ = 0; r_ < 2; ++r_) { const size_t co_ = (size_t)((ai_ * HALF + (2 * mh_ + r_) * 16) * D + bj_ * HALF) * 2; \
            aw[(hb_) & 1][r_] = *(const u32x4*)(((const char*)y2b + co_) + (size_t)eb0); pw[(hb_) & 1][r_] = *(const u32x4*)(((const char*)pp + co_) + (size_t)eb0); } } while (0)
        PLE_LOAD(0);
        if (u.pm != last_pm) { stab_from_partials(st2, u.pm, xl, eps, wid0); last_pm = u.pm; }
        const PG8_LAS f32x2* S = (const PG8_LAS f32x2*)(xl + (STAB_OFF - RING_BYTES));
#pragma unroll
        for (int bj = 0; bj < 2; ++bj) {
            f32x4 gv[2], bv[2], csv[2], bwv[2];
#pragma unroll
            for (int n = 0; n < 2; ++n) { const int c = col0 + bj * HALF + 4 * n; gv[n] = *(const f32x4*)(lng + c); bv[n] = *(const f32x4*)(lnb + c); csv[n] = *(const f32x4*)(cs + c); bwv[n] = *(const f32x4*)(bw + c); }
#pragma unroll
            for (int ai = 0; ai < 2; ++ai) {
#pragma unroll
                for (int mh = 0; mh < 2; ++mh) {
                    const int hb = bj * 4 + ai * 2 + mh;
                    if (hb < 7) PLE_LOAD(hb + 1);
#pragma unroll
                    for (int r = 0; r < 2; ++r) {
                        const int m = 2 * mh + r, rl = ai * HALF + wr * 64 + m * 16 + fr; const size_t co = (size_t)((ai * HALF + m * 16) * D + bj * HALF); const f32x2 sr = S[rl];
                        f32x4 a0, a1, p0, p1; PG8_UNPACK8(aw[hb & 1][r], a0, a1); PG8_UNPACK8(pw[hb & 1][r], p0, p1);
                        const float nmr = -sr.x * sr.y; const f32x4 x0 = fma4(a0, sr.y, nmr) * gv[0] + bv[0], x1 = fma4(a1, sr.y, nmr) * gv[1] + bv[1];
                        const f32x4 t0 = acc[ai][bj][m][0] * sr.y + (csv[0] * nmr + bwv[0]), t1 = acc[ai][bj][m][1] * sr.y + (csv[1] * nmr + bwv[1]);
                        const f32x4 o0 = x0 + sigmoid4(t0) * p0, o1 = x1 + sigmoid4(t1) * p1;
                        if (out32) { float* op = (float*)(((char*)out32 + co * 4) + (size_t)eb0 * 2); __builtin_nontemporal_store(o0, (f32x4*)op); __builtin_nontemporal_store(o1, (f32x4*)(op + 4)); }
                        else { u32x4 w; PG8_PACK8(w, o0, o1); *(u32x4*)(((char*)xb + co * 2) + (size_t)eb0) = w; }
                    }
                    asm volatile("" ::: "memory");
                }
            }
        }
#undef PLE_LOAD
    }
};
}
namespace pg8 {
template <class Epi, class Sched, bool ALIGN_EPI = false, bool SP2 = false>
__device__ __forceinline__ void gemm_phase(PG8_LAS unsigned char* lds, const Gemm g, const Sched& S, const Epi& E) {
    int wid_ = g.wid0; asm volatile("" : "+s"(wid_));     const int tid = opaque_tid(wid_), wid = wid_, lane = tid & 63, wr = wid >> 2, wc = wid & 3, fr = lane & 15, fq = lane >> 4;
    const int K = g.K, nt = K / BK;
    unsigned voffA[2], voffB[2];
#pragma unroll
    for (int i = 0; i < 2; ++i) { int R, C; stage_rc(tid * 16 + i * 8192, R, C); const int Rb = Epi::PERM ? ((R & ~31) + perm32(R & 31)) : R;
        voffA[i] = (unsigned)(R * K + C) * 2u; voffB[i] = (unsigned)(Rb * K + C) * 2u; }
    const size_t kstep = (size_t)(BK * 2);
    const size_t hstep = (size_t)HALF * K * 2;
    const size_t tstep = 2 * hstep;
    const unsigned ldsw = (unsigned)wid * 1024u;
    const int aoff = lds_byte(wr * 64 + fr, fq * 8), boff = lds_byte(wc * 32 + fr, fq * 8);
#define PG8_SA(b, h) (((b) * 2 + (h)) * HTB)
#define PG8_SB(b, h) ((4 + (b) * 2 + (h)) * HTB)
#define PG8_STAGE(bufoff, gbase, voff) do { _Pragma("unroll") for (int _i = 0; _i < 2; ++_i) \
        __builtin_amdgcn_global_load_lds((const unsigned*)((const char*)(gbase) + (voff)[_i]), (PG8_LAS unsigned*)(lds + (bufoff) + ldsw + _i * 8192), 16, 0, 0); } while (0)
#define PG8_LDA(dst, b, h) do { _Pragma("unroll") for (int m = 0; m < 4; ++m) _Pragma("unroll") for (int k = 0; k < 2; ++k) dst[m][k] = *(const PG8_LAS bf16x8*)(lds + PG8_SA(b, h) + aoff + m * 2048 + k * 1024); } while (0)
#define PG8_LDB(dst, b, h) do { _Pragma("unroll") for (int n = 0; n < 2; ++n) _Pragma("unroll") for (int k = 0; k < 2; ++k) dst[n][k] = *(const PG8_LAS bf16x8*)(lds + PG8_SB(b, h) + boff + n * 2048 + k * 1024); } while (0)
#define PG8_MMA(ai, bj, At, Bt) do { __builtin_amdgcn_s_setprio(1); _Pragma("unroll") for (int m = 0; m < 4; ++m) _Pragma("unroll") for (int n = 0; n < 2; ++n) _Pragma("unroll") for (int k = 0; k < 2; ++k) \
        acc[ai][bj][m][n] = PG8_MFMA16(Bt[n][k], At[m][k], acc[ai][bj][m][n]); __builtin_amdgcn_s_setprio(0); } while (0)
#define PG8_WAIT_V(n) asm volatile("s_waitcnt vmcnt(" #n ")" ::: "memory")
#define PG8_WAIT_L(n) asm volatile("s_waitcnt lgkmcnt(" #n ")" ::: "memory")
#define PG8_BAR __builtin_amdgcn_s_barrier()
#define PG8_SCHED __builtin_amdgcn_sched_barrier(0)
    Unit cur, nxt; int ui = 0;
    float z0_ = 0.f; asm volatile("" : "+v"(z0_));
    if (!S.next(0, cur)) return;
    f32x4 acc[2][2][4][2];
#pragma unroll
    for (int a = 0; a < 2; ++a)
#pragma unroll
        for (int b = 0; b < 2; ++b)
#pragma unroll
            for (int m = 0; m < 4; ++m)
#pragma unroll
                for (int n = 0; n < 2; ++n) acc[a][b][m][n] = (f32x4){z0_, z0_, z0_, z0_};
    bf16x8 At[4][2], B0[2][2], B1[2][2];
    const char* cA = (const char*)g.A + (size_t)cur.pm * tstep; const char* cB = (const char*)g.Bt + (size_t)cur.pn * tstep;
    S.a_ready(cur);
    if constexpr (SP2) {
        PG8_STAGE(PG8_SB(0, 0), cB, voffB); PG8_STAGE(PG8_SB(0, 1), cB + hstep, voffB); PG8_STAGE(PG8_SA(0, 0), cA, voffA); PG8_STAGE(PG8_SA(0, 1), cA + hstep, voffA);
        if (wr == 1) PG8_BAR;
        PG8_WAIT_V(2); PG8_BAR;
        PG8_STAGE(PG8_SB(1, 0), cB + kstep, voffB); PG8_STAGE(PG8_SA(1, 0), cA + kstep, voffA); PG8_STAGE(PG8_SB(1, 1), cB + hstep + kstep, voffB);
        PG8_WAIT_V(6); PG8_BAR;
    } else {
        PG8_STAGE(PG8_SB(0, 0), cB, voffB); PG8_STAGE(PG8_SA(0, 0), cA, voffA); PG8_STAGE(PG8_SB(0, 1), cB + hstep, voffB); PG8_STAGE(PG8_SA(0, 1), cA + hstep, voffA);
        if (wr == 1) PG8_BAR;
        PG8_WAIT_V(4); PG8_BAR;
        PG8_STAGE(PG8_SB(1, 0), cB + kstep, voffB); PG8_STAGE(PG8_SA(1, 0), cA + kstep, voffA); PG8_STAGE(PG8_SB(1, 1), cB + hstep + kstep, voffB);
        PG8_WAIT_V(6); PG8_BAR;
    }
    for (;;) {
        const bool has_next = S.next(ui + 1, nxt);
        const char* nA = has_next ? (const char*)g.A + (size_t)nxt.pm * tstep : cA; const char* nB = has_next ? (const char*)g.Bt + (size_t)nxt.pn * tstep : cB;
        for (int t = 0; t < nt; t += 2) {
            const bool last = (t == nt - 2);
            const char* a1 = cA + (size_t)(t + 1) * kstep;
            const char* a2 = last ? nA : cA + (size_t)(t + 2) * kstep; const char* b2 = last ? nB : cB + (size_t)(t + 2) * kstep;
            const char* a3 = a2 + kstep; const char* b3 = b2 + kstep;
            if (last && has_next) S.a_ready(nxt);
            if constexpr (SP2) {
            PG8_LDB(B0, 0, 0); PG8_LDB(B1, 0, 1); PG8_SCHED; PG8_LDA(At, 0, 0); PG8_STAGE(PG8_SA(1, 1), a1 + hstep, voffA);
            PG8_WAIT_V(8); PG8_WAIT_L(0); PG8_BAR; PG8_MMA(0, 0, At, B0); PG8_MMA(0, 1, At, B1); PG8_BAR; PG8_SCHED;
            PG8_LDA(At, 0, 1); PG8_STAGE(PG8_SB(0, 0), b2, voffB); PG8_STAGE(PG8_SB(0, 1), b2 + hstep, voffB); PG8_STAGE(PG8_SA(0, 0), a2, voffA);
            PG8_WAIT_V(8); PG8_WAIT_L(0); PG8_BAR; PG8_MMA(1, 0, At, B0); PG8_MMA(1, 1, At, B1); PG8_BAR; PG8_SCHED;
            PG8_LDB(B0, 1, 0); PG8_LDB(B1, 1, 1); PG8_SCHED; PG8_LDA(At, 1, 0); PG8_STAGE(PG8_SA(0, 1), a2 + hstep, voffA);
            PG8_WAIT_V(8); PG8_WAIT_L(0); PG8_BAR; PG8_MMA(0, 0, At, B0); PG8_MMA(0, 1, At, B1); PG8_BAR; PG8_SCHED;
            PG8_LDA(At, 1, 1); PG8_STAGE(PG8_SB(1, 0), b3, voffB); PG8_STAGE(PG8_SB(1, 1), b3 + hstep, voffB); PG8_STAGE(PG8_SA(1, 0), a3, voffA);
            PG8_WAIT_V(8); PG8_WAIT_L(0); PG8_BAR; PG8_MMA(1, 0, At, B0); PG8_MMA(1, 1, At, B1); PG8_BAR; PG8_SCHED;
            } else {
            PG8_LDB(B0, 0, 0); PG8_SCHED; PG8_LDA(At, 0, 0); PG8_STAGE(PG8_SA(1, 1), a1 + hstep, voffA);
            PG8_WAIT_L(8); PG8_BAR; PG8_WAIT_L(0); PG8_MMA(0, 0, At, B0); PG8_BAR; PG8_SCHED;
            PG8_LDB(B1, 0, 1); PG8_STAGE(PG8_SB(0, 0), b2, voffB);
            PG8_BAR; PG8_WAIT_L(0); PG8_MMA(0, 1, At, B1); PG8_BAR;
            PG8_LDA(At, 0, 1); PG8_STAGE(PG8_SA(0, 0), a2, voffA);
            PG8_BAR; PG8_WAIT_L(0); PG8_MMA(1, 0, At, B0); PG8_BAR; PG8_SCHED;
            PG8_STAGE(PG8_SB(0, 1), b2 + hstep, voffB);
            PG8_WAIT_V(6); PG8_BAR; PG8_MMA(1, 1, At, B1); PG8_BAR;
            PG8_LDB(B0, 1, 0); PG8_SCHED; PG8_LDA(At, 1, 0); PG8_STAGE(PG8_SA(0, 1), a2 + hstep, voffA);
            PG8_WAIT_L(8); PG8_BAR; PG8_WAIT_L(0); PG8_MMA(0, 0, At, B0); PG8_BAR; PG8_SCHED;
            PG8_LDB(B1, 1, 1); PG8_STAGE(PG8_SB(1, 0), b3, voffB);
            PG8_BAR; PG8_WAIT_L(0); PG8_MMA(0, 1, At, B1); PG8_BAR;
            PG8_LDA(At, 1, 1); PG8_STAGE(PG8_SA(1, 0), a3, voffA);
            PG8_BAR; PG8_WAIT_L(0); PG8_MMA(1, 0, At, B0); PG8_BAR; PG8_SCHED;
            PG8_STAGE(PG8_SB(1, 1), b3 + hstep, voffB);
            PG8_WAIT_V(6); PG8_BAR; PG8_MMA(1, 1, At, B1); PG8_BAR;
            }
        }
        if constexpr (ALIGN_EPI) { if (wr == 0) PG8_BAR; }
        if constexpr (!Epi::AFTER_DRAIN) { S.epi_gate(ui); E(acc, cur, wr, wc, fr, fq); S.done(cur); }
        if (!has_next) break;
#pragma unroll
        for (int a = 0; a < 2; ++a)
#pragma unroll
            for (int b = 0; b < 2; ++b)
#pragma unroll
                for (int m = 0; m < 4; ++m)
#pragma unroll
                    for (int n = 0; n < 2; ++n) acc[a][b][m][n] = (f32x4){z0_, z0_, z0_, z0_};
        cur = nxt; cA = nA; cB = nB; ++ui;
        if constexpr (ALIGN_EPI) { if (wr == 1) PG8_BAR; }
    }
    PG8_WAIT_V(0);
    if constexpr (!ALIGN_EPI) { if (wr == 0) PG8_BAR; }
    PG8_BAR;
    if constexpr (Epi::AFTER_DRAIN) { E.fused(acc, cur, wr, wc, fr, fq, lds, wid, lane); S.done(cur); }
#undef PG8_SA
#undef PG8_SB
#undef PG8_STAGE
#undef PG8_LDA
#undef PG8_LDB
#undef PG8_MMA
#undef PG8_WAIT_V
#undef PG8_WAIT_L
#undef PG8_BAR
#undef PG8_SCHED
}
}
#define XB_TMO      128
#define XB_XCNT(j)  (256  + 64 * (j))
#define XB_XSUB(j)  (1280 + 64 * (j))
#define XB_XGEN(j)  (2304 + 64 * (j))
#define XB_TOP      3328
#define XB_TOPGEN   3392
#define XB_TOPS     3456
#define XCD_BAR_WORDS 3520
#define XB_SPIN_CAP (1u << 18)
#ifndef PROBE_FORCE_FULL
#define PROBE_FORCE_FULL 0
#endif

__device__ __forceinline__ unsigned xb_ld(unsigned* p)              { return __hip_atomic_load(p, __ATOMIC_RELAXED, __HIP_MEMORY_SCOPE_AGENT); }
__device__ __forceinline__ unsigned xb_add(unsigned* p, unsigned v) { return __hip_atomic_fetch_add(p, v, __ATOMIC_RELAXED, __HIP_MEMORY_SCOPE_AGENT); }
__device__ __forceinline__ unsigned xb_xcc_id() { return (unsigned)__builtin_amdgcn_s_getreg((3 << 11) | 20) & 0xFu; }
#define XB_SPIN(cond, bar) do { unsigned _sp = 0; while (cond) { __builtin_amdgcn_s_sleep(1); \
    if ((++_sp & 255u) == 0u) { if (xb_ld(&(bar)[XB_TMO])) break; if (_sp > XB_SPIN_CAP) { atomicAdd(&(bar)[XB_TMO], 1u); break; } } } } while (0)

struct XcdBarrier {
    int wid0;
    unsigned* bar; unsigned x;
    volatile LAS unsigned* st;
};

__device__ __forceinline__ XcdBarrier xcd_barrier_post(unsigned* bar, volatile LAS unsigned* st) {
    XcdBarrier b; b.bar = bar; b.x = xb_xcc_id(); b.st = st;
    if (threadIdx.x == 0) st[4] = xb_add(&bar[XB_XCNT(b.x)], 1u);
    return b;
}
__device__ __forceinline__ void xcd_barrier_complete(unsigned* bar, unsigned x, unsigned& nloc, unsigned& nx, unsigned& uni, unsigned& xv) {
    const unsigned G = gridDim.x * gridDim.y * gridDim.z;
    unsigned sum, cnt, mine, below, odd, sp = 0u;
    for (;;) {
        sum = 0u; cnt = 0u; mine = 0u; below = 0u; odd = 0u;
#pragma unroll
        for (unsigned j = 0; j < 16; ++j) { const unsigned c = xb_ld(&bar[XB_XCNT(j)]); sum += c; cnt += (c > 0u) ? 1u : 0u; mine = (j == x) ? c : mine; below += (c > 0u && j < x) ? 1u : 0u; odd += (c > 0u && c * 8u != G) ? 1u : 0u; }
        if (sum == G) break;
        __builtin_amdgcn_s_sleep(1);
        if ((++sp & 255u) == 0u) { if (xb_ld(&bar[XB_TMO])) break; if (sp > XB_SPIN_CAP) { atomicAdd(&bar[XB_TMO], 1u); break; } }
    }
    nloc = mine > 0u ? mine : 1u; nx = cnt > 0u ? cnt : 1u;
    uni = (sum == G && cnt == 8u && odd == 0u && !PROBE_FORCE_FULL) ? 1u : 0u; xv = below;
}

__device__ __forceinline__ void xcd_barrier(const XcdBarrier& b) {
    asm volatile("s_waitcnt vmcnt(0)" ::: "memory");
    __syncthreads();
    if (opaque_tid(b.wid0) == 0) {
        unsigned* bar = b.bar;
        __builtin_amdgcn_s_waitcnt(0);
        unsigned nloc = b.st[0], nx = b.st[1];
        if (nloc == 0u) { unsigned uni, xv; xcd_barrier_complete(bar, b.x, nloc, nx, uni, xv); b.st[0] = nloc; b.st[1] = nx; b.st[2] = uni; b.st[3] = xv; }
        const unsigned old = xb_add(&bar[XB_XSUB(b.x)], 1u);
        const unsigned gen = old / nloc;
        if (old + 1u == (gen + 1u) * nloc) {
            __builtin_amdgcn_fence(__ATOMIC_RELEASE, "agent");
            asm volatile("s_waitcnt vmcnt(0)" ::: "memory");
            const unsigned og = xb_add(&bar[XB_TOP], 1u);
            const unsigned tg = og / nx;
            if (og + 1u == (tg + 1u) * nx) xb_add(&bar[XB_TOPGEN], 1u);
#if PROBE_STAMP == 7 || PROBE_STAMP == 8
            else { const unsigned long long tq0_ = __builtin_amdgcn_s_memrealtime(); XB_SPIN(xb_ld(&bar[XB_TOPGEN]) == tg, bar); atomicAdd((unsigned long long*)bar + 4096 + 1 + b.x, __builtin_amdgcn_s_memrealtime() - tq0_); }
#else
            else XB_SPIN(xb_ld(&bar[XB_TOPGEN]) == tg, bar);
#endif
            __builtin_amdgcn_fence(__ATOMIC_ACQUIRE, "agent");
            xb_add(&bar[XB_XGEN(b.x)], 1u);
            asm volatile("s_waitcnt vmcnt(0)" ::: "memory");
        } else {
            XB_SPIN(xb_ld(&bar[XB_XGEN(b.x)]) == gen, bar);
            __builtin_amdgcn_fence(__ATOMIC_ACQUIRE, "agent");
            asm volatile("s_waitcnt vmcnt(0)" ::: "memory");
        }
    }
    __syncthreads();
}

__device__ __forceinline__ void xcd_seam_local(const XcdBarrier& b, const bool wb) {
    asm volatile("s_waitcnt vmcnt(0)" ::: "memory");
    __syncthreads();
    if (opaque_tid(b.wid0) == 0) {
        unsigned* bar = b.bar;
        __builtin_amdgcn_s_waitcnt(0);
        const unsigned nloc = b.st[0];
        const unsigned old = xb_add(&bar[XB_XSUB(b.x)], 1u);
        const unsigned gen = old / nloc;
        if (old + 1u == (gen + 1u) * nloc) {
            xb_add(&bar[XB_XGEN(b.x)], 1u);
            if (wb) {
            __builtin_amdgcn_fence(__ATOMIC_RELEASE, "agent");
            asm volatile("s_waitcnt vmcnt(0)" ::: "memory");
            }
            xb_add(&bar[XB_TOPS], 1u);
        }
        else XB_SPIN(xb_ld(&bar[XB_XGEN(b.x)]) == gen, bar);
        __builtin_amdgcn_fence(__ATOMIC_ACQUIRE, "agent");
        asm volatile("s_waitcnt vmcnt(0)" ::: "memory");
    }
    __syncthreads();
}
__device__ __forceinline__ void xcd_gate(unsigned* tops, unsigned target) {
    unsigned sp = 0u;
    while (xb_ld(tops) < target) { __builtin_amdgcn_s_sleep(1); if (++sp > XB_SPIN_CAP) break; }
    asm volatile("" ::: "memory");
}

__device__ const float kInvFreq[16] = {1.000000000e+00f, 4.403665960e-01f, 1.939227432e-01f, 8.539710194e-02f, 3.760603070e-02f, 1.656044088e-02f, 7.292664610e-03f, 3.211446106e-03f,
                                       1.414213562e-03f, 6.227724371e-04f, 2.742481884e-04f, 1.207697351e-04f, 5.318295734e-05f, 2.341999971e-05f, 1.031338525e-05f, 4.541670478e-06f};

__device__ __forceinline__ void sincos_f64(float angf, float& so, float& co) {
    const double a = (double)angf;
    const double k = __builtin_rint(a * 0.63661977236758134308);
    const double r = __builtin_fma(-k, 6.123233995736766e-17, __builtin_fma(-k, 1.5707963267948966, a));
    const double r2 = r * r;
    double s = -7.6471637318198164759e-13; s = s * r2 + 1.6059043836821614599e-10; s = s * r2 - 2.5052108385441718775e-8; s = s * r2 + 2.7557319223985890653e-6;
    s = s * r2 - 1.9841269841269841270e-4; s = s * r2 + 8.3333333333333333333e-3; s = s * r2 - 1.6666666666666666667e-1; s = s * r2 * r + r;
    double c = 4.7794773323873852974e-14; c = c * r2 - 1.1470745597729724714e-11; c = c * r2 + 2.0876756987868098979e-9; c = c * r2 - 2.7557319223985890653e-7;
    c = c * r2 + 2.4801587301587301587e-5; c = c * r2 - 1.3888888888888888889e-3; c = c * r2 + 4.1666666666666666667e-2; c = c * r2 - 0.5; c = c * r2 + 1.0;
    const int q = (int)((long long)k & 3);
    const double sv = (q == 0) ? s : (q == 1) ? c : (q == 2) ? -s : -c;
    const double cv = (q == 0) ? c : (q == 1) ? -s : (q == 2) ? -c : s;
    so = (float)sv; co = (float)cv;
}

#ifndef W8BIT
#define W8BIT 0
#endif
#if W8BIT
__device__ __forceinline__ float WQ(float f) { unsigned u = __builtin_bit_cast(unsigned, f); u = (u + 0x7fffu + ((u >> 16) & 1u)) & 0xffff0000u; return __builtin_bit_cast(float, u); }
#else
#define WQ(x) (x)
#endif
struct TJob { const float* W; int K, N; bf16* WT; int mode; const float* g; const float* b; float* pcs; float* pbw; };
__device__ __forceinline__ void tr_item(const TJob& J, LAS float* scr, int item, int lane) {
    const int nblk = J.N / 32, kb = item / nblk, nb = item - kb * nblk, k0 = 64 * kb, n0 = 32 * nb;
#pragma unroll 8
    for (int i = 0; i < 32; ++i) { const int kk = 2 * i + (lane >> 5); scr[kk * 33 + (lane & 31)] = J.W[(size_t)(k0 + kk) * J.N + n0 + (lane & 31)]; }
    LDS_WAIT(); asm volatile("" ::: "memory");
    int drow0 = n0;
    if (J.mode == 2) { const int isup = n0 >= FF ? 1 : 0, hc = n0 - isup * FF; drow0 = 256 * (hc >> 7) + 128 * isup + (hc & 127); }
    const int c = lane & 7;
    float gk[8];
#pragma unroll
    for (int j = 0; j < 8; ++j) gk[j] = J.mode ? J.g[k0 + 8 * c + j] : 1.0f;
#pragma unroll
    for (int j = 0; j < 4; ++j) { const int n = (lane >> 3) + 8 * j; const LAS float* s = scr + (8 * c) * 33 + n;
        v4u o; o.x = pk2(WQ(s[0 * 33] * gk[0]), WQ(s[1 * 33] * gk[1])); o.y = pk2(WQ(s[2 * 33] * gk[2]), WQ(s[3 * 33] * gk[3])); o.z = pk2(WQ(s[4 * 33] * gk[4]), WQ(s[5 * 33] * gk[5])); o.w = pk2(WQ(s[6 * 33] * gk[6]), WQ(s[7 * 33] * gk[7]));
        *(GAS v4u*)(J.WT + (size_t)(drow0 + n) * J.K + k0 + 8 * c) = o; }
    if (J.mode) {
        float cs = 0.f, bw = 0.f; const int kh = (lane >> 5) * 32;
#pragma unroll 8
        for (int t = 0; t < 32; ++t) { const int kk = kh + t; const float w = scr[kk * 33 + (lane & 31)]; cs += bf_round(WQ(w * J.g[k0 + kk])); bw += w * J.b[k0 + kk]; }
        cs += shx(cs, 32, lane); bw += shx(bw, 32, lane);
        if (lane < 32) { J.pcs[(size_t)kb * J.N + drow0 + lane] = cs; J.pbw[(size_t)kb * J.N + drow0 + lane] = bw; }
    }
    LDS_WAIT(); asm volatile("" ::: "memory");
}

struct Args { const float* in[20]; float* out; unsigned char* ws; int ph_lo, ph_hi; };
#define CAS __attribute__((address_space(4)))
__device__ __forceinline__ const unsigned char CAS* kargs_() { const unsigned char CAS* p = (const unsigned char CAS*)__builtin_amdgcn_kernarg_segment_ptr(); asm volatile("" : "+s"(p)); return p; }
__device__ __forceinline__ const float* arg_in(int i) { return (const float*)(const GAS float*)*(const float* const CAS*)(kargs_() + 8 * i); }
__device__ __forceinline__ float* arg_out() { return (float*)(GAS float*)*(float* const CAS*)(kargs_() + 160); }
__device__ __forceinline__ unsigned char* arg_ws() { return (unsigned char*)(GAS unsigned char*)*(unsigned char* const CAS*)(kargs_() + 168); }
static_assert(sizeof(Args) == 184, "Args layout");

__device__ __forceinline__ TJob make_job(int id) {
    unsigned char* ws = arg_ws(); float* part = (float*)(ws + WS_PART);
    TJob J; J.mode = 0; J.g = nullptr; J.b = nullptr; J.pcs = nullptr; J.pbw = nullptr;
    switch (id) {
    case 0: J.W = arg_in(4); J.K = D; J.N = HW; J.WT = (bf16*)(ws + WS_W_IN); break;
    case 1: J.W = arg_in(9); J.K = D; J.N = D; J.WT = (bf16*)(ws + WS_W_OA); break;
    case 2: J.W = arg_in(10); J.K = D; J.N = NQKV; J.WT = (bf16*)(ws + WS_W_QKV); break;
    case 3: J.W = arg_in(11); J.K = AW; J.N = D; J.WT = (bf16*)(ws + WS_W_OB); break;
    case 4: case 5: { const int l = id - 4; J.W = arg_in(14) + (size_t)l * D * NGU; J.K = D; J.N = NGU; J.WT = (bf16*)(ws + WS_W_GU + l * W_GU_STRIDE); J.mode = 2;
        J.g = arg_in(12) + l * D; J.b = arg_in(13) + l * D; J.pcs = part + PART_GU + l * PART_GU_L; J.pbw = J.pcs + (size_t)KB32 * NGU; break; }
    case 6: case 7: { const int l = id - 6; J.W = arg_in(15) + (size_t)l * FF * D; J.K = FF; J.N = D; J.WT = (bf16*)(ws + WS_W_DN + l * W_DN_STRIDE); break; }
    case 8: case 9: { const int l = id - 8; J.W = arg_in(18) + (size_t)l * D * D; J.K = D; J.N = D; J.WT = (bf16*)(ws + WS_W_GT + l * W_GT_STRIDE); J.mode = 1;
        J.g = arg_in(16) + l * D; J.b = arg_in(17) + l * D; J.pcs = part + PART_GT + l * PART_GT_L; J.pbw = J.pcs + (size_t)KB32 * D; break; }
    default: { const int l = id - 10; J.W = arg_in(19) + (size_t)l * PLE * D; J.K = PLE; J.N = D; J.WT = (bf16*)(ws + WS_W_PJ + l * W_PJ_STRIDE); break; }
    }
    return J;
}
__device__ __forceinline__ int job_items(int id) {
    switch (id) { case 0: return (D / 64) * (HW / 32); case 1: return (D / 64) * (D / 32); case 2: return (D / 64) * (NQKV / 32); case 3: return (AW / 64) * (D / 32);
        case 4: case 5: return (D / 64) * (NGU / 32); case 6: case 7: return (FF / 64) * (D / 32); case 8: case 9: return (D / 64) * (D / 32); default: return (PLE / 64) * (D / 32); }
}

__device__ __forceinline__ void conv_bf16(const float* src, bf16* dst, size_t n8, size_t gt, size_t nthr) {
    size_t i = gt;
#pragma unroll 1
    for (; i + 3 * nthr < n8; i += 4 * nthr) {
        f32x4 a[4], b[4];
#pragma unroll
        for (int k = 0; k < 4; ++k) { a[k] = *(const GAS f32x4*)(src + 8 * (i + k * nthr)); b[k] = *(const GAS f32x4*)(src + 8 * (i + k * nthr) + 4); }
#pragma unroll
        for (int k = 0; k < 4; ++k) { v4u o; o.x = pk2(a[k][0], a[k][1]); o.y = pk2(a[k][2], a[k][3]); o.z = pk2(b[k][0], b[k][1]); o.w = pk2(b[k][2], b[k][3]); *(GAS v4u*)(dst + 8 * (i + k * nthr)) = o; }
    }
    for (; i < n8; i += nthr) {
        const f32x4 a = *(const GAS f32x4*)(src + 8 * i), b = *(const GAS f32x4*)(src + 8 * i + 4);
        v4u o; o.x = pk2(a[0], a[1]); o.y = pk2(a[2], a[3]); o.z = pk2(b[0], b[1]); o.w = pk2(b[2], b[3]);
        *(GAS v4u*)(dst + 8 * i) = o;
    }
}

__device__ __forceinline__ void prologue_phase(LAS unsigned char* lds, int G, int wid0) {
    const int tid = opaque_tid(wid0), lane = tid & 63, wave = tid >> 6;
    LAS float* scr = (LAS float*)(lds + wave * 16384);
    const int gw = blockIdx.x * NWAVES + wave, NGW = G * NWAVES;
#pragma unroll 1
    for (int id = 0; id < 12; ++id) {
        const TJob J = make_job(id); const int ni = job_items(id);
#pragma unroll 1
        for (int it = gw; it < ni; it += NGW) tr_item(J, scr, it, lane);
    }
    const size_t gt = (size_t)blockIdx.x * 512 + tid, nthr = (size_t)G * 512;
    conv_bf16(arg_in(7), (bf16*)(arg_ws() + WS_W_S), (size_t)16 * 128 * 128 / 8, gt, nthr);
    float* rot = (float*)(arg_ws() + WS_ROT);
    for (size_t i = gt; i < (size_t)16384 * 16; i += nthr) { const int pos = (int)(i >> 4), f = (int)(i & 15); float s, c; sincos_f64((float)pos * kInvFreq[f], s, c); rot[pos * 32 + f] = c; rot[pos * 32 + 16 + f] = s; }
}
__device__ __forceinline__ void finalize_vecs(int G, int wid0) {
    const float* part = (const float*)(arg_ws() + WS_PART); float* vec = (float*)(arg_ws() + WS_VEC);
    const int gt = blockIdx.x * 512 + opaque_tid(wid0), nthr = G * 512;
    for (int i = gt; i < 2 * 2 * NGU; i += nthr) {
        const float* p = part + PART_GU + (size_t)(i / NGU) * KB32 * NGU + (i % NGU); float s = 0.f;
        for (int kb = 0; kb < KB32; ++kb) s += p[(size_t)kb * NGU];
        vec[VEC_GU + i] = s;
    }
    for (int i = gt; i < 2 * 2 * D; i += nthr) {
        const float* p = part + PART_GT + (size_t)(i / D) * KB32 * D + (i % D); float s = 0.f;
        for (int kb = 0; kb < KB32; ++kb) s += p[(size_t)kb * D];
        vec[VEC_GT + i] = s;
    }
}

__device__ __forceinline__ void sgu_phase(LAS unsigned char* lds, const bf16* H, bf16* GATED, const bf16* WS, const float* bs, const float* lng, const float* lnb, const float* stv, int G, int slot, int wid0) {
    const int tid = opaque_tid(wid0), lane = tid & 63, wave = tid >> 6, i16 = lane & 15, kq = lane >> 4;
    LAS f32x2v* SV = (LAS f32x2v*)(lds + STAB_OFF);
    LAS float* LG = (LAS float*)(lds + 65536); LAS float* LB = LG + D;
    for (int i = tid; i < D; i += 512) { LG[i] = lng[i]; LB[i] = lnb[i]; }
#pragma unroll 1
    for (int chunk = slot; chunk < MG / 128; chunk += G) {
        const size_t row0 = (size_t)chunk * 128;
        if (tid < 128) {
            const f32x4* pq = (const f32x4*)(stv + (row0 + tid) * 16);
            const f32x4 a = pq[0], b = pq[1], c = pq[2], d = pq[3];
            const float S_ = ((a[0] + a[2]) + (b[0] + b[2])) + ((c[0] + c[2]) + (d[0] + d[2]));
            const float Q_ = ((a[1] + a[3]) + (b[1] + b[3])) + ((c[1] + c[3]) + (d[1] + d[3]));
            const float mean = S_ * (1.0f / D); float var = Q_ * (1.0f / D) - mean * mean; var = var < 0.f ? 0.f : var;
            SV[tid] = (f32x2v){mean, 1.0f / sqrtf(var + LN_EPS)};
        }
        const int p = 16 * wave + i16;
        v4u vt[4];
#define SGU_VLOAD(g_) do { _Pragma("unroll") for (int n = 0; n < 4; ++n) { const int id = tid + 512 * n, q = id >> 4, ch = id & 15; vt[n] = *(const GAS v4u*)(H + (row0 + q) * HW + D + (g_) * 128 + ch * 8); } } while (0)
        SGU_VLOAD(0);
        bf16x8 wfn[4]; float biasn = bs[p];
#pragma unroll
        for (int s = 0; s < 4; ++s) wfn[s] = *(const GAS bf16x8*)(WS + ((size_t)p) * 128 + 32 * s + 8 * kq);
        v4u uwn[4];
#pragma unroll
        for (int cp = 0; cp < 4; ++cp) uwn[cp] = *(const GAS v4u*)(H + (row0 + p) * HW + 32 * cp + 8 * kq);
        WG_BAR();
#pragma unroll 1
        for (int g = 0; g < 16; ++g) {
            LAS unsigned char* img = lds + (g & 1) * 32768;
#pragma unroll
            for (int n = 0; n < 4; ++n) {
                const int id = tid + 512 * n, q = id >> 4, ch = id & 15; const int c0 = g * 128 + ch * 8;
                const v4u d = vt[n];
                const f32x2v sr = SV[q];
                const f32x4 g0 = *(const LAS f32x4*)(LG + c0), g1 = *(const LAS f32x4*)(LG + c0 + 4), b0 = *(const LAS f32x4*)(LB + c0), b1 = *(const LAS f32x4*)(LB + c0 + 4);
                f32x4 x0, x1; x0[0] = bf_lo(d.x); x0[1] = bf_hi(d.x); x0[2] = bf_lo(d.y); x0[3] = bf_hi(d.y); x1[0] = bf_lo(d.z); x1[1] = bf_hi(d.z); x1[2] = bf_lo(d.w); x1[3] = bf_hi(d.w);
                x0 = ((x0 - sr.x) * sr.y) * g0 + b0; x1 = ((x1 - sr.x) * sr.y) * g1 + b1;
                v4u o; o.x = pk2(x0[0], x0[1]); o.y = pk2(x0[2], x0[3]); o.z = pk2(x1[0], x1[1]); o.w = pk2(x1[2], x1[3]);
                *(LAS v4u*)(img + off_b(q, ch)) = o;
            }
            bf16x8 wf[4];
#pragma unroll
            for (int s = 0; s < 4; ++s) wf[s] = wfn[s];
            const float bias = biasn;
            v4u uw[4];
#pragma unroll
            for (int cp = 0; cp < 4; ++cp) uw[cp] = uwn[cp];
            if (g < 15) { SGU_VLOAD(g + 1);
#pragma unroll
                for (int s = 0; s < 4; ++s) wfn[s] = *(const GAS bf16x8*)(WS + ((size_t)((g + 1) * 128 + p)) * 128 + 32 * s + 8 * kq);
                biasn = bs[(g + 1) * 128 + p];
#pragma unroll
                for (int cp = 0; cp < 4; ++cp) uwn[cp] = *(const GAS v4u*)(H + (row0 + p) * HW + (g + 1) * 128 + 32 * cp + 8 * kq); }
            WG_BAR();
            f32x4 acc[8];
#pragma unroll
            for (int ct = 0; ct < 8; ++ct) {
                f32x4 c4 = (f32x4){0.f, 0.f, 0.f, 0.f};
#pragma unroll
                for (int s = 0; s < 4; ++s) {
                    const unsigned qq = (unsigned)(i16 >> 2), pp = (unsigned)(lane & 3);
                    const s16x4 lo = tr_read(img + off_b(32 * s + 8 * kq + qq, 4 * (ct >> 1) + pp) + 8 * (ct & 1));
                    const s16x4 hi = tr_read(img + off_b(32 * s + 8 * kq + 4 + qq, 4 * (ct >> 1) + pp) + 8 * (ct & 1));
                    const bf16x8 af = __builtin_shufflevector(lo, hi, 0, 1, 2, 3, 4, 5, 6, 7);
                    c4 = PG8_MFMA16(af, wf[s], c4);
                }
                acc[ct] = c4;
            }
#pragma unroll
            for (int cp = 0; cp < 4; ++cp) {
                const int c = g * 128 + 32 * cp + 8 * kq;
                const f32x4 a = acc[2 * cp], b = acc[2 * cp + 1];
                v4u ow;
                ow.x = pk2((a[0] + bias) * bf_lo(uw[cp].x), (a[1] + bias) * bf_hi(uw[cp].x)); ow.y = pk2((a[2] + bias) * bf_lo(uw[cp].y), (a[3] + bias) * bf_hi(uw[cp].y));
                ow.z = pk2((b[0] + bias) * bf_lo(uw[cp].z), (b[1] + bias) * bf_hi(uw[cp].z)); ow.w = pk2((b[2] + bias) * bf_lo(uw[cp].w), (b[3] + bias) * bf_hi(uw[cp].w));
                *(GAS v4u*)(GATED + (row0 + p) * D + c) = ow;
            }
        }
#undef SGU_VLOAD
        WG_BAR();
    }
}

struct AttnUnit { int g, h, dil, L, i0; size_t tok0; };
__device__ __forceinline__ AttnUnit attn_decode(int j, int xv, int S) {
    AttnUnit A; const int ltps = 24 - __builtin_clz((unsigned)S);
    A.g = j >> 8; const int rem = j & 255; A.h = (rem >> 3) & 7; const int ls = (rem & 7) | ((rem >> 6) << 3);
    const int ldil = 2 * A.g; A.dil = 1 << ldil; A.L = S >> ldil;
    int b, r, it;
    if (ltps <= 5) { b = (xv << (5 - ltps)) + (ls >> ltps); const int wslot = ls & ((1 << ltps) - 1), ltpr = ltps - ldil; r = wslot >> ltpr; it = wslot & ((1 << ltpr) - 1); }
    else { const int lq = ltps - 5, ltq = 5 - ldil; b = xv >> lq; const int q = xv & ((1 << lq) - 1); r = ls >> ltq; it = (q << ltq) + (ls & ((1 << ltq) - 1)); }
    A.i0 = it * 128;
    A.tok0 = (size_t)b * S + r;
    return A;
}
#define ATTN_KV_LOAD(A_) do { const int j0_ = (A_).i0 - 64 + (tid >> 4); \
    const bf16* Kp_ = QKV + (A_).g * 3072 + (A_).h * 128 + 1024 + ((A_).tok0 + (size_t)((long)j0_ * (A_).dil)) * NQKV + (tid & 15) * 8; const size_t rs_ = (size_t)32 * (A_).dil * NQKV;   \
    _Pragma("unroll") for (int n = 0; n < 8; ++n) { const int j = j0_ + 32 * n; \
        kreg[n] = (v4u){zz_, zz_, zz_, zz_}; vreg[n] = (v4u){zz_, zz_, zz_, zz_}; \
        if (j >= 0 && j < (A_).L) { kreg[n] = *(const GAS v4u*)(Kp_ + n * rs_); vreg[n] = *(const GAS v4u*)(Kp_ + n * rs_ + 1024); } } } while (0)
__device__ __forceinline__ void attn_phase(LAS unsigned char* lds, bf16* QKV, float* LSE, int S, int cv, bool dry, int wid0) {
    const int tid = opaque_tid(wid0), lane = tid & 63, wave = tid >> 6, iq = lane & 15, kq = lane >> 4;
    LAS unsigned char* Kimg = lds; LAS unsigned char* Vimg = lds + 65536;
    constexpr int NU = 3 * 8 * 32; const int xv = cv & 7;
    v4u kreg[8], vreg[8];
    unsigned zz_ = 0u; asm volatile("" : "+v"(zz_));
    int u = cv >> 3;
    bf16x8 qfn[4];
#define ATTN_Q_LOAD(A_) do { const size_t qt_ = (A_).tok0 + (size_t)((A_).i0 + 16 * wave + iq) * (A_).dil; const bf16* qb_ = QKV + (A_).g * 3072 + (A_).h * 128 + qt_ * NQKV + 8 * kq; \
    _Pragma("unroll") for (int s = 0; s < 4; ++s) qfn[s] = *(const GAS bf16x8*)(qb_ + 32 * s); } while (0)
    if (u < NU) { const AttnUnit A0 = attn_decode(u, xv, S); ATTN_KV_LOAD(A0); ATTN_Q_LOAD(A0); }
#pragma unroll 1
    while (u < NU) {
        const AttnUnit A = attn_decode(u, xv, S);
        const int g = A.g, h = A.h, dil = A.dil, L = A.L, i0 = A.i0; const size_t tok0 = A.tok0;
        bf16* Qb = QKV + g * 3072 + h * 128;
#pragma unroll
        for (int n = 0; n < 8; ++n) { const int id = tid + 512 * n, kl = id >> 4, ch = id & 15; *(LAS v4u*)(Kimg + off_b(kl, ch)) = kreg[n]; *(LAS v4u*)(Vimg + off_b(kl, ch)) = vreg[n]; }
        const int qi = i0 + 16 * wave + iq; const size_t qtok = tok0 + (size_t)qi * dil;
        bf16x8 qf[4];
#pragma unroll
        for (int s = 0; s < 4; ++s) qf[s] = qfn[s];
        WG_BAR();
        const int un = u + 32;
        if (un < NU) { const AttnUnit An = attn_decode(un, xv, S); ATTN_KV_LOAD(An); ATTN_Q_LOAD(An); }
        f32x4 st[9];
#pragma unroll
        for (int T = 0; T < 9; ++T) {
            f32x4 c4 = (f32x4){0.f, 0.f, 0.f, 0.f};
#pragma unroll
            for (int s = 0; s < 4; ++s) { const bf16x8 kf = *(const LAS bf16x8*)(Kimg + off_b(16 * wave + 16 * T + iq, 4 * s + kq)); c4 = PG8_MFMA16(kf, qf[s], c4); }
            st[T] = c4;
        }
#pragma unroll
        for (int e = 0; e < 4; ++e) { if (4 * kq + e - iq < 0) st[0][e] = -1.0e30f; if (4 * kq + e - iq > 0) st[8][e] = -1.0e30f; }
        if (i0 == 0 || i0 + 192 > L) {
#pragma unroll
            for (int T = 0; T < 9; ++T)
#pragma unroll
                for (int e = 0; e < 4; ++e) { const int j = i0 + 16 * wave - 64 + 16 * T + 4 * kq + e; if (j < 0 || j >= L) st[T][e] = -1.0e30f; }
        }
        float mx = -3.0e38f;
#pragma unroll
        for (int T = 0; T < 9; ++T)
#pragma unroll
            for (int e = 0; e < 4; ++e) mx = fmaxf(mx, st[T][e]);
        mx = fmaxf(mx, shx(mx, 16, lane)); mx = fmaxf(mx, shx(mx, 32, lane));
        float den = 0.f;
#pragma unroll
        for (int T = 0; T < 9; ++T)
#pragma unroll
            for (int e = 0; e < 4; ++e) { const float pv = fast_exp2(st[T][e] - mx); st[T][e] = pv; den += pv; }
        den += shx(den, 16, lane); den += shx(den, 32, lane);
        bf16x8 pf[5];
#pragma unroll
        for (int s2 = 0; s2 < 5; ++s2) {
            v4u w; w.x = pk2(st[2 * s2][0], st[2 * s2][1]); w.y = pk2(st[2 * s2][2], st[2 * s2][3]);
            if (s2 < 4) { w.z = pk2(st[2 * s2 + 1][0], st[2 * s2 + 1][1]); w.w = pk2(st[2 * s2 + 1][2], st[2 * s2 + 1][3]); } else { w.z = 0u; w.w = 0u; }
            pf[s2] = __builtin_bit_cast(bf16x8, w);
        }
        const float inv = 1.0f / den;
        const unsigned qq = (unsigned)(iq >> 2), pp = (unsigned)(lane & 3);
#pragma unroll
        for (int cp = 0; cp < 4; ++cp) {
            f32x4 oo[2];
#pragma unroll
            for (int hc = 0; hc < 2; ++hc) {
                f32x4 o4 = (f32x4){0.f, 0.f, 0.f, 0.f};
#pragma unroll
                for (int s2 = 0; s2 < 5; ++s2) {
                    unsigned r0 = 16 * wave + 32 * s2 + 4 * kq + qq, r1 = r0 + 16; r1 = r1 > 255u ? 255u : r1;
                    const s16x4 lo = tr_read(Vimg + off_b(r0, 4 * cp + pp) + 8 * hc);
                    const s16x4 hi = tr_read(Vimg + off_b(r1, 4 * cp + pp) + 8 * hc);
                    const bf16x8 vf = __builtin_shufflevector(lo, hi, 0, 1, 2, 3, 4, 5, 6, 7);
                    o4 = PG8_MFMA16(vf, pf[s2], o4);
                }
                oo[hc] = o4;
            }
            v4u ow; ow.x = pk2(oo[0][0] * inv, oo[0][1] * inv); ow.y = pk2(oo[0][2] * inv, oo[0][3] * inv); ow.z = pk2(oo[1][0] * inv, oo[1][1] * inv); ow.w = pk2(oo[1][2] * inv, oo[1][3] * inv);
            if (!dry) *(GAS v4u*)(Qb + qtok * NQKV + 32 * cp + 8 * kq) = ow;
        }
        if (kq == 0 && !dry) LSE[(qtok * 3 + g) * 8 + h] = (mx + __builtin_amdgcn_logf(den)) * LN2;
        WG_BAR();
        u = un;
    }
}
#undef ATTN_KV_LOAD
#undef ATTN_Q_LOAD
__device__ __forceinline__ void combine_phase(const bf16* QKV, const float* LSE, bf16* ATT, int slot, int wid0) {
    const int tid = opaque_tid(wid0), ch = tid & 127, h = ch >> 4;
#pragma unroll 1
    for (int it = 0; it < 8; ++it) {
        v4u a[4], b[4], c[4]; float l0[4], l1[4], l2[4];
#pragma unroll
        for (int k = 0; k < 4; ++k) { const size_t t = (size_t)slot * 128 + it * 16 + k * 4 + (tid >> 7);
            l0[k] = LSE[(t * 3 + 0) * 8 + h]; l1[k] = LSE[(t * 3 + 1) * 8 + h]; l2[k] = LSE[(t * 3 + 2) * 8 + h];
            a[k] = *(const GAS v4u*)(QKV + t * NQKV + ch * 8); b[k] = *(const GAS v4u*)(QKV + t * NQKV + 3072 + ch * 8); c[k] = *(const GAS v4u*)(QKV + t * NQKV + 6144 + ch * 8); }
#pragma unroll
        for (int k = 0; k < 4; ++k) { const size_t t = (size_t)slot * 128 + it * 16 + k * 4 + (tid >> 7);
            const float m = fmaxf(l0[k], fmaxf(l1[k], l2[k]));
            float w0 = fast_exp2((l0[k] - m) * 1.4426950408889634f), w1 = fast_exp2((l1[k] - m) * 1.4426950408889634f), w2 = fast_exp2((l2[k] - m) * 1.4426950408889634f);
            const float inv = 1.0f / (w0 + w1 + w2); w0 *= inv; w1 *= inv; w2 *= inv;
            v4u o;
            o.x = pk2(w0 * bf_lo(a[k].x) + w1 * bf_lo(b[k].x) + w2 * bf_lo(c[k].x), w0 * bf_hi(a[k].x) + w1 * bf_hi(b[k].x) + w2 * bf_hi(c[k].x));
            o.y = pk2(w0 * bf_lo(a[k].y) + w1 * bf_lo(b[k].y) + w2 * bf_lo(c[k].y), w0 * bf_hi(a[k].y) + w1 * bf_hi(b[k].y) + w2 * bf_hi(c[k].y));
            o.z = pk2(w0 * bf_lo(a[k].z) + w1 * bf_lo(b[k].z) + w2 * bf_lo(c[k].z), w0 * bf_hi(a[k].z) + w1 * bf_hi(b[k].z) + w2 * bf_hi(c[k].z));
            o.w = pk2(w0 * bf_lo(a[k].w) + w1 * bf_lo(b[k].w) + w2 * bf_lo(c[k].w), w0 * bf_hi(a[k].w) + w1 * bf_hi(b[k].w) + w2 * bf_hi(c[k].w));
            *(GAS v4u*)(ATT + t * AW + ch * 8) = o; }
    }
}

#ifndef MK_PER_PHASE
#define MK_PER_PHASE 0
#endif
constexpr int N_PHASES = 1 + 2 * (2 + 4 + 3 + 4);
#ifndef GEMM_SP2
#define GEMM_SP2 true
#endif
#ifndef PROBE_SITE
#define PROBE_SITE 0
#endif
#define REPS(site, cond) ((PROBE_SITE == (site) && (cond)) ? 2 : 1)
#ifndef PROBE_STAMP
#define PROBE_STAMP 0
#endif
#define STAMP_GAIN 4
constexpr int CW_ACC = 8192;
__device__ __forceinline__ unsigned long long wall_() { return __builtin_amdgcn_s_memrealtime(); }

__global__ void __launch_bounds__(NWAVES * 64, 2) trunk_fwd(Args args) {
    extern __shared__ __attribute__((aligned(16))) unsigned char lds_raw[];
    LAS unsigned char* lds = (LAS unsigned char*)lds_raw;
    LAS unsigned char* xl = lds + RING_BYTES;
    const int G = gridDim.x;
    const int wid0 = __builtin_amdgcn_readfirstlane((int)threadIdx.x >> 6);
    for (int u = threadIdx.x; u < (LDS_BYTES - RING_BYTES) / 4; u += NWAVES * 64) ((LAS unsigned*)(lds + RING_BYTES))[u] = 0u;
    __syncthreads();
    const int lo = __builtin_amdgcn_readfirstlane(args.ph_lo), hi = __builtin_amdgcn_readfirstlane(args.ph_hi);
    XcdBarrier bar; bar.wid0 = wid0; bar.bar = (unsigned*)(arg_ws() + WS_CTL); bar.x = 0; bar.st = (volatile LAS unsigned*)(lds + MISC_OFF) + 8;
    if (hi - lo > 1) { bar = xcd_barrier_post((unsigned*)(arg_ws() + WS_CTL), (volatile LAS unsigned*)(lds + MISC_OFF) + 8); bar.wid0 = wid0; }
    int pc = 0, nsp = 0; unsigned gate_t = 0u, gacc = 0u; (void)gacc;
#ifndef PROBE_DBLBAR
#define PROBE_DBLBAR 0
#endif
#define RUN_PH (pc >= lo && pc < hi)
#define SEAM() do { gate_t = 0u; if (pc >= lo && pc + 1 < hi) { if (PROBE_STAMP == 1 && opaque_tid(wid0) == 0) ((volatile LAS unsigned*)(lds + MISC_OFF))[16] = (unsigned)wall_(); XcdBarrier b2_ = bar; asm volatile("" : "+s"(b2_.bar), "+s"(b2_.x)); b2_.bar = (unsigned*)(GAS unsigned*)b2_.bar; xcd_barrier(b2_); if (PROBE_DBLBAR) { xcd_barrier(b2_); xcd_barrier(b2_); } if (PROBE_STAMP == 1 && opaque_tid(wid0) == 0) atomicAdd((unsigned long long*)(arg_ws() + WS_CTL) + CW_ACC / 2, (unsigned long long)((unsigned)wall_() - ((volatile LAS unsigned*)(lds + MISC_OFF))[16])); } pc = __builtin_amdgcn_readfirstlane(pc + 1); } while (0)
#define SEAML(WB_) do { gate_t = 0u; if (pc >= lo && pc + 1 < hi) { XcdBarrier b2_ = bar; asm volatile("" : "+s"(b2_.bar), "+s"(b2_.x)); b2_.bar = (unsigned*)(GAS unsigned*)b2_.bar; \
        if (PROBE_STAMP == 1 && opaque_tid(wid0) == 0) ((volatile LAS unsigned*)(lds + MISC_OFF))[16] = (unsigned)wall_(); \
        if (__builtin_amdgcn_readfirstlane((int)((volatile LAS unsigned*)(lds + MISC_OFF))[10]) != 0) { xcd_seam_local(b2_, WB_); if (PROBE_STAMP == 1 && opaque_tid(wid0) == 0) atomicAdd((unsigned long long*)(arg_ws() + WS_CTL) + CW_ACC / 2, (unsigned long long)((unsigned)wall_() - ((volatile LAS unsigned*)(lds + MISC_OFF))[16])); nsp = __builtin_amdgcn_readfirstlane(nsp + 1); gate_t = (unsigned)nsp * 8u; } else xcd_barrier(b2_); } \
    pc = __builtin_amdgcn_readfirstlane(pc + 1); } while (0)
#define ENDGATE() do { if (gate_t != 0u) xcd_gate((unsigned*)(arg_ws() + WS_CTL) + XB_TOPS, gate_t); } while (0)
#define GATE(So_) do { (So_).gate_p = (unsigned*)(arg_ws() + WS_CTL) + XB_TOPS; (So_).gate_t = gate_t; } while (0)
#define WSP(T, off) ((T*)(arg_ws() + (off)))
#define BIGP(T, off) ((T*)(arg_ws() + WS_BIG + (off)))
#define XOUT(grp) (arg_out() + (size_t)(grp) * MG * D)
#define VECP() ((const float*)(arg_ws() + WS_VEC))
#define PH_LOCALS int grp_ = grp, layer_ = layer; asm volatile("" : "+s"(grp_), "+s"(layer_)); const int S_ = grp_ == 0 ? 2048 : 16384; (void)layer_; (void)S_; const int cv_ = __builtin_amdgcn_readfirstlane((int)((volatile LAS unsigned*)(lds + MISC_OFF))[13]), slot_ = (cv_ & 7) * 32 + (cv_ >> 3); (void)slot_

#define THIN_BEGIN unsigned long long tt0_ = 0; if (PROBE_STAMP == 2) tt0_ = wall_();
#define THIN_END if (PROBE_STAMP == 2 && opaque_tid(wid0) == 0) atomicAdd((unsigned long long*)(arg_ws() + WS_CTL) + CW_ACC / 2, wall_() - tt0_);
    if (RUN_PH) { THIN_BEGIN _Pragma("unroll 1") for (int rep = 0; rep < REPS(1, true); ++rep) prologue_phase(lds, G, wid0);
        conv_bf16(arg_in(0), WSP(bf16, WS_XB), (size_t)MG * D / 8, (size_t)blockIdx.x * 512 + opaque_tid(wid0), (size_t)G * 512); THIN_END }
    SEAM();
    { volatile LAS unsigned* st_ = (volatile LAS unsigned*)(lds + MISC_OFF) + 8; if (opaque_tid(wid0) == 0) st_[5] = st_[2] ? st_[4] * 8u + st_[3] : blockIdx.x; __syncthreads(); }
#pragma unroll 1
    for (int grp = 0; grp < 2; ++grp) {
#pragma unroll 1
        for (int layer = 0; layer < 2; ++layer) {
            if (layer == 0) {
                if (RUN_PH) { PH_LOCALS; if (grp_ == 0) finalize_vecs(G, wid0);
                    _Pragma("unroll 1") for (int rep = 0; rep < REPS(3, grp_ == 0); ++rep) {
                    pg8::Gemm g{WSP(bf16, WS_XB), WSP(const bf16, WS_W_IN), MG, HW, D, wid0}; pg8::StaticOrder So; So.init(MG, HW, G, cv_);
                    pg8::EpiPlain<1> E{BIGP(bf16, BIG_H), HW, wid0, WSP(float, WS_ST1), xl, 8};
                    pg8::gemm_phase<pg8::EpiPlain<1>, pg8::StaticOrder, true, GEMM_SP2>(lds, g, So, E);
                } ENDGATE(); }
                if (grp == 0) SEAM(); else SEAML(true);
                if (RUN_PH) { PH_LOCALS; THIN_BEGIN _Pragma("unroll 1") for (int rep = 0; rep < REPS(4, grp_ == 0); ++rep) sgu_phase(lds, BIGP(const bf16, BIG_H), BIGP(bf16, BIG_GATED), WSP(const bf16, WS_W_S), arg_in(8), arg_in(5), arg_in(6), WSP(const float, WS_ST1), G, slot_, wid0); THIN_END }
                SEAML(true);
            } else {
                if (RUN_PH) { PH_LOCALS; _Pragma("unroll 1") for (int rep = 0; rep < REPS(5, grp_ == 0); ++rep) {
                    pg8::Gemm g{WSP(bf16, WS_XB), WSP(const bf16, WS_W_QKV), MG, NQKV, D, wid0}; pg8::StaticOrder So; So.init(MG, NQKV, G, cv_); GATE(So);
                    pg8::EpiQKV E{BIGP(bf16, BIG_QKV), WSP(const float, WS_ROT), S_ - 1, QSCALE, wid0};
                    pg8::gemm_phase<pg8::EpiQKV, pg8::StaticOrder, true, GEMM_SP2>(lds, g, So, E); if (PROBE_STAMP == 9) gacc = __builtin_amdgcn_readfirstlane(gacc + So.gwait);
                } }
                if (grp == 0) SEAML(true); else SEAM();
                if (RUN_PH) { PH_LOCALS; THIN_BEGIN _Pragma("unroll 1") for (int rep = REPS(6, grp_ == 0) - 1; rep >= 0; --rep) attn_phase(lds, BIGP(bf16, BIG_QKV), BIGP(float, BIG_LSE), S_, cv_, rep != 0, wid0); THIN_END }
                SEAML(true);
                if (RUN_PH) { PH_LOCALS; THIN_BEGIN _Pragma("unroll 1") for (int rep = 0; rep < REPS(7, grp_ == 0); ++rep) combine_phase(BIGP(const bf16, BIG_QKV), BIGP(const float, BIG_LSE), BIGP(bf16, BIG_ATT), slot_, wid0); THIN_END }
                SEAML(true);
            }
            if (RUN_PH) { PH_LOCALS; _Pragma("unroll 1") for (int rep = 0; rep < REPS(8, grp_ == 0 && layer_ == 0); ++rep) {
                pg8::Gemm g{layer_ == 0 ? BIGP(const bf16, BIG_GATED) : BIGP(const bf16, BIG_ATT), layer_ == 0 ? WSP(const bf16, WS_W_OA) : WSP(const bf16, WS_W_OB), MG, D, layer_ == 0 ? D : AW, wid0};
                pg8::StaticOrder So; So.init(MG, D, G, cv_);
                pg8::EpiY1 E{(const float*)nullptr, WSP(const bf16, WS_XB), WSP(bf16, WS_XB), WSP(float, WS_ST1), xl, ALPHA, wid0};
                pg8::gemm_phase<pg8::EpiY1, pg8::StaticOrder, true, GEMM_SP2>(lds, g, So, E);
                ENDGATE();
                conv_bf16(arg_in(2 + grp_) + ((size_t)layer_ * MG + (size_t)slot_ * 128) * PLE, BIGP(bf16, BIG_PB) + (size_t)slot_ * 128 * PLE, (size_t)128 * PLE / 8, (size_t)opaque_tid(wid0), (size_t)512);
            } }
            SEAML(true);
            if (RUN_PH) { PH_LOCALS; _Pragma("unroll 1") for (int rep = 0; rep < REPS(9, grp_ == 0 && layer_ == 0); ++rep) {
                unsigned long long ck0_ = 0, cw0_ = 0; if (PROBE_STAMP == 3) { ck0_ = clock64(); cw0_ = wall_(); }
                { pg8::Gemm g{WSP(const bf16, WS_XB), WSP(const bf16, WS_W_GU + layer_ * W_GU_STRIDE), MG, NGU, D, wid0}; pg8::StaticOrder So; So.init(MG, NGU, G, cv_);
                  pg8::EpiGU E{WSP(const float, WS_ST1), VECP() + VEC_GU + layer_ * VEC_GU_L, VECP() + VEC_GU + layer_ * VEC_GU_L + NGU, BIGP(bf16, BIG_HB), xl, LN_EPS, wid0};
                  pg8::gemm_phase<pg8::EpiGU, pg8::StaticOrder, true, GEMM_SP2>(lds, g, So, E); }
                if (PROBE_STAMP == 3 && grp_ == 0 && layer_ == 0 && blockIdx.x == 0 && opaque_tid(wid0) == 0) { const unsigned long long dc = clock64() - ck0_, dw = wall_() - cw0_; atomicAdd((unsigned long long*)(arg_ws() + WS_CTL) + CW_ACC / 2, dc * 100ull / (dw ? dw : 1ull) * 100ull * 256ull / STAMP_GAIN); }
                ENDGATE();
                { int kple = PLE; asm volatile("" : "+s"(kple));
                  pg8::Gemm g{BIGP(const bf16, BIG_PB), WSP(const bf16, WS_W_PJ + layer_ * W_PJ_STRIDE), MG, D, kple, wid0}; pg8::StaticOrder So; So.init(MG, D, G, cv_);
                  pg8::EpiPlain<0> E{BIGP(bf16, BIG_PP), D, wid0};
                  pg8::gemm_phase<pg8::EpiPlain<0>, pg8::StaticOrder, true, GEMM_SP2>(lds, g, So, E); }
            } }
            SEAML(true);
            if (PROBE_SITE == 10 && RUN_PH) { PH_LOCALS; if (grp_ == 0 && layer_ == 0) {
                pg8::Gemm g{BIGP(const bf16, BIG_HB), WSP(const bf16, WS_W_DN + layer_ * W_DN_STRIDE), MG, D, FF, wid0}; pg8::StaticOrder So; So.init(MG, D, G, cv_);
                pg8::EpiY2 E{WSP(const bf16, WS_XB), BIGP(bf16, BIG_XB2), WSP(const float, WS_ST1), WSP(float, WS_ST2), arg_in(12) + layer_ * D, arg_in(13) + layer_ * D, xl, ALPHA, LN_EPS, wid0};
                pg8::gemm_phase<pg8::EpiY2, pg8::StaticOrder, true, GEMM_SP2>(lds, g, So, E);
            } }
            if (RUN_PH) { PH_LOCALS; {
                pg8::Gemm g{BIGP(const bf16, BIG_HB), WSP(const bf16, WS_W_DN + layer_ * W_DN_STRIDE), MG, D, FF, wid0}; pg8::StaticOrder So; So.init(MG, D, G, cv_);
                pg8::EpiY2 E{WSP(const bf16, WS_XB), BIGP(bf16, BIG_XB2), WSP(const float, WS_ST1), WSP(float, WS_ST2), arg_in(12) + layer_ * D, arg_in(13) + layer_ * D, xl, ALPHA, LN_EPS, wid0};
                pg8::gemm_phase<pg8::EpiY2, pg8::StaticOrder, true, GEMM_SP2>(lds, g, So, E);
            } }
            SEAML(true);
            if (RUN_PH) { PH_LOCALS; _Pragma("unroll 1") for (int rep = 0; rep < REPS(11, grp_ == 0 && layer_ == 0); ++rep) {
                pg8::Gemm g{BIGP(const bf16, BIG_XB2), WSP(const bf16, WS_W_GT + layer_ * W_GT_STRIDE), MG, D, D, wid0}; pg8::StaticOrder So; So.init(MG, D, G, cv_);
                pg8::EpiPLE E{BIGP(const bf16, BIG_XB2), layer_ == 0 ? (float*)nullptr : XOUT(grp_), WSP(bf16, WS_XB), BIGP(const bf16, BIG_PP), WSP(const float, WS_ST2), arg_in(16) + layer_ * D, arg_in(17) + layer_ * D,
                              VECP() + VEC_GT + layer_ * VEC_GT_L, VECP() + VEC_GT + layer_ * VEC_GT_L + D, xl, LN_EPS, wid0};
                pg8::gemm_phase<pg8::EpiPLE, pg8::StaticOrder, true, GEMM_SP2>(lds, g, So, E);
                }
                ENDGATE();
                if (grp_ == 0 && layer_ == 1) conv_bf16(arg_in(1) + (size_t)slot_ * 128 * D, WSP(bf16, WS_XB) + (size_t)slot_ * 128 * D, (size_t)128 * D / 8, (size_t)opaque_tid(wid0), (size_t)512);
            }
            SEAML(true);
        }
    }
    if (PROBE_STAMP == 9 && opaque_tid(wid0) == 0) atomicAdd((unsigned long long*)(arg_ws() + WS_CTL) + CW_ACC / 2, (unsigned long long)gacc);
    if (PROBE_STAMP != 0 && hi - lo > 1) {
        { XcdBarrier b2_ = bar; asm volatile("" : "+s"(b2_.bar), "+s"(b2_.x)); b2_.bar = (unsigned*)(GAS unsigned*)b2_.bar; xcd_barrier(b2_); }
        if (blockIdx.x == 0 && opaque_tid(wid0) == 0) {
            unsigned long long acc = __hip_atomic_load((unsigned long long*)(arg_ws() + WS_CTL) + CW_ACC / 2, __ATOMIC_RELAXED, __HIP_MEMORY_SCOPE_AGENT);
            if (PROBE_STAMP == 7 || PROBE_STAMP == 8) { unsigned long long mn = ~0ull, sm = 0ull; for (int j = 0; j < 8; ++j) { const unsigned long long v = __hip_atomic_load((unsigned long long*)(arg_ws() + WS_CTL) + CW_ACC / 2 + 1 + j, __ATOMIC_RELAXED, __HIP_MEMORY_SCOPE_AGENT); mn = v < mn ? v : mn; sm += v; } acc = (PROBE_STAMP == 7 ? mn : sm / 8ull) * 256ull; }
            const unsigned long long ticks = acc / 256ull * STAMP_GAIN, t0 = wall_();
            while (wall_() - t0 < ticks) __builtin_amdgcn_s_sleep(32);
        }
        __syncthreads();
    }
#undef RUN_PH
#undef SEAM
}

extern "C" void kernel_launch(void* const* d_in, const int* in_sizes, int n_in, void* d_out, int out_size, void* d_ws, size_t ws_size, hipStream_t stream) {
    static int grid = 0;
    if (grid == 0) {
        if (n_in != 20 || in_sizes[0] != MG * D || in_sizes[1] != MG * D || out_size != 2 * MG * D || ws_size < WS_END) {
            fprintf(stderr, "kernel_launch: unexpected shapes (n_in %d, in0 %d, out %d, ws %zu < %zu); nothing launched\n", n_in, n_in > 0 ? in_sizes[0] : -1, out_size, ws_size, (size_t)WS_END); grid = -1; return; }
        int dev = 0, cus = 0, per_cu = 0;
        if (hipGetDevice(&dev) != hipSuccess || hipDeviceGetAttribute(&cus, hipDeviceAttributeMultiprocessorCount, dev) != hipSuccess) { grid = -1; return; }
        if (hipFuncSetAttribute((const void*)trunk_fwd, hipFuncAttributeMaxDynamicSharedMemorySize, LDS_BYTES) != hipSuccess) { fprintf(stderr, "kernel_launch: hipFuncSetAttribute failed\n"); grid = -1; return; }
        if (hipOccupancyMaxActiveBlocksPerMultiprocessor(&per_cu, (const void*)trunk_fwd, NWAVES * 64, LDS_BYTES) != hipSuccess || per_cu < 1)
            fprintf(stderr, "kernel_launch: note: occupancy query reports %d workgroups per CU\n", per_cu);
        (void)hipGetLastError();
        grid = cus;
    }
    if (grid < 0) return;
    if (hipMemsetAsync((char*)d_ws + WS_CTL, 0, CTL_ZERO_BYTES, stream) != hipSuccess) return;
    Args a{};
    for (int i = 0; i < 20; ++i) a.in[i] = (const float*)d_in[i];
    a.out = (float*)d_out; a.ws = (unsigned char*)d_ws;
#if MK_PER_PHASE
    for (int p = 0; p < N_PHASES; ++p) { a.ph_lo = p; a.ph_hi = p + 1; hipLaunchKernelGGL(trunk_fwd, dim3(grid), dim3(NWAVES * 64), LDS_BYTES, stream, a); }
#else
    a.ph_lo = 0; a.ph_hi = N_PHASES;
    hipLaunchKernelGGL(trunk_fwd, dim3(grid), dim3(NWAVES * 64), LDS_BYTES, stream, a);
#endif
    const hipError_t le = hipPeekAtLastError();
    if (le != hipSuccess) fprintf(stderr, "kernel_launch: launch failed: %s\n", hipGetErrorName(le));
}
```
